# Optimizing an MI355X kernel written in HIP

```python
import jax, jax.numpy as jnp
from jax import lax
import numpy as np

D_MODEL = 1024
BATCH = 4
SEQ = 8192
DEPTH = 1
DEC_BATCH = 128
DEC_SEQ = 4
PAST_LEN = 16384
PAGE_SIZE = 128

HGRN_HEADS = 4
HGRN_KDIM = 128
HGRN_VDIM = 128
HGRN_CHUNK = 64
N_Q_HEADS = 8
N_KV_HEADS = 2
HEAD_DIM = 64
Q_PER_KV = N_Q_HEADS // N_KV_HEADS
WINDOW = 128
D_FF = -(-(8 * D_MODEL) // (3 * 256)) * 256

HGRN_FWIDTH = HGRN_HEADS * HGRN_KDIM
HGRN_VWIDTH = HGRN_HEADS * HGRN_VDIM
ATTN_QWIDTH = N_Q_HEADS * HEAD_DIM
ATTN_KVWIDTH = N_KV_HEADS * HEAD_DIM
PROJ_SIZES = (HGRN_FWIDTH, HGRN_FWIDTH, HGRN_VWIDTH, HGRN_VWIDTH,
              ATTN_QWIDTH, ATTN_KVWIDTH, ATTN_KVWIDTH, D_MODEL, D_MODEL)
PROJ_WIDTH = sum(PROJ_SIZES)
EPS = 1e-6
NEG_BIG = -1e30

kernel_name = "hgrn2_swa_sink_alibi_parallel_hybrid_step"


def _split_points():
    pts, acc = [], 0
    for s in PROJ_SIZES[:-1]:
        acc += s
        pts.append(acc)
    return pts


def rms_norm(x, w):
    xf = x.astype(jnp.float32)
    xf = xf * lax.rsqrt(jnp.mean(xf * xf, axis=-1, keepdims=True) + EPS)
    return xf * w.astype(jnp.float32)


def alibi_slopes():
    return jnp.exp2(-8.0 * jnp.arange(1, N_Q_HEADS + 1, dtype=jnp.float32) / N_Q_HEADS)


def hgrn2_chunked(q, k, g, v, s0):
    b, t, h, dk = q.shape
    dv = v.shape[-1]
    c = min(HGRN_CHUNK, t)
    n = -(-t // c)
    pad = n * c - t
    if pad:
        pw = ((0, 0), (0, pad), (0, 0), (0, 0))
        q, k, g, v = jnp.pad(q, pw), jnp.pad(k, pw), jnp.pad(g, pw), jnp.pad(v, pw)

    def to_chunks(a):
        return a.reshape(b, n, c, h, a.shape[-1]).transpose(1, 0, 3, 2, 4)

    qc, kc, gc, vc = to_chunks(q), to_chunks(k), to_chunks(g), to_chunks(v)
    causal = jnp.tril(jnp.ones((c, c), dtype=bool))

    def step(s, inp):
        qi, ki, gi, vi = inp
        cum = jnp.cumsum(gi, axis=2)
        o_inter = jnp.einsum('bhtk,bhkv->bhtv', qi * jnp.exp(cum), s)
        diff = cum[:, :, :, None, :] - cum[:, :, None, :, :]
        decay = jnp.exp(jnp.where(causal[:, :, None], diff, -jnp.inf))
        scores = jnp.einsum('bhtk,bhjk,bhtjk->bhtj', qi, ki, decay)
        o = o_inter + jnp.einsum('bhtj,bhjv->bhtv', scores, vi)
        last = cum[:, :, -1]
        s_new = jnp.exp(last)[..., None] * s + jnp.einsum(
            'bhjk,bhjv->bhkv', ki * jnp.exp(last[:, :, None] - cum), vi)
        return s_new, o

    s_fin, o = lax.scan(step, s0, (qc, kc, gc, vc))
    o = o.transpose(1, 0, 3, 2, 4).reshape(b, n * c, h, dv)[:, :t]
    return o, s_fin


def hgrn2_branch(q_raw, f_raw, i_raw, g_raw, s0, lb, hgrn_norm_w):
    b, t, _ = q_raw.shape
    shp = (b, t, HGRN_HEADS, HGRN_KDIM)
    q = (jax.nn.silu(q_raw.astype(jnp.float32)) * (HGRN_KDIM ** -0.5)).reshape(shp)
    lbf = lb.astype(jnp.float32)
    f = lbf + (1.0 - lbf) * jax.nn.sigmoid(f_raw.astype(jnp.float32))
    k = (1.0 - f).reshape(shp)
    g = jnp.log(f).reshape(shp)
    v = i_raw.astype(jnp.float32).reshape(b, t, HGRN_HEADS, HGRN_VDIM)
    o, s_fin = hgrn2_chunked(q, k, g, v, s0.astype(jnp.float32))
    o = rms_norm(o, hgrn_norm_w.reshape(HGRN_HEADS, HGRN_VDIM))
    o = o.reshape(b, t, HGRN_VWIDTH) * jax.nn.silu(g_raw.astype(jnp.float32))
    return o, s_fin


def swa_core(q, k, v, q_pos, k_pos, sinks):
    s = jnp.einsum('bnqhgd,bnkhd->bnhgqk', q, k,
                   preferred_element_type=jnp.float32) * (HEAD_DIM ** -0.5)
    dist = q_pos[:, :, None] - k_pos[:, None, :]
    valid = (dist >= 0) & (dist < WINDOW) & (k_pos[:, None, :] >= 0)
    slopes = alibi_slopes().reshape(N_KV_HEADS, Q_PER_KV)[None, None, :, :, None, None]
    s = s - slopes * dist.astype(jnp.float32)[None, :, None, None]
    s = jnp.where(valid[None, :, None, None], s, NEG_BIG)
    sink = sinks.astype(jnp.float32).reshape(N_KV_HEADS, Q_PER_KV)[None, None, :, :, None, None]
    m = jnp.maximum(jnp.max(s, axis=-1, keepdims=True), sink)
    p = jnp.exp(s - m)
    p = p / (jnp.sum(p, axis=-1, keepdims=True) + jnp.exp(sink - m))
    return jnp.einsum('bnhgqk,bnkhd->bnqhgd', p, v.astype(jnp.float32))


def swa_prompt(q, k, v, sinks):
    b, t = q.shape[:2]
    nb = t // WINDOW
    qb = q.reshape(b, nb, WINDOW, N_KV_HEADS, Q_PER_KV, HEAD_DIM)
    kb = k.reshape(b, nb, WINDOW, N_KV_HEADS, HEAD_DIM)
    vb = v.reshape(b, nb, WINDOW, N_KV_HEADS, HEAD_DIM)
    k_prev = jnp.concatenate([jnp.zeros_like(kb[:, :1]), kb[:, :-1]], axis=1)
    v_prev = jnp.concatenate([jnp.zeros_like(vb[:, :1]), vb[:, :-1]], axis=1)
    k_band = jnp.concatenate([k_prev, kb], axis=2)
    v_band = jnp.concatenate([v_prev, vb], axis=2)
    blk = jnp.arange(nb, dtype=jnp.int32)[:, None] * WINDOW
    q_pos = blk + jnp.arange(WINDOW, dtype=jnp.int32)[None]
    k_pos = blk - WINDOW + jnp.arange(2 * WINDOW, dtype=jnp.int32)[None]
    o = swa_core(qb, k_band, v_band, q_pos, k_pos, sinks)
    return o.reshape(b, t, ATTN_QWIDTH)


def swa_sample(q, k, v, ck, cv, sinks):
    b, t = q.shape[:2]
    cw = ck.shape[1]
    k_all = jnp.concatenate([ck.astype(k.dtype), k], axis=1)
    v_all = jnp.concatenate([cv.astype(v.dtype), v], axis=1)
    q_pos = (PAST_LEN + jnp.arange(t, dtype=jnp.int32))[None]
    k_pos = jnp.concatenate([PAST_LEN - cw + jnp.arange(cw, dtype=jnp.int32), q_pos[0]])[None]
    o = swa_core(q.reshape(b, 1, t, N_KV_HEADS, Q_PER_KV, HEAD_DIM),
                 k_all[:, None], v_all[:, None], q_pos, k_pos, sinks)
    return o.reshape(b, t, ATTN_QWIDTH), k_all[:, -cw:], v_all[:, -cw:]


def layer_forward(x, s0, ck, cv, lb, norm1_w, w_in, hgrn_norm_w, q_norm_w, k_norm_w, sinks,
                  w_o_hgrn, w_o_attn, w_out, norm2_w, w_ffn_gate, w_ffn_up, w_ffn_down):
    b, t, _ = x.shape
    dt = x.dtype
    h = rms_norm(x, norm1_w).astype(dt)
    proj = h @ w_in
    qa, fa, ia, ga, qb, kb, vb, gate_a, gate_b = jnp.split(proj, _split_points(), axis=-1)
    if s0 is None:
        s0 = jnp.zeros((b, HGRN_HEADS, HGRN_KDIM, HGRN_VDIM), jnp.float32)
    y_a, s_new = hgrn2_branch(qa, fa, ia, ga, s0, lb, hgrn_norm_w)
    q = rms_norm(qb.reshape(b, t, N_Q_HEADS, HEAD_DIM), q_norm_w).astype(dt)
    k = rms_norm(kb.reshape(b, t, N_KV_HEADS, HEAD_DIM), k_norm_w).astype(dt)
    v = vb.reshape(b, t, N_KV_HEADS, HEAD_DIM)
    if ck is None:
        y_b = swa_prompt(q, k, v, sinks)
        cw = min(WINDOW, t)
        k_new, v_new = k[:, t - cw:], v[:, t - cw:]
    else:
        y_b, k_new, v_new = swa_sample(q, k, v, ck, cv, sinks)
    branch_a = (y_a.astype(dt) @ w_o_hgrn).astype(jnp.float32)
    branch_b = (y_b.astype(dt) @ w_o_attn).astype(jnp.float32)
    merged = (jax.nn.sigmoid(gate_a.astype(jnp.float32)) * branch_a
              + jax.nn.sigmoid(gate_b.astype(jnp.float32)) * branch_b)
    x = x + merged.astype(dt) @ w_out
    h2 = rms_norm(x, norm2_w).astype(dt)
    x = x + (jax.nn.silu(h2 @ w_ffn_gate) * (h2 @ w_ffn_up)) @ w_ffn_down
    return x, s_new, k_new, v_new


def setup_inputs(seed: int = 0) -> dict:
    key = jax.random.key(seed)
    ks = jax.random.split(key, 20)

    def nrm(k, shape, scale):
        return jax.random.normal(k, shape, jnp.float32) * scale

    cw = min(WINDOW, PAST_LEN)
    return {
        "x_prompt": nrm(ks[0], (BATCH, SEQ, D_MODEL), 1.0),
        "x_sample": nrm(ks[1], (DEC_BATCH, DEC_SEQ, D_MODEL), 1.0),
        "state_hgrn": nrm(ks[2], (DEPTH, DEC_BATCH, HGRN_HEADS, HGRN_KDIM, HGRN_VDIM), 0.5),
        "cache_k": nrm(ks[3], (DEPTH, DEC_BATCH, cw, N_KV_HEADS, HEAD_DIM), 1.0),
        "cache_v": nrm(ks[4], (DEPTH, DEC_BATCH, cw, N_KV_HEADS, HEAD_DIM), 1.0),
        "norm1_w": 1.0 + nrm(ks[5], (DEPTH, D_MODEL), 0.01),
        "w_in": nrm(ks[6], (DEPTH, D_MODEL, PROJ_WIDTH), D_MODEL ** -0.5),
        "lb_logits": nrm(ks[7], (DEPTH + 1, HGRN_FWIDTH), 0.1),
        "hgrn_norm_w": 1.0 + nrm(ks[8], (DEPTH, HGRN_VWIDTH), 0.01),
        "q_norm_w": 1.0 + nrm(ks[9], (DEPTH, HEAD_DIM), 0.01),
        "k_norm_w": 1.0 + nrm(ks[10], (DEPTH, HEAD_DIM), 0.01),
        "sinks": nrm(ks[11], (DEPTH, N_Q_HEADS), 0.5),
        "w_o_hgrn": nrm(ks[12], (DEPTH, HGRN_VWIDTH, D_MODEL), HGRN_VWIDTH ** -0.5),
        "w_o_attn": nrm(ks[13], (DEPTH, ATTN_QWIDTH, D_MODEL), ATTN_QWIDTH ** -0.5),
        "w_out": nrm(ks[14], (DEPTH, D_MODEL, D_MODEL), D_MODEL ** -0.5),
        "norm2_w": 1.0 + nrm(ks[15], (DEPTH, D_MODEL), 0.01),
        "w_ffn_gate": nrm(ks[16], (DEPTH, D_MODEL, D_FF), D_MODEL ** -0.5),
        "w_ffn_up": nrm(ks[17], (DEPTH, D_MODEL, D_FF), D_MODEL ** -0.5),
        "w_ffn_down": nrm(ks[18], (DEPTH, D_FF, D_MODEL), D_FF ** -0.5),
    }


def reference(x_prompt, x_sample, state_hgrn, cache_k, cache_v, norm1_w, w_in, lb_logits,
              hgrn_norm_w, q_norm_w, k_norm_w, sinks, w_o_hgrn, w_o_attn, w_out, norm2_w,
              w_ffn_gate, w_ffn_up, w_ffn_down):
    lower_bounds = jnp.cumsum(jax.nn.softmax(lb_logits.astype(jnp.float32), axis=0), axis=0)
    xp, xs = x_prompt, x_sample
    sp_list, kp_list, vp_list, ss_list, ksl, vsl = [], [], [], [], [], []
    for l in range(DEPTH):
        w = (lower_bounds[l], norm1_w[l], w_in[l], hgrn_norm_w[l], q_norm_w[l], k_norm_w[l],
             sinks[l], w_o_hgrn[l], w_o_attn[l], w_out[l], norm2_w[l], w_ffn_gate[l],
             w_ffn_up[l], w_ffn_down[l])
        xp, sp, kp, vp = layer_forward(xp, None, None, None, *w)
        xs, ss, kss, vss = layer_forward(xs, state_hgrn[l], cache_k[l], cache_v[l], *w)
        sp_list.append(sp)
        kp_list.append(kp)
        vp_list.append(vp)
        ss_list.append(ss)
        ksl.append(kss)
        vsl.append(vss)
    return (xp, xs, jnp.stack(sp_list), jnp.stack(kp_list), jnp.stack(vp_list),
            jnp.stack(ss_list), jnp.stack(ksl), jnp.stack(vsl))
```

```cpp
#include <hip/hip_runtime.h>
#include <hip/hip_cooperative_groups.h>
#include <cstdio>
#include <cstdint>
namespace cg = cooperative_groups;

#ifndef MK_N_LAUNCHES
#define MK_N_LAUNCHES 1
#endif

constexpr int DM = 1024, SEQ = 8192, NBATCH = 4, MP = NBATCH * SEQ, DEC_B = 128, DEC_T = 4, MS = DEC_B * DEC_T, MT = MP + MS;
constexpr int PW = 4864, DFF = 2816;
constexpr float EPS = 1e-6f;

constexpr size_t UB = (size_t)MT * 512 * 2;
constexpr size_t WS_W1T = 0;
constexpr size_t WS_WOH = WS_W1T + (size_t)PW * DM * 2;
constexpr size_t WS_WOA = WS_WOH + (size_t)1024 * 512 * 2;
constexpr size_t WS_WOUT = WS_WOA + (size_t)1024 * 512 * 2;
constexpr size_t WS_WGU = WS_WOUT + (size_t)1024 * 1024 * 2;
constexpr size_t WS_WD = WS_WGU + (size_t)2 * DFF * DM * 2;
constexpr size_t WS_MISC = WS_WD + (size_t)DM * DFF * 2;
constexpr size_t WS_LBV = WS_MISC;
constexpr size_t WS_SUMSQ = WS_MISC + 4096;
constexpr size_t WS_DT = WS_MISC + 512 * 1024;
constexpr size_t WS_R0 = (size_t)32 << 20;
constexpr size_t WS_R1 = WS_R0 + 2 * UB;
constexpr size_t WS_R2 = WS_R1 + UB;
constexpr size_t WS_R3 = WS_R2 + UB;
constexpr size_t WS_R4 = WS_R3 + 2 * UB;
constexpr size_t WS_R5 = WS_R4 + UB;
constexpr size_t WS_R6 = WS_R5 + UB;
constexpr size_t WS_R7 = WS_R6 + UB;
constexpr size_t WS_R8 = WS_R7 + UB / 2;
constexpr size_t WS_R9 = WS_R8 + 2 * UB;
constexpr size_t WS_R10 = WS_R9 + 2 * UB;
constexpr size_t WS_END = WS_R10 + UB;
static_assert(WS_MISC == ((size_t)30 << 20) && WS_END <= ((size_t)512 << 20), "d_ws map");
static_assert((size_t)MT * DFF * 2 <= 6 * UB, "ACT fits R0..R3");

constexpr size_t O_Y = 0;
constexpr size_t O_SP = (size_t)MT * DM;
constexpr size_t O_KP = O_SP + (size_t)4 * 4 * 128 * 128;
constexpr size_t O_VP = O_KP + (size_t)4 * 128 * 128;
constexpr size_t O_SS = O_VP + (size_t)4 * 128 * 128;
constexpr size_t O_KS = O_SS + (size_t)128 * 4 * 128 * 128;
constexpr size_t O_VS = O_KS + (size_t)128 * 128 * 128;
constexpr size_t O_END = O_VS + (size_t)128 * 128 * 128;

constexpr int LDS_BYTES = 131072;
constexpr int NTHREADS = 512;

#define LAS __attribute__((address_space(3)))
typedef unsigned short bf16;
typedef float f32x4 __attribute__((ext_vector_type(4)));
typedef float f32x2 __attribute__((ext_vector_type(2)));
typedef unsigned u32x4 __attribute__((ext_vector_type(4)));
typedef unsigned u32x2 __attribute__((ext_vector_type(2)));
typedef short bf16x8 __attribute__((ext_vector_type(8)));
typedef short s16x4 __attribute__((ext_vector_type(4)));

__device__ __forceinline__ float bf2f(unsigned short u) { return __uint_as_float((unsigned)u << 16); }
__device__ __forceinline__ float bflo(unsigned w) { return __uint_as_float(w << 16); }
__device__ __forceinline__ float bfhi(unsigned w) { return __uint_as_float(w & 0xffff0000u); }
typedef __bf16 bf16x2_t __attribute__((ext_vector_type(2)));
__device__ __forceinline__ unsigned pk2(float lo, float hi) { f32x2 v = {lo, hi}; bf16x2_t b = __builtin_convertvector(v, bf16x2_t); return __builtin_bit_cast(unsigned, b); }
__device__ __forceinline__ float sigm(float x) { return __builtin_amdgcn_rcpf(1.f + __expf(-x)); }
__device__ __forceinline__ s16x4 tr_read(const bf16* p) {
    return __builtin_bit_cast(s16x4, __builtin_amdgcn_ds_read_tr16_b64_v4i16((LAS s16x4*)(LAS void*)p));
}
__device__ __forceinline__ bf16x8 cat8(s16x4 a, s16x4 b) { return (bf16x8){a[0], a[1], a[2], a[3], b[0], b[1], b[2], b[3]}; }
__device__ __forceinline__ bf16x8 pk8(f32x4 a, f32x4 b) { u32x4 w; w.x = pk2(a[0], a[1]); w.y = pk2(a[2], a[3]); w.z = pk2(b[0], b[1]); w.w = pk2(b[2], b[3]); return __builtin_bit_cast(bf16x8, w); }
#define MFMA16(a, b, c) __builtin_amdgcn_mfma_f32_16x16x32_bf16((a), (b), (c), 0, 0, 0)

namespace pg8 {
#define PG8_LAS __attribute__((address_space(3)))
typedef unsigned short bf16_t;
typedef short bf16x8 __attribute__((ext_vector_type(8)));
typedef float f32x4 __attribute__((ext_vector_type(4)));
typedef unsigned u32x4 __attribute__((ext_vector_type(4)));
constexpr int BM = 256, BK = 64, HALF = 128, HTB = HALF * BK * 2  , STAGE_BYTES = 8 * HTB, NXCD = 8, WGM = 8;

__host__ __device__ __forceinline__ int lds_byte(int r, int c) { const int st = (r >> 4) * 2 + (c >> 5), rr = r & 15, cc = c & 31, ob = rr * 64 + cc * 2; return st * 1024 + (ob ^ (((ob >> 9) & 1) << 5)); }
__host__ __device__ __forceinline__ void stage_rc(int b, int& R, int& C) { const int st = b / 1024, sb = b % 1024, swz = sb ^ (((sb >> 9) & 1) << 5); R = (st >> 1) * 16 + swz / 64; C = (st & 1) * 32 + (swz % 64) / 2; }
__host__ __device__ __forceinline__ int perm32(int rho) { const int n = rho >> 4, i = rho & 15; return 8 * (i >> 2) + 4 * n + (i & 3); }

struct Unit { int pm, pn; };
struct Gemm { const bf16_t* A; const bf16_t* Bt; int M, N, K; };

struct StaticOrder {
    int nM, nN, nwg, G, c;
    __host__ __device__ void init(int M, int N, int G_, int c_) { nM = M / BM; nN = N / BM; nwg = nM * nN; G = G_; c = c_; }
    __host__ __device__ bool next(int i, Unit& u) const {
        const long L = (long)i * G + c; if (L >= nwg) return false;
        int wgid = (int)L; { const int q = nwg / NXCD, r = nwg % NXCD, xcd = wgid % NXCD, off = wgid / NXCD; wgid = (xcd < r ? xcd * (q + 1) : r * (q + 1) + (xcd - r) * q) + off; }
        const int nig = WGM * nN, gid = wgid / nig, fm = gid * WGM, gsz = (nM - fm) < WGM ? (nM - fm) : WGM;
        u.pm = fm + ((wgid % nig) % gsz); u.pn = (wgid % nig) / gsz; return true;
    }
    __device__ __forceinline__ void a_ready(const Unit&) const {}
    __device__ __forceinline__ void done(const Unit&) const {}
};

__device__ __forceinline__ unsigned cvt_pk_bf16(float lo, float hi) { unsigned r; asm volatile("v_cvt_pk_bf16_f32 %0, %1, %2" : "=v"(r) : "v"(lo), "v"(hi)); return r; }

struct EpiProj {
    static constexpr bool PERM = true, AFTER_DRAIN = false;
    bf16_t *QH, *KH, *VH, *OG, *QA, *KV, *GA, *GB; float* GH; const float* lbv;
    __device__ __forceinline__ void operator()(const f32x4 (&acc)[2][2][4][2], const Unit& u, int wr, int wc, int fr, int fq) const {
        const int pn = u.pn; int mode, ld, cb; bf16_t* dst; float sc = 1.f;
        if (pn < 2)        { mode = 1; dst = QH; ld = 512;  cb = pn * 256; sc = 0.08838834764831845f; }
        else if (pn < 4)   { mode = 3; dst = KH; ld = 512;  cb = (pn - 2) * 256; }
        else if (pn < 6)   { mode = 0; dst = VH; ld = 512;  cb = (pn - 4) * 256; }
        else if (pn < 8)   { mode = 1; dst = OG; ld = 512;  cb = (pn - 6) * 256; }
        else if (pn < 10)  { mode = 0; dst = QA; ld = 512;  cb = (pn - 8) * 256; }
        else if (pn == 10) { mode = 0; dst = KV; ld = 256;  cb = 0; }
        else if (pn < 15)  { mode = 2; dst = GA; ld = 1024; cb = (pn - 11) * 256; }
        else               { mode = 2; dst = GB; ld = 1024; cb = (pn - 15) * 256; }
        const int row0 = u.pm * BM + wr * 64 + fr, col0 = cb + wc * 32 + 8 * fq;
#pragma unroll
        for (int bj = 0; bj < 2; ++bj) {
            const int col = col0 + bj * HALF;
            f32x4 l0 = {0.f, 0.f, 0.f, 0.f}, l1 = l0;
            if (mode == 3) { l0 = *(const f32x4*)(lbv + col); l1 = *(const f32x4*)(lbv + col + 4); }
#pragma unroll
            for (int ai = 0; ai < 2; ++ai)
#pragma unroll
                for (int m = 0; m < 4; ++m) {
                    const size_t row = (size_t)(row0 + ai * HALF + m * 16);
                    f32x4 v0 = acc[ai][bj][m][0], v1 = acc[ai][bj][m][1];
                    if (mode == 1) {
#pragma unroll
                        for (int i = 0; i < 4; ++i) { v0[i] = v0[i] * sigm(v0[i]) * sc; v1[i] = v1[i] * sigm(v1[i]) * sc; }
                    } else if (mode == 2) {
#pragma unroll
                        for (int i = 0; i < 4; ++i) { v0[i] = sigm(v0[i]); v1[i] = sigm(v1[i]); }
                    } else if (mode == 3) {
                        f32x4 g0, g1;
#pragma unroll
                        for (int i = 0; i < 4; ++i) {
                            const float f0 = l0[i] + (1.f - l0[i]) * sigm(v0[i]), f1 = l1[i] + (1.f - l1[i]) * sigm(v1[i]);
                            g0[i] = __logf(f0); g1[i] = __logf(f1); v0[i] = 1.f - f0; v1[i] = 1.f - f1;
                        }
                        float* gp = GH + row * 512 + col; *(f32x4*)gp = g0; *(f32x4*)(gp + 4) = g1;
                    }
                    u32x4 w; w.x = pk2(v0[0], v0[1]); w.y = pk2(v0[2], v0[3]); w.z = pk2(v1[0], v1[1]); w.w = pk2(v1[2], v1[3]);
                    *(u32x4*)(dst + row * ld + col) = w;
                }
        }
    }
};
template <bool ADD> struct EpiGate {
    static constexpr bool PERM = true, AFTER_DRAIN = false;
    const bf16_t* gate; const bf16_t* T; bf16_t* O;
    __device__ __forceinline__ void operator()(const f32x4 (&acc)[2][2][4][2], const Unit& u, int wr, int wc, int fr, int fq) const {
        const int row0 = u.pm * BM + wr * 64 + fr, col0 = u.pn * BM + wc * 32 + 8 * fq;
#pragma unroll
        for (int ai = 0; ai < 2; ++ai)
#pragma unroll
            for (int m = 0; m < 4; ++m)
#pragma unroll
                for (int bj = 0; bj < 2; ++bj) {
                    const size_t off = (size_t)(row0 + ai * HALF + m * 16) * 1024 + col0 + bj * HALF;
                    const u32x4 gw = *(const u32x4*)(gate + off);
                    f32x4 v0 = acc[ai][bj][m][0], v1 = acc[ai][bj][m][1];
                    v0[0] *= bflo(gw.x); v0[1] *= bfhi(gw.x); v0[2] *= bflo(gw.y); v0[3] *= bfhi(gw.y);
                    v1[0] *= bflo(gw.z); v1[1] *= bfhi(gw.z); v1[2] *= bflo(gw.w); v1[3] *= bfhi(gw.w);
                    if (ADD) { const u32x4 tw = *(const u32x4*)(T + off);
                        v0[0] += bflo(tw.x); v0[1] += bfhi(tw.x); v0[2] += bflo(tw.y); v0[3] += bfhi(tw.y);
                        v1[0] += bflo(tw.z); v1[1] += bfhi(tw.z); v1[2] += bflo(tw.w); v1[3] += bfhi(tw.w); }
                    u32x4 w; w.x = pk2(v0[0], v0[1]); w.y = pk2(v0[2], v0[3]); w.z = pk2(v1[0], v1[1]); w.w = pk2(v1[2], v1[3]);
                    *(u32x4*)(O + off) = w;
                }
    }
};
struct EpiRes1 {
    static constexpr bool PERM = true, AFTER_DRAIN = false;
    const float* xp; const float* xs; float* out; bf16_t* X1B; float* sumsq;
    __device__ __forceinline__ void operator()(const f32x4 (&acc)[2][2][4][2], const Unit& u, int wr, int wc, int fr, int fq) const {
        const int row0 = u.pm * BM + wr * 64 + fr, col0 = u.pn * BM + wc * 32 + 8 * fq;
        const float* xb = (u.pm * BM < MP) ? xp : xs - (size_t)MP * 1024;
#pragma unroll
        for (int ai = 0; ai < 2; ++ai)
#pragma unroll
            for (int m = 0; m < 4; ++m) {
                const int row = row0 + ai * HALF + m * 16; float ss = 0.f;
#pragma unroll
                for (int bj = 0; bj < 2; ++bj) {
                    const size_t off = (size_t)row * 1024 + col0 + bj * HALF;
                    const f32x4 v0 = acc[ai][bj][m][0] + *(const f32x4*)(xb + off), v1 = acc[ai][bj][m][1] + *(const f32x4*)(xb + off + 4);
                    *(f32x4*)(out + off) = v0; *(f32x4*)(out + off + 4) = v1;
                    ss += (v0[0] * v0[0] + v0[1] * v0[1]) + (v0[2] * v0[2] + v0[3] * v0[3]) + (v1[0] * v1[0] + v1[1] * v1[1]) + (v1[2] * v1[2] + v1[3] * v1[3]);
                    u32x4 w; w.x = pk2(v0[0], v0[1]); w.y = pk2(v0[2], v0[3]); w.z = pk2(v1[0], v1[1]); w.w = pk2(v1[2], v1[3]);
                    *(u32x4*)(X1B + off) = w;
                }
                ss += __shfl_xor(ss, 16); ss += __shfl_xor(ss, 32);
                if (fq == 0) atomicAdd(sumsq + row, ss);
            }
    }
};
struct EpiFfn {
    static constexpr bool PERM = true, AFTER_DRAIN = false;
    const float* sumsq; bf16_t* ACT;
    __device__ __forceinline__ void operator()(const f32x4 (&acc)[2][2][4][2], const Unit& u, int wr, int wc, int fr, int fq) const {
        const int row0 = u.pm * BM + wr * 64 + fr, col0 = u.pn * HALF + wc * 32 + 8 * fq;
#pragma unroll
        for (int ai = 0; ai < 2; ++ai)
#pragma unroll
            for (int m = 0; m < 4; ++m) {
                const int row = row0 + ai * HALF + m * 16;
                const float r = __builtin_amdgcn_rsqf(sumsq[row] * (1.f / 1024.f) + 1e-6f);
                f32x4 o0, o1;
#pragma unroll
                for (int i = 0; i < 4; ++i) {
                    const float g0 = acc[ai][0][m][0][i] * r, g1 = acc[ai][0][m][1][i] * r;
                    o0[i] = g0 * sigm(g0) * (acc[ai][1][m][0][i] * r); o1[i] = g1 * sigm(g1) * (acc[ai][1][m][1][i] * r);
                }
                u32x4 w; w.x = pk2(o0[0], o0[1]); w.y = pk2(o0[2], o0[3]); w.z = pk2(o1[0], o1[1]); w.w = pk2(o1[2], o1[3]);
                *(u32x4*)(ACT + (size_t)row * 2816 + col0) = w;
            }
    }
};
struct EpiRes2 {
    static constexpr bool PERM = true, AFTER_DRAIN = false;
    float* out;
    __device__ __forceinline__ void operator()(const f32x4 (&acc)[2][2][4][2], const Unit& u, int wr, int wc, int fr, int fq) const {
        const int row0 = u.pm * BM + wr * 64 + fr, col0 = u.pn * BM + wc * 32 + 8 * fq;
#pragma unroll
        for (int ai = 0; ai < 2; ++ai)
#pragma unroll
            for (int m = 0; m < 4; ++m)
#pragma unroll
                for (int bj = 0; bj < 2; ++bj) {
                    float* p = out + (size_t)(row0 + ai * HALF + m * 16) * 1024 + col0 + bj * HALF;
                    const f32x4 v0 = *(const f32x4*)p + acc[ai][bj][m][0], v1 = *(const f32x4*)(p + 4) + acc[ai][bj][m][1];
                    *(f32x4*)p = v0; *(f32x4*)(p + 4) = v1;
                }
    }
};
template <class Epi, class Sched, bool ALIGN_EPI = false, bool SP2 = false>
__device__ __forceinline__ void gemm_phase(PG8_LAS unsigned char* lds, const Gemm g, const Sched& S, const Epi& E) {
    const int tid = threadIdx.x, wid = __builtin_amdgcn_readfirstlane(tid >> 6), lane = tid & 63, wr = wid >> 2, wc = wid & 3, fr = lane & 15, fq = lane >> 4;
    const int K = g.K, nt = K / BK;
    unsigned voffA[2], voffB[2];
#pragma unroll
    for (int i = 0; i < 2; ++i) { int R, C; stage_rc(tid * 16 + i * 8192, R, C); const int Rb = Epi::PERM ? ((R & ~31) + perm32(R & 31)) : R;
        voffA[i] = (unsigned)(R * K + C) * 2u; voffB[i] = (unsigned)(Rb * K + C) * 2u; }
    const size_t kstep = (size_t)(BK * 2);
    const size_t hstep = (size_t)HALF * K * 2;
    const size_t tstep = 2 * hstep;
    const unsigned ldsw = (unsigned)wid * 1024u;
    const int aoff = lds_byte(wr * 64 + fr, fq * 8), boff = lds_byte(wc * 32 + fr, fq * 8);
#define PG8_SA(b, h) (((b) * 2 + (h)) * HTB)
#define PG8_SB(b, h) ((4 + (b) * 2 + (h)) * HTB)
#define PG8_STAGE(bufoff, gbase, voff) do { _Pragma("unroll") for (int _i = 0; _i < 2; ++_i) \
        __builtin_amdgcn_global_load_lds((const unsigned*)((const char*)(gbase) + (voff)[_i]), (PG8_LAS unsigned*)(lds + (bufoff) + ldsw + _i * 8192), 16, 0, 0); } while (0)
#define PG8_LDA(dst, b, h) do { _Pragma("unroll") for (int m = 0; m < 4; ++m) _Pragma("unroll") for (int k = 0; k < 2; ++k) dst[m][k] = *(const PG8_LAS bf16x8*)(lds + PG8_SA(b, h) + aoff + m * 2048 + k * 1024); } while (0)
#define PG8_LDB(dst, b, h) do { _Pragma("unroll") for (int n = 0; n < 2; ++n) _Pragma("unroll") for (int k = 0; k < 2; ++k) dst[n][k] = *(const PG8_LAS bf16x8*)(lds + PG8_SB(b, h) + boff + n * 2048 + k * 1024); } while (0)
#define PG8_MMA(ai, bj, At, Bt) do { __builtin_amdgcn_s_setprio(1); _Pragma("unroll") for (int m = 0; m < 4; ++m) _Pragma("unroll") for (int n = 0; n < 2; ++n) _Pragma("unroll") for (int k = 0; k < 2; ++k) \
        acc[ai][bj][m][n] = __builtin_amdgcn_mfma_f32_16x16x32_bf16(Bt[n][k], At[m][k], acc[ai][bj][m][n], 0, 0, 0); __builtin_amdgcn_s_setprio(0); } while (0)
#define PG8_WAIT_V(n) asm volatile("s_waitcnt vmcnt(" #n ")" ::: "memory")
#define PG8_WAIT_L(n) asm volatile("s_waitcnt lgkmcnt(" #n ")" ::: "memory")
#define PG8_BAR __builtin_amdgcn_s_barrier()
#define PG8_SCHED __builtin_amdgcn_sched_barrier(0)
    Unit cur, nxt; int ui = 0;
    if (!S.next(0, cur)) return;
    f32x4 acc[2][2][4][2];
#pragma unroll
    for (int a = 0; a < 2; ++a)
#pragma unroll
        for (int b = 0; b < 2; ++b)
#pragma unroll
            for (int m = 0; m < 4; ++m)
#pragma unroll
                for (int n = 0; n < 2; ++n) acc[a][b][m][n] = (f32x4){0.f, 0.f, 0.f, 0.f};
    bf16x8 At[4][2], B0[2][2], B1[2][2];
    const char* cA = (const char*)g.A + (size_t)cur.pm * tstep; const char* cB = (const char*)g.Bt + (size_t)cur.pn * tstep;
    S.a_ready(cur);
    if constexpr (SP2) {
        PG8_STAGE(PG8_SB(0, 0), cB, voffB); PG8_STAGE(PG8_SB(0, 1), cB + hstep, voffB); PG8_STAGE(PG8_SA(0, 0), cA, voffA); PG8_STAGE(PG8_SA(0, 1), cA + hstep, voffA);
        if (wr == 1) PG8_BAR;
        PG8_WAIT_V(2); PG8_BAR;
        PG8_STAGE(PG8_SB(1, 0), cB + kstep, voffB); PG8_STAGE(PG8_SA(1, 0), cA + kstep, voffA); PG8_STAGE(PG8_SB(1, 1), cB + hstep + kstep, voffB);
        PG8_WAIT_V(6); PG8_BAR;
    } else {
        PG8_STAGE(PG8_SB(0, 0), cB, voffB); PG8_STAGE(PG8_SA(0, 0), cA, voffA); PG8_STAGE(PG8_SB(0, 1), cB + hstep, voffB); PG8_STAGE(PG8_SA(0, 1), cA + hstep, voffA);
        if (wr == 1) PG8_BAR;
        PG8_WAIT_V(4); PG8_BAR;
        PG8_STAGE(PG8_SB(1, 0), cB + kstep, voffB); PG8_STAGE(PG8_SA(1, 0), cA + kstep, voffA); PG8_STAGE(PG8_SB(1, 1), cB + hstep + kstep, voffB);
        PG8_WAIT_V(6); PG8_BAR;
    }
    for (;;) {
        const bool has_next = S.next(ui + 1, nxt);
        const char* nA = has_next ? (const char*)g.A + (size_t)nxt.pm * tstep : cA; const char* nB = has_next ? (const char*)g.Bt + (size_t)nxt.pn * tstep : cB;
        for (int t = 0; t < nt; t += 2) {
            const bool last = (t == nt - 2);
            const char* a1 = cA + (size_t)(t + 1) * kstep;
            const char* a2 = last ? nA : cA + (size_t)(t + 2) * kstep; const char* b2 = last ? nB : cB + (size_t)(t + 2) * kstep;
            const char* a3 = a2 + kstep; const char* b3 = b2 + kstep;
            if (last && has_next) S.a_ready(nxt);
            if constexpr (SP2) {
            PG8_LDB(B0, 0, 0); PG8_LDB(B1, 0, 1); PG8_SCHED; PG8_LDA(At, 0, 0); PG8_STAGE(PG8_SA(1, 1), a1 + hstep, voffA);
            PG8_WAIT_V(8); PG8_WAIT_L(0); PG8_BAR; PG8_MMA(0, 0, At, B0); PG8_MMA(0, 1, At, B1); PG8_BAR; PG8_SCHED;
            PG8_LDA(At, 0, 1); PG8_STAGE(PG8_SB(0, 0), b2, voffB); PG8_STAGE(PG8_SB(0, 1), b2 + hstep, voffB); PG8_STAGE(PG8_SA(0, 0), a2, voffA);
            PG8_WAIT_V(8); PG8_WAIT_L(0); PG8_BAR; PG8_MMA(1, 0, At, B0); PG8_MMA(1, 1, At, B1); PG8_BAR; PG8_SCHED;
            PG8_LDB(B0, 1, 0); PG8_LDB(B1, 1, 1); PG8_SCHED; PG8_LDA(At, 1, 0); PG8_STAGE(PG8_SA(0, 1), a2 + hstep, voffA);
            PG8_WAIT_V(8); PG8_WAIT_L(0); PG8_BAR; PG8_MMA(0, 0, At, B0); PG8_MMA(0, 1, At, B1); PG8_BAR; PG8_SCHED;
            PG8_LDA(At, 1, 1); PG8_STAGE(PG8_SB(1, 0), b3, voffB); PG8_STAGE(PG8_SB(1, 1), b3 + hstep, voffB); PG8_STAGE(PG8_SA(1, 0), a3, voffA);
            PG8_WAIT_V(8); PG8_WAIT_L(0); PG8_BAR; PG8_MMA(1, 0, At, B0); PG8_MMA(1, 1, At, B1); PG8_BAR; PG8_SCHED;
            } else {
            PG8_LDB(B0, 0, 0); PG8_SCHED; PG8_LDA(At, 0, 0); PG8_STAGE(PG8_SA(1, 1), a1 + hstep, voffA);
            PG8_WAIT_L(8); PG8_BAR; PG8_WAIT_L(0); PG8_MMA(0, 0, At, B0); PG8_BAR; PG8_SCHED;
            PG8_LDB(B1, 0, 1); PG8_STAGE(PG8_SB(0, 0), b2, voffB);
            PG8_BAR; PG8_WAIT_L(0); PG8_MMA(0, 1, At, B1); PG8_BAR;
            PG8_LDA(At, 0, 1); PG8_STAGE(PG8_SA(0, 0), a2, voffA);
            PG8_BAR; PG8_WAIT_L(0); PG8_MMA(1, 0, At, B0); PG8_BAR; PG8_SCHED;
            PG8_STAGE(PG8_SB(0, 1), b2 + hstep, voffB);
            PG8_WAIT_V(6); PG8_BAR; PG8_MMA(1, 1, At, B1); PG8_BAR;
            PG8_LDB(B0, 1, 0); PG8_SCHED; PG8_LDA(At, 1, 0); PG8_STAGE(PG8_SA(0, 1), a2 + hstep, voffA);
            PG8_WAIT_L(8); PG8_BAR; PG8_WAIT_L(0); PG8_MMA(0, 0, At, B0); PG8_BAR; PG8_SCHED;
            PG8_LDB(B1, 1, 1); PG8_STAGE(PG8_SB(1, 0), b3, voffB);
            PG8_BAR; PG8_WAIT_L(0); PG8_MMA(0, 1, At, B1); PG8_BAR;
            PG8_LDA(At, 1, 1); PG8_STAGE(PG8_SA(1, 0), a3, voffA);
            PG8_BAR; PG8_WAIT_L(0); PG8_MMA(1, 0, At, B0); PG8_BAR; PG8_SCHED;
            PG8_STAGE(PG8_SB(1, 1), b3 + hstep, voffB);
            PG8_WAIT_V(6); PG8_BAR; PG8_MMA(1, 1, At, B1); PG8_BAR;
            }
        }
        if constexpr (ALIGN_EPI) { if (wr == 0) PG8_BAR; }
        if constexpr (!Epi::AFTER_DRAIN) { E(acc, cur, wr, wc, fr, fq); S.done(cur); }
        if (!has_next) break;
#pragma unroll
        for (int a = 0; a < 2; ++a)
#pragma unroll
            for (int b = 0; b < 2; ++b)
#pragma unroll
                for (int m = 0; m < 4; ++m)
#pragma unroll
                    for (int n = 0; n < 2; ++n) acc[a][b][m][n] = (f32x4){0.f, 0.f, 0.f, 0.f};
        cur = nxt; cA = nA; cB = nB; ++ui;
        if constexpr (ALIGN_EPI) { if (wr == 1) PG8_BAR; }
    }
    PG8_WAIT_V(0);
    if constexpr (!ALIGN_EPI) { if (wr == 0) PG8_BAR; }
    PG8_BAR;
    if constexpr (Epi::AFTER_DRAIN) { E.fused(acc, cur, wr, wc, fr, fq, lds, wid, lane); S.done(cur); }
#undef PG8_SA
#undef PG8_SB
#undef PG8_STAGE
#undef PG8_LDA
#undef PG8_LDB
#undef PG8_MMA
#undef PG8_WAIT_V
#undef PG8_WAIT_L
#undef PG8_BAR
#undef PG8_SCHED
}
}

struct Args {
    const float *x_prompt, *x_sample, *state_hgrn, *cache_k, *cache_v, *norm1_w, *w_in, *lb_logits, *hgrn_norm_w, *q_norm_w, *k_norm_w, *sinks,
                *w_o_hgrn, *w_o_attn, *w_out, *norm2_w, *w_ffn_gate, *w_ffn_up, *w_ffn_down;
    float* out; unsigned char* ws; int ph_lo, ph_hi;
};

__device__ __forceinline__ float wave_sum(float v) {
#pragma unroll
    for (int o = 1; o < 64; o <<= 1) v += __shfl_xor(v, o);
    return v;
}

__device__ __forceinline__ void p0_transpose_item(const float* __restrict__ W, int ldw, int K, bf16* WT, int k0, int n0, int drow0, const float* __restrict__ ks, LAS float* scr, int lane) {
#pragma unroll 8
    for (int i = 0; i < 32; ++i) { const int kk = 2 * i + (lane >> 5); const float s = ks ? ks[k0 + kk] : 1.f; scr[kk * 33 + (lane & 31)] = W[(size_t)(k0 + kk) * ldw + n0 + (lane & 31)] * s; }
    asm volatile("s_waitcnt lgkmcnt(0)" ::: "memory");
    const int c = lane & 7;
#pragma unroll
    for (int j = 0; j < 4; ++j) { const int n = (lane >> 3) + 8 * j; const LAS float* s = scr + (8 * c) * 33 + n;
        u32x4 o; o.x = pk2(s[0 * 33], s[1 * 33]); o.y = pk2(s[2 * 33], s[3 * 33]); o.z = pk2(s[4 * 33], s[5 * 33]); o.w = pk2(s[6 * 33], s[7 * 33]);
        *(u32x4*)(WT + (size_t)(drow0 + n) * K + k0 + 8 * c) = o; }
    asm volatile("s_waitcnt lgkmcnt(0)" ::: "memory");
}

__device__ __forceinline__ void p0_prologue(const Args& a, unsigned char* lds) {
    const int tid = threadIdx.x, lane = tid & 63, wave = tid >> 6;
    LAS float* scr = (LAS float*)(LAS void*)(lds + wave * 16384);
    const int gw = blockIdx.x * 8 + wave, NGW = gridDim.x * 8;
    unsigned char* ws = a.ws;
    constexpr int I1 = 16 * 152, I2 = 8 * 32, I4 = 16 * 32, I5 = 16 * 88, I7 = 44 * 32;
    constexpr int NITEMS = I1 + 2 * I2 + I4 + 2 * I5 + I7;
    for (int it = gw; it < NITEMS; it += NGW) {
        int r = it;
        if (r < I1) { p0_transpose_item(a.w_in, PW, 1024, (bf16*)(ws + WS_W1T), 64 * (r / 152), 32 * (r % 152), 32 * (r % 152), a.norm1_w, scr, lane); continue; } r -= I1;
        if (r < I2) { p0_transpose_item(a.w_o_hgrn, 1024, 512, (bf16*)(ws + WS_WOH), 64 * (r / 32), 32 * (r % 32), 32 * (r % 32), nullptr, scr, lane); continue; } r -= I2;
        if (r < I2) { p0_transpose_item(a.w_o_attn, 1024, 512, (bf16*)(ws + WS_WOA), 64 * (r / 32), 32 * (r % 32), 32 * (r % 32), nullptr, scr, lane); continue; } r -= I2;
        if (r < I4) { p0_transpose_item(a.w_out, 1024, 1024, (bf16*)(ws + WS_WOUT), 64 * (r / 32), 32 * (r % 32), 32 * (r % 32), nullptr, scr, lane); continue; } r -= I4;
        if (r < I5) { const int n0 = 32 * (r % 88); p0_transpose_item(a.w_ffn_gate, DFF, 1024, (bf16*)(ws + WS_WGU), 64 * (r / 88), n0, (n0 >> 7) * 256 + (n0 & 127), a.norm2_w, scr, lane); continue; } r -= I5;
        if (r < I5) { const int n0 = 32 * (r % 88); p0_transpose_item(a.w_ffn_up, DFF, 1024, (bf16*)(ws + WS_WGU), 64 * (r / 88), n0, (n0 >> 7) * 256 + 128 + (n0 & 127), a.norm2_w, scr, lane); continue; } r -= I5;
        p0_transpose_item(a.w_ffn_down, 1024, DFF, (bf16*)(ws + WS_WD), 64 * (r / 32), 32 * (r % 32), 32 * (r % 32), nullptr, scr, lane);
    }
    bf16* XB = (bf16*)(ws + WS_R0);
    for (int m = gw; m < MT; m += NGW) {
        const float* xrow = (m < MP) ? a.x_prompt + (size_t)m * 1024 : a.x_sample + (size_t)(m - MP) * 1024;
        const f32x4* xr = (const f32x4*)xrow + lane;
        f32x4 v[4]; float s = 0.f;
#pragma unroll
        for (int j = 0; j < 4; ++j) { v[j] = xr[64 * j]; s += (v[j][0] * v[j][0] + v[j][1] * v[j][1]) + (v[j][2] * v[j][2] + v[j][3] * v[j][3]); }
        const float rstd = __builtin_amdgcn_rsqf(wave_sum(s) * (1.f / 1024.f) + EPS);
        u32x2* o8 = (u32x2*)(XB + (size_t)m * 1024) + lane;
#pragma unroll
        for (int j = 0; j < 4; ++j) { u32x2 w; w.x = pk2(v[j][0] * rstd, v[j][1] * rstd); w.y = pk2(v[j][2] * rstd, v[j][3] * rstd); o8[64 * j] = w; }
    }
    float* sumsq = (float*)(ws + WS_SUMSQ);
    for (int i = blockIdx.x * NTHREADS + tid; i < MT; i += gridDim.x * NTHREADS) sumsq[i] = 0.f;
    if (blockIdx.x == 0) { float* lbv = (float*)(ws + WS_LBV); lbv[tid] = sigm(a.lb_logits[tid] - a.lb_logits[512 + tid]); }
}

__device__ __forceinline__ void hgrn_local_item(const Args& a, int cidx, int h, unsigned char* lds) {
    const int tid = threadIdx.x, lane = tid & 63, wid = tid >> 6;
    float* cumS = (float*)lds; float* segT = (float*)(lds + 32768); bf16* KdS = (bf16*)(lds + 34816); bf16* VS = (bf16*)(lds + 52224);
    unsigned char* ws = a.ws;
    const size_t r0 = (size_t)cidx * 64;
    float* G = (float*)(ws + WS_R3) + r0 * 512 + h * 128;
    const bf16* KH = (const bf16*)(ws + WS_R2) + r0 * 512 + h * 128;
    const bf16* VH = (const bf16*)(ws + WS_R4) + r0 * 512 + h * 128;
#pragma unroll
    for (int i = 0; i < 4; ++i) { const int idx = tid + 512 * i, j = idx >> 5, k4 = (idx & 31) * 4; *(f32x4*)(cumS + j * 128 + k4) = *(const f32x4*)(G + (size_t)j * 512 + k4); }
    __syncthreads();
    {
        const int k = tid & 127, seg = tid >> 7; float v[16]; float run = 0.f;
#pragma unroll
        for (int i = 0; i < 16; ++i) { run += cumS[(seg * 16 + i) * 128 + k]; v[i] = run; }
        segT[seg * 128 + k] = run;
        __syncthreads();
        float off = 0.f;
#pragma unroll
        for (int s = 0; s < 3; ++s) off += (s < seg) ? segT[s * 128 + k] : 0.f;
#pragma unroll
        for (int i = 0; i < 16; ++i) cumS[(seg * 16 + i) * 128 + k] = v[i] + off;
    }
    __syncthreads();
#ifndef HL_NO_WB
#pragma unroll
    for (int i = 0; i < 4; ++i) { const int idx = tid + 512 * i, j = idx >> 5, k4 = (idx & 31) * 4; *(f32x4*)(G + (size_t)j * 512 + k4) = *(const f32x4*)(cumS + j * 128 + k4); }
    if (tid < 128) ((float*)(ws + WS_DT))[(size_t)(cidx * 4 + h) * 128 + tid] = __expf(cumS[63 * 128 + tid]);
#endif
#pragma unroll
    for (int i = 0; i < 2; ++i) {
        const int idx = tid + 512 * i, j = idx >> 4, k8 = (idx & 15) * 8;
        const u32x4 kw = *(const u32x4*)(KH + (size_t)j * 512 + k8);
        const f32x4 c0 = *(const f32x4*)(cumS + j * 128 + k8), c1 = *(const f32x4*)(cumS + j * 128 + k8 + 4);
        const f32x4 l0 = *(const f32x4*)(cumS + 63 * 128 + k8), l1 = *(const f32x4*)(cumS + 63 * 128 + k8 + 4);
        u32x4 w;
        w.x = pk2(bflo(kw.x) * __expf(l0[0] - c0[0]), bfhi(kw.x) * __expf(l0[1] - c0[1]));
        w.y = pk2(bflo(kw.y) * __expf(l0[2] - c0[2]), bfhi(kw.y) * __expf(l0[3] - c0[3]));
        w.z = pk2(bflo(kw.z) * __expf(l1[0] - c1[0]), bfhi(kw.z) * __expf(l1[1] - c1[1]));
        w.w = pk2(bflo(kw.w) * __expf(l1[2] - c1[2]), bfhi(kw.w) * __expf(l1[3] - c1[3]));
        *(u32x4*)(KdS + j * 136 + k8) = w;
        *(u32x4*)(VS + j * 136 + k8) = *(const u32x4*)(VH + (size_t)j * 512 + k8);
    }
    __syncthreads();
    {
        const int i16 = lane & 15, g = lane >> 4, q = i16 >> 2, p = i16 & 3;
        bf16x8 af[2];
#pragma unroll
        for (int jc = 0; jc < 2; ++jc) af[jc] = cat8(tr_read(KdS + (32 * jc + 8 * g + q) * 136 + 16 * wid + 4 * p), tr_read(KdS + (32 * jc + 8 * g + 4 + q) * 136 + 16 * wid + 4 * p));
        bf16* SLT = (bf16*)(ws + WS_R0) + (size_t)(cidx * 4 + h) * 16384;
#pragma unroll
        for (int nt = 0; nt < 8; ++nt) {
            f32x4 acc = {0.f, 0.f, 0.f, 0.f};
#pragma unroll
            for (int jc = 0; jc < 2; ++jc) {
                const bf16x8 bfr = cat8(tr_read(VS + (32 * jc + 8 * g + q) * 136 + 16 * nt + 4 * p), tr_read(VS + (32 * jc + 8 * g + 4 + q) * 136 + 16 * nt + 4 * p));
                acc = MFMA16(af[jc], bfr, acc);
            }
            u32x2 w; w.x = pk2(acc[0], acc[1]); w.y = pk2(acc[2], acc[3]);
#ifndef HL_NO_SLT
            *(u32x2*)(SLT + (size_t)(16 * nt + i16) * 128 + 16 * wid + 4 * g) = w;
#endif
        }
    }
    __syncthreads();
}

__device__ __forceinline__ void attn_prompt_item(const Args& a, int b, int qb, int kvh, unsigned char* lds) {
    const int tid = threadIdx.x, lane = tid & 63, wid = __builtin_amdgcn_readfirstlane(tid >> 6);
    bf16* KS = (bf16*)lds; bf16* VS = (bf16*)(lds + 36864);
    unsigned char* ws = a.ws;
    const bf16* QA = (const bf16*)(ws + WS_R6); const bf16* KV = (const bf16*)(ws + WS_R7); bf16* YB = (bf16*)(ws + WS_R10);
    {
        const int key = tid >> 1, half = tid & 1;
        u32x4 kw[4], vw[4];
        const bool zero = (qb == 0 && key < 128);
        const size_t row = (size_t)b * SEQ + (size_t)(qb - 1) * 128 + key;
#pragma unroll
        for (int c = 0; c < 4; ++c) {
            if (zero) { kw[c] = (u32x4){0u, 0u, 0u, 0u}; vw[c] = kw[c]; }
            else { kw[c] = *(const u32x4*)(KV + row * 256 + kvh * 64 + half * 32 + 8 * c); vw[c] = *(const u32x4*)(KV + row * 256 + 128 + kvh * 64 + half * 32 + 8 * c); }
        }
        float ss = 0.f;
#pragma unroll
        for (int c = 0; c < 4; ++c) { const float e0 = bflo(kw[c].x), e1 = bfhi(kw[c].x), e2 = bflo(kw[c].y), e3 = bfhi(kw[c].y), e4 = bflo(kw[c].z), e5 = bfhi(kw[c].z), e6 = bflo(kw[c].w), e7 = bfhi(kw[c].w);
            ss += (e0 * e0 + e1 * e1) + (e2 * e2 + e3 * e3) + (e4 * e4 + e5 * e5) + (e6 * e6 + e7 * e7); }
        ss += __shfl_xor(ss, 1);
        const float rstd = __builtin_amdgcn_rsqf(ss * (1.f / 64.f) + EPS);
        const bool wr_cache = (qb == SEQ / 128 - 1) && key >= 128;
        float* ck = a.out + O_KP + ((size_t)(b * 128 + (key - 128)) * 2 + kvh) * 64 + half * 32;
        float* cv = a.out + O_VP + ((size_t)(b * 128 + (key - 128)) * 2 + kvh) * 64 + half * 32;
#pragma unroll
        for (int c = 0; c < 4; ++c) {
            const f32x4 w0 = *(const f32x4*)(a.k_norm_w + half * 32 + 8 * c), w1 = *(const f32x4*)(a.k_norm_w + half * 32 + 8 * c + 4);
            f32x4 n0, n1;
            n0[0] = bflo(kw[c].x) * rstd * w0[0]; n0[1] = bfhi(kw[c].x) * rstd * w0[1]; n0[2] = bflo(kw[c].y) * rstd * w0[2]; n0[3] = bfhi(kw[c].y) * rstd * w0[3];
            n1[0] = bflo(kw[c].z) * rstd * w1[0]; n1[1] = bfhi(kw[c].z) * rstd * w1[1]; n1[2] = bflo(kw[c].w) * rstd * w1[2]; n1[3] = bfhi(kw[c].w) * rstd * w1[3];
            u32x4 w; w.x = pk2(n0[0], n0[1]); w.y = pk2(n0[2], n0[3]); w.z = pk2(n1[0], n1[1]); w.w = pk2(n1[2], n1[3]);
            *(u32x4*)(KS + key * 72 + half * 32 + 8 * c) = w;
            *(u32x4*)(VS + key * 72 + half * 32 + 8 * c) = vw[c];
            if (wr_cache) {
                *(f32x4*)(ck + 8 * c) = n0; *(f32x4*)(ck + 8 * c + 4) = n1;
                *(f32x4*)(cv + 8 * c) = (f32x4){bflo(vw[c].x), bfhi(vw[c].x), bflo(vw[c].y), bfhi(vw[c].y)};
                *(f32x4*)(cv + 8 * c + 4) = (f32x4){bflo(vw[c].z), bfhi(vw[c].z), bflo(vw[c].w), bfhi(vw[c].w)};
            }
        }
    }
    __syncthreads();
    const int i16 = lane & 15, g = lane >> 4, q = i16 >> 2, p = i16 & 3;
#pragma unroll 1
    for (int task = wid; task < 32; task += 8) {
        const int qt = task >> 2, g4 = task & 3, hq = kvh * 4 + g4;
        const size_t row = (size_t)b * SEQ + (size_t)qb * 128 + 16 * qt + i16;
        bf16x8 bq[2];
        {
            u32x4 qw[2]; float ss = 0.f;
#pragma unroll
            for (int c = 0; c < 2; ++c) { qw[c] = *(const u32x4*)(QA + row * 512 + hq * 64 + 32 * c + 8 * g);
                const float e0 = bflo(qw[c].x), e1 = bfhi(qw[c].x), e2 = bflo(qw[c].y), e3 = bfhi(qw[c].y), e4 = bflo(qw[c].z), e5 = bfhi(qw[c].z), e6 = bflo(qw[c].w), e7 = bfhi(qw[c].w);
                ss += (e0 * e0 + e1 * e1) + (e2 * e2 + e3 * e3) + (e4 * e4 + e5 * e5) + (e6 * e6 + e7 * e7); }
            ss += __shfl_xor(ss, 16); ss += __shfl_xor(ss, 32);
            const float rstd = __builtin_amdgcn_rsqf(ss * (1.f / 64.f) + EPS);
#pragma unroll
            for (int c = 0; c < 2; ++c) {
                const f32x4 w0 = *(const f32x4*)(a.q_norm_w + 32 * c + 8 * g), w1 = *(const f32x4*)(a.q_norm_w + 32 * c + 8 * g + 4);
                u32x4 w;
                w.x = pk2(bflo(qw[c].x) * rstd * w0[0], bfhi(qw[c].x) * rstd * w0[1]); w.y = pk2(bflo(qw[c].y) * rstd * w0[2], bfhi(qw[c].y) * rstd * w0[3]);
                w.z = pk2(bflo(qw[c].z) * rstd * w1[0], bfhi(qw[c].z) * rstd * w1[1]); w.w = pk2(bflo(qw[c].w) * rstd * w1[2], bfhi(qw[c].w) * rstd * w1[3]);
                bq[c] = __builtin_bit_cast(bf16x8, w);
            }
        }
        const int t0 = qt > 0 ? qt - 1 : 0;
        const float slope = exp2f(-(float)(hq + 1)), sink = a.sinks[hq];
        f32x4 sc[10]; float mx = -3.0e38f;
        const int qz = (qb == 0) ? -1 : 0, band0 = 16 * t0 + 4 * g, dist0 = 128 + 16 * qt + i16 - band0;
#pragma unroll
        for (int t = 0; t < 10; ++t) {
            f32x4 s = {0.f, 0.f, 0.f, 0.f};
#pragma unroll
            for (int c = 0; c < 2; ++c) s = MFMA16(*(const bf16x8*)(KS + (16 * (t0 + t) + i16) * 72 + 32 * c + 8 * g), bq[c], s);
#pragma unroll
            for (int r = 0; r < 4; ++r) {
                const int band = band0 + 16 * t + r, dist = dist0 - 16 * t - r;
                const int msk = ((dist | (127 - dist)) >> 31) | (((band - 128) >> 31) & qz);
                s[r] = s[r] * 0.125f - slope * (float)dist + __int_as_float(msk & (int)0xF149F2CAu);
                mx = fmaxf(mx, s[r]);
            }
            sc[t] = s;
            __builtin_amdgcn_sched_barrier(0);
        }
        mx = fmaxf(mx, __shfl_xor(mx, 16)); mx = fmaxf(mx, __shfl_xor(mx, 32)); mx = fmaxf(mx, sink);
        float sum = 0.f;
#pragma unroll
        for (int t = 0; t < 10; ++t)
#pragma unroll
            for (int r = 0; r < 4; ++r) { const float e = __expf(sc[t][r] - mx); sc[t][r] = e; sum += e; }
        sum += __shfl_xor(sum, 16); sum += __shfl_xor(sum, 32);
        const float inv = 1.f / (sum + __expf(sink - mx));
        bf16x8 pb[5];
#pragma unroll
        for (int ch = 0; ch < 5; ++ch) pb[ch] = pk8(sc[2 * ch], sc[2 * ch + 1]);
#pragma unroll
        for (int dt = 0; dt < 4; ++dt) {
            f32x4 acc = {0.f, 0.f, 0.f, 0.f};
#pragma unroll
            for (int ch = 0; ch < 5; ++ch) {
                const bf16x8 av = cat8(tr_read(VS + (16 * (t0 + 2 * ch) + 4 * g + q) * 72 + 16 * dt + 4 * p), tr_read(VS + (16 * (t0 + 2 * ch + 1) + 4 * g + q) * 72 + 16 * dt + 4 * p));
                acc = MFMA16(av, pb[ch], acc);
            }
            u32x2 w; w.x = pk2(acc[0] * inv, acc[1] * inv); w.y = pk2(acc[2] * inv, acc[3] * inv);
            *(u32x2*)(YB + row * 512 + hq * 64 + 16 * dt + 4 * g) = w;
            __builtin_amdgcn_sched_barrier(0);
        }
    }
    __syncthreads();
}

__device__ __forceinline__ void attn_sample_item(const Args& a, int b, unsigned char* lds) {
    const int tid = threadIdx.x;
    float* qn = (float*)lds; float* knew = (float*)(lds + 8192); float* vnew = (float*)(lds + 10240); float* sc = (float*)(lds + 12288); float* invs = (float*)(lds + 29696);
    unsigned char* ws = a.ws;
    const bf16* QA = (const bf16*)(ws + WS_R6); const bf16* KV = (const bf16*)(ws + WS_R7); bf16* YB = (bf16*)(ws + WS_R10);
    const size_t rb = (size_t)MP + (size_t)b * 4;
    {
        const int pair = tid >> 4, d4 = (tid & 15) * 4, hq = pair >> 2, t = pair & 3;
        const u32x2 w = *(const u32x2*)(QA + (rb + t) * 512 + hq * 64 + d4);
        const float e0 = bflo(w.x), e1 = bfhi(w.x), e2 = bflo(w.y), e3 = bfhi(w.y);
        float ss = (e0 * e0 + e1 * e1) + (e2 * e2 + e3 * e3);
        ss += __shfl_xor(ss, 1); ss += __shfl_xor(ss, 2); ss += __shfl_xor(ss, 4); ss += __shfl_xor(ss, 8);
        const float rstd = __builtin_amdgcn_rsqf(ss * (1.f / 64.f) + EPS);
        const f32x4 nw = *(const f32x4*)(a.q_norm_w + d4);
        *(f32x4*)(qn + pair * 64 + d4) = (f32x4){e0 * rstd * nw[0], e1 * rstd * nw[1], e2 * rstd * nw[2], e3 * rstd * nw[3]};
    }
    if (tid < 128) {
        const int t = tid >> 5, kvh = (tid >> 4) & 1, d4 = (tid & 15) * 4;
        const u32x2 w = *(const u32x2*)(KV + (rb + t) * 256 + kvh * 64 + d4);
        const float e0 = bflo(w.x), e1 = bfhi(w.x), e2 = bflo(w.y), e3 = bfhi(w.y);
        float ss = (e0 * e0 + e1 * e1) + (e2 * e2 + e3 * e3);
        ss += __shfl_xor(ss, 1); ss += __shfl_xor(ss, 2); ss += __shfl_xor(ss, 4); ss += __shfl_xor(ss, 8);
        const float rstd = __builtin_amdgcn_rsqf(ss * (1.f / 64.f) + EPS);
        const f32x4 nw = *(const f32x4*)(a.k_norm_w + d4);
        *(f32x4*)(knew + t * 128 + kvh * 64 + d4) = (f32x4){e0 * rstd * nw[0], e1 * rstd * nw[1], e2 * rstd * nw[2], e3 * rstd * nw[3]};
        const u32x2 v = *(const u32x2*)(KV + (rb + t) * 256 + 128 + kvh * 64 + d4);
        *(f32x4*)(vnew + t * 128 + kvh * 64 + d4) = (f32x4){bflo(v.x), bfhi(v.x), bflo(v.y), bfhi(v.y)};
    }
    __syncthreads();
    const float* ck = a.cache_k + (size_t)b * 16384; const float* cv = a.cache_v + (size_t)b * 16384;
    for (int idx = tid; idx < 132 * 32; idx += 512) {
        const int key = idx >> 5, pair = idx & 31, hq = pair >> 2, t = pair & 3, kvh = hq >> 2;
        const float* qp = qn + pair * 64; float dot = 0.f;
        if (key < 128) { const float* kp = ck + (key * 2 + kvh) * 64;
#pragma unroll
            for (int d = 0; d < 64; d += 4) { const f32x4 kk = *(const f32x4*)(kp + d), qq = *(const f32x4*)(qp + d); dot += (kk[0] * qq[0] + kk[1] * qq[1]) + (kk[2] * qq[2] + kk[3] * qq[3]); }
        } else { const float* kp = knew + (key - 128) * 128 + kvh * 64;
#pragma unroll
            for (int d = 0; d < 64; d += 4) { const f32x4 kk = *(const f32x4*)(kp + d), qq = *(const f32x4*)(qp + d); dot += (kk[0] * qq[0] + kk[1] * qq[1]) + (kk[2] * qq[2] + kk[3] * qq[3]); }
        }
        const int dist = key < 128 ? t + 128 - key : t - (key - 128);
        const bool valid = dist >= 0 && dist < 128;
        sc[pair * 136 + key] = valid ? dot * 0.125f - exp2f(-(float)(hq + 1)) * (float)dist : -1e30f;
    }
    __syncthreads();
    {
        const int pair = tid >> 4, l16 = tid & 15, hq = pair >> 2; const float sink = a.sinks[hq];
        float mx = -3.0e38f;
        for (int key = l16; key < 132; key += 16) mx = fmaxf(mx, sc[pair * 136 + key]);
        mx = fmaxf(mx, __shfl_xor(mx, 1)); mx = fmaxf(mx, __shfl_xor(mx, 2)); mx = fmaxf(mx, __shfl_xor(mx, 4)); mx = fmaxf(mx, __shfl_xor(mx, 8));
        mx = fmaxf(mx, sink);
        float sum = 0.f;
        for (int key = l16; key < 132; key += 16) { const float e = __expf(sc[pair * 136 + key] - mx); sc[pair * 136 + key] = e; sum += e; }
        sum += __shfl_xor(sum, 1); sum += __shfl_xor(sum, 2); sum += __shfl_xor(sum, 4); sum += __shfl_xor(sum, 8);
        if (l16 == 0) invs[pair] = 1.f / (sum + __expf(sink - mx));
    }
    __syncthreads();
    {
        const int pair = tid >> 4, d4 = (tid & 15) * 4, hq = pair >> 2, t = pair & 3, kvh = hq >> 2;
        f32x4 acc = {0.f, 0.f, 0.f, 0.f};
#pragma unroll 4
        for (int key = 0; key < 128; ++key) { const float pv = sc[pair * 136 + key]; acc += pv * *(const f32x4*)(cv + (key * 2 + kvh) * 64 + d4); }
#pragma unroll
        for (int key = 0; key < 4; ++key) { const float pv = sc[pair * 136 + 128 + key]; acc += pv * *(const f32x4*)(vnew + key * 128 + kvh * 64 + d4); }
        const float inv = invs[pair];
        u32x2 w; w.x = pk2(acc[0] * inv, acc[1] * inv); w.y = pk2(acc[2] * inv, acc[3] * inv);
        *(u32x2*)(YB + (rb + t) * 512 + hq * 64 + d4) = w;
    }
    {
        float* ok = a.out + O_KS + (size_t)b * 16384; float* ov = a.out + O_VS + (size_t)b * 16384;
        for (int i4 = tid; i4 < 4096; i4 += 512) {
            const int f = i4 * 4;
            if (f < 124 * 128) { *(f32x4*)(ok + f) = *(const f32x4*)(ck + f + 512); *(f32x4*)(ov + f) = *(const f32x4*)(cv + f + 512); }
            else { *(f32x4*)(ok + f) = *(const f32x4*)(knew + f - 124 * 128); *(f32x4*)(ov + f) = *(const f32x4*)(vnew + f - 124 * 128); }
        }
    }
    __syncthreads();
}

__device__ __forceinline__ void hgrn_scan(const Args& a) {
    unsigned char* ws = a.ws;
    unsigned* SLT = (unsigned*)(ws + WS_R0); const float* DT = (const float*)(ws + WS_DT);
    for (int e = blockIdx.x * NTHREADS + threadIdx.x; e < 4 * 4 * 128 * 64; e += gridDim.x * NTHREADS) {
        const int kp = e & 63, v = (e >> 6) & 127, h = (e >> 13) & 3, b = e >> 15;
        float s0 = 0.f, s1 = 0.f;
        for (int c0 = 0; c0 < 128; c0 += 8) {
            unsigned loc[8]; f32x2 d[8];
#pragma unroll
            for (int i = 0; i < 8; ++i) { const size_t ci = (size_t)((b * 128 + c0 + i) * 4 + h); loc[i] = SLT[(ci * 128 + v) * 64 + kp]; d[i] = *(const f32x2*)(DT + ci * 128 + 2 * kp); }
#pragma unroll
            for (int i = 0; i < 8; ++i) { const size_t ci = (size_t)((b * 128 + c0 + i) * 4 + h);
                SLT[(ci * 128 + v) * 64 + kp] = pk2(s0, s1);
                s0 = d[i][0] * s0 + bflo(loc[i]); s1 = d[i][1] * s1 + bfhi(loc[i]); }
        }
        float* o = a.out + O_SP + ((size_t)(b * 4 + h) * 128 + 2 * kp) * 128 + v;
        o[0] = s0; o[128] = s1;
    }
}

__device__ __forceinline__ void hgrn_out_item(const Args& a, int cidx, int h, unsigned char* lds) {
    const int tid = threadIdx.x, lane = tid & 63, wid = tid >> 6;
    bf16* QdS = (bf16*)lds; bf16* KxS = (bf16*)(lds + 17408); bf16* VS = (bf16*)(lds + 34816); bf16* SS = (bf16*)(lds + 52224); float* red = (float*)(lds + 87040);
    unsigned char* ws = a.ws;
    const size_t r0 = (size_t)cidx * 64;
    const float* CU = (const float*)(ws + WS_R3) + r0 * 512 + h * 128;
    const bf16* QH = (const bf16*)(ws + WS_R1) + r0 * 512 + h * 128;
    const bf16* KH = (const bf16*)(ws + WS_R2) + r0 * 512 + h * 128;
    const bf16* VH = (const bf16*)(ws + WS_R4) + r0 * 512 + h * 128;
    const bf16* OG = (const bf16*)(ws + WS_R5) + r0 * 512 + h * 128;
    bf16* YA = (bf16*)(ws + WS_R6) + r0 * 512 + h * 128;
    const bf16* SLT = (const bf16*)(ws + WS_R0) + (size_t)(cidx * 4 + h) * 16384;
#pragma unroll
    for (int i = 0; i < 2; ++i) {
        const int idx = tid + 512 * i, j = idx >> 4, k8 = (idx & 15) * 8;
        const f32x4 c0 = *(const f32x4*)(CU + (size_t)j * 512 + k8), c1 = *(const f32x4*)(CU + (size_t)j * 512 + k8 + 4);
        const u32x4 qw = *(const u32x4*)(QH + (size_t)j * 512 + k8), kw = *(const u32x4*)(KH + (size_t)j * 512 + k8);
        float e[8], ei[8];
#pragma unroll
        for (int x = 0; x < 4; ++x) { e[x] = __expf(c0[x]); e[4 + x] = __expf(c1[x]); ei[x] = __expf(-c0[x]); ei[4 + x] = __expf(-c1[x]); }
        u32x4 w;
        w.x = pk2(bflo(qw.x) * e[0], bfhi(qw.x) * e[1]); w.y = pk2(bflo(qw.y) * e[2], bfhi(qw.y) * e[3]); w.z = pk2(bflo(qw.z) * e[4], bfhi(qw.z) * e[5]); w.w = pk2(bflo(qw.w) * e[6], bfhi(qw.w) * e[7]);
        *(u32x4*)(QdS + j * 136 + k8) = w;
        w.x = pk2(bflo(kw.x) * ei[0], bfhi(kw.x) * ei[1]); w.y = pk2(bflo(kw.y) * ei[2], bfhi(kw.y) * ei[3]); w.z = pk2(bflo(kw.z) * ei[4], bfhi(kw.z) * ei[5]); w.w = pk2(bflo(kw.w) * ei[6], bfhi(kw.w) * ei[7]);
        *(u32x4*)(KxS + j * 136 + k8) = w;
        *(u32x4*)(VS + j * 136 + k8) = *(const u32x4*)(VH + (size_t)j * 512 + k8);
    }
#pragma unroll
    for (int i = 0; i < 4; ++i) { const int idx = tid + 512 * i, v = idx >> 4, c8 = (idx & 15) * 8; *(u32x4*)(SS + v * 136 + c8) = *(const u32x4*)(SLT + (size_t)v * 128 + c8); }
    __syncthreads();
    const int i16 = lane & 15, g = lane >> 4, q = i16 >> 2, p = i16 & 3, tt = wid & 3, vh = wid >> 2;
    bf16x8 bq[4];
#pragma unroll
    for (int kc = 0; kc < 4; ++kc) bq[kc] = *(const bf16x8*)(QdS + (16 * tt + i16) * 136 + 32 * kc + 8 * g);
    f32x4 sc[4];
#pragma unroll
    for (int jt = 0; jt < 4; ++jt) {
        f32x4 s = {0.f, 0.f, 0.f, 0.f};
        if (jt <= tt) {
#pragma unroll
            for (int kc = 0; kc < 4; ++kc) s = MFMA16(*(const bf16x8*)(KxS + (16 * jt + i16) * 136 + 32 * kc + 8 * g), bq[kc], s);
            if (jt == tt) {
#pragma unroll
                for (int r = 0; r < 4; ++r) s[r] = (4 * g + r > i16) ? 0.f : s[r];
            }
        }
        sc[jt] = s;
    }
    bf16x8 pb[2];
    pb[0] = pk8(sc[0], sc[1]); pb[1] = pk8(sc[2], sc[3]);
    f32x4 acc[4]; float ss = 0.f;
#pragma unroll
    for (int vt = 0; vt < 4; ++vt) {
        const int v0 = vh * 64 + 16 * vt;
        f32x4 c = {0.f, 0.f, 0.f, 0.f};
#pragma unroll
        for (int kc = 0; kc < 4; ++kc) c = MFMA16(*(const bf16x8*)(SS + (v0 + i16) * 136 + 32 * kc + 8 * g), bq[kc], c);
#pragma unroll
        for (int jc = 0; jc < 2; ++jc) {
            const bf16x8 av = cat8(tr_read(VS + (32 * jc + 4 * g + q) * 136 + v0 + 4 * p), tr_read(VS + (32 * jc + 16 + 4 * g + q) * 136 + v0 + 4 * p));
            c = MFMA16(av, pb[jc], c);
        }
        acc[vt] = c; ss += (c[0] * c[0] + c[1] * c[1]) + (c[2] * c[2] + c[3] * c[3]);
    }
    ss += __shfl_xor(ss, 16); ss += __shfl_xor(ss, 32);
    if (g == 0) red[vh * 64 + 16 * tt + i16] = ss;
    __syncthreads();
    const float rstd = __builtin_amdgcn_rsqf((red[16 * tt + i16] + red[64 + 16 * tt + i16]) * (1.f / 128.f) + EPS);
#pragma unroll
    for (int vt = 0; vt < 4; ++vt) {
        const int col = vh * 64 + 16 * vt + 4 * g; const size_t t = (size_t)(16 * tt + i16);
        const u32x2 ow = *(const u32x2*)(OG + t * 512 + col); const f32x4 nw = *(const f32x4*)(a.hgrn_norm_w + h * 128 + col);
        u32x2 w; w.x = pk2(acc[vt][0] * rstd * nw[0] * bflo(ow.x), acc[vt][1] * rstd * nw[1] * bfhi(ow.x)); w.y = pk2(acc[vt][2] * rstd * nw[2] * bflo(ow.y), acc[vt][3] * rstd * nw[3] * bfhi(ow.y));
        *(u32x2*)(YA + t * 512 + col) = w;
    }
    __syncthreads();
}

__device__ __forceinline__ void hgrn_sample_item(const Args& a, int b, int h, unsigned char* lds) {
    const int tid = threadIdx.x, lane = tid & 63, wid = tid >> 6;
    float* part = (float*)lds;
    float* wsum = (float*)(lds + 32768);
    unsigned char* ws = a.ws;
    const int v4 = (tid & 31) * 4, kg = tid >> 5;
    const float* S0 = a.state_hgrn + ((size_t)(b * 4 + h) * 128 + 8 * kg) * 128 + v4;
    float* S1 = a.out + O_SS + ((size_t)(b * 4 + h) * 128 + 8 * kg) * 128 + v4;
    f32x4 S[8];
#pragma unroll
    for (int e = 0; e < 8; ++e) S[e] = *(const f32x4*)(S0 + e * 128);
    const size_t rb = (size_t)MP + (size_t)b * 4;
#pragma unroll
    for (int t = 0; t < 4; ++t) {
        const size_t off = (rb + t) * 512 + h * 128;
        const f32x4 g0 = *(const f32x4*)((const float*)(ws + WS_R3) + off + 8 * kg), g1 = *(const f32x4*)((const float*)(ws + WS_R3) + off + 8 * kg + 4);
        const u32x4 kw = *(const u32x4*)((const bf16*)(ws + WS_R2) + off + 8 * kg), qw = *(const u32x4*)((const bf16*)(ws + WS_R1) + off + 8 * kg);
        const u32x2 vw = *(const u32x2*)((const bf16*)(ws + WS_R4) + off + v4);
        const f32x4 vv = {bflo(vw.x), bfhi(vw.x), bflo(vw.y), bfhi(vw.y)};
        const float f[8] = {__expf(g0[0]), __expf(g0[1]), __expf(g0[2]), __expf(g0[3]), __expf(g1[0]), __expf(g1[1]), __expf(g1[2]), __expf(g1[3])};
        const float kk[8] = {bflo(kw.x), bfhi(kw.x), bflo(kw.y), bfhi(kw.y), bflo(kw.z), bfhi(kw.z), bflo(kw.w), bfhi(kw.w)};
        const float qq[8] = {bflo(qw.x), bfhi(qw.x), bflo(qw.y), bfhi(qw.y), bflo(qw.z), bfhi(qw.z), bflo(qw.w), bfhi(qw.w)};
        f32x4 po = {0.f, 0.f, 0.f, 0.f};
#pragma unroll
        for (int e = 0; e < 8; ++e) { S[e] = f[e] * S[e] + kk[e] * vv; po += qq[e] * S[e]; }
        *(f32x4*)(part + (t * 16 + kg) * 128 + v4) = po;
    }
#pragma unroll
    for (int e = 0; e < 8; ++e) *(f32x4*)(S1 + e * 128) = S[e];
    __syncthreads();
    const int t = tid >> 7, v = tid & 127;
    float o = 0.f;
#pragma unroll
    for (int k = 0; k < 16; ++k) o += part[(t * 16 + k) * 128 + v];
    const float s2 = wave_sum(o * o);
    if (lane == 0) wsum[wid] = s2;
    __syncthreads();
    const float rstd = __builtin_amdgcn_rsqf((wsum[2 * t] + wsum[2 * t + 1]) * (1.f / 128.f) + EPS);
    const size_t off = (rb + t) * 512 + h * 128 + v;
    const float y = o * rstd * a.hgrn_norm_w[h * 128 + v] * bf2f(((const bf16*)(ws + WS_R5))[off]);
    ((bf16*)(ws + WS_R6))[off] = (bf16)(pk2(y, 0.f) & 0xffffu);
    __syncthreads();
}

__global__ void __launch_bounds__(NTHREADS, 2) mk_fwd(Args a) {
    extern __shared__ __attribute__((aligned(16))) unsigned char lds[];
    cg::grid_group grid = cg::this_grid();
    const int lo = a.ph_lo, hi = a.ph_hi, G = gridDim.x, bid = blockIdx.x;
    unsigned char* ws = a.ws;
    LAS unsigned char* ring = (LAS unsigned char*)(LAS void*)lds;
#ifdef PH_MASK
#define IN(k) (((PH_MASK) >> (k)) & 1)
#else
#define IN(k) (lo <= (k) && (k) < hi)
#endif
#define SEAM(k) do { if (IN(k) && IN((k) + 1)) grid.sync(); } while (0)

    if (IN(0)) { p0_prologue(a, lds); }
    SEAM(0);
    if (IN(1)) {
        pg8::Gemm g{(const bf16*)(ws + WS_R0), (const bf16*)(ws + WS_W1T), MT, PW, 1024}; pg8::StaticOrder S; S.init(MT, PW, G, bid);
        pg8::EpiProj E{(bf16*)(ws + WS_R1), (bf16*)(ws + WS_R2), (bf16*)(ws + WS_R4), (bf16*)(ws + WS_R5), (bf16*)(ws + WS_R6), (bf16*)(ws + WS_R7), (bf16*)(ws + WS_R8), (bf16*)(ws + WS_R9),
                       (float*)(ws + WS_R3), (const float*)(ws + WS_LBV)};
        pg8::gemm_phase<pg8::EpiProj, pg8::StaticOrder, true, true>(ring, g, S, E);
    }
    SEAM(1);
    if (IN(2)) {
        constexpr int N_LOC = 512 * 4, N_ATT = 4 * 64 * 2, N_SAT = DEC_B;
        for (int it = bid; it < N_LOC + N_ATT + N_SAT; it += G) {
#ifndef P2_SEL
#define P2_SEL 7
#endif
            if (it < N_LOC) { if (P2_SEL & 1) hgrn_local_item(a, it >> 2, it & 3, lds); }
            else if (it < N_LOC + N_ATT) { const int r = it - N_LOC; if (P2_SEL & 2) attn_prompt_item(a, r >> 7, (r >> 1) & 63, r & 1, lds); }
            else { if (P2_SEL & 4) attn_sample_item(a, it - N_LOC - N_ATT, lds); }
        }
    }
    SEAM(2);
    if (IN(3)) { hgrn_scan(a); }
    SEAM(3);
    if (IN(4)) {
        constexpr int N_OUT = 512 * 4, N_SMP = DEC_B * 4;
        for (int it = bid; it < N_OUT + N_SMP; it += G) {
            if (it < N_OUT) hgrn_out_item(a, it >> 2, it & 3, lds);
            else { const int r = it - N_OUT; hgrn_sample_item(a, r >> 2, r & 3, lds); }
        }
    }
    SEAM(4);
    if (IN(5)) {
        pg8::StaticOrder S; S.init(MT, 1024, G, bid);
        { pg8::Gemm g{(const bf16*)(ws + WS_R6), (const bf16*)(ws + WS_WOH), MT, 1024, 512};
          pg8::EpiGate<false> E{(const bf16*)(ws + WS_R8), nullptr, (bf16*)(ws + WS_R1)};
          pg8::gemm_phase<pg8::EpiGate<false>, pg8::StaticOrder, true, true>(ring, g, S, E); }
        { pg8::Gemm g{(const bf16*)(ws + WS_R10), (const bf16*)(ws + WS_WOA), MT, 1024, 512};
          pg8::EpiGate<true> E{(const bf16*)(ws + WS_R9), (const bf16*)(ws + WS_R1), (bf16*)(ws + WS_R3)};
          pg8::gemm_phase<pg8::EpiGate<true>, pg8::StaticOrder, true, true>(ring, g, S, E); }
    }
    SEAM(5);
    if (IN(6)) {
        pg8::Gemm g{(const bf16*)(ws + WS_R3), (const bf16*)(ws + WS_WOUT), MT, 1024, 1024}; pg8::StaticOrder S; S.init(MT, 1024, G, bid);
        pg8::EpiRes1 E{a.x_prompt, a.x_sample, a.out + O_Y, (bf16*)(ws + WS_R8), (float*)(ws + WS_SUMSQ)};
        pg8::gemm_phase<pg8::EpiRes1, pg8::StaticOrder, true, true>(ring, g, S, E);
    }
    SEAM(6);
    if (IN(7)) {
        pg8::Gemm g{(const bf16*)(ws + WS_R8), (const bf16*)(ws + WS_WGU), MT, 2 * DFF, 1024}; pg8::StaticOrder S; S.init(MT, 2 * DFF, G, bid);
        pg8::EpiFfn E{(const float*)(ws + WS_SUMSQ), (bf16*)(ws + WS_R0)};
        pg8::gemm_phase<pg8::EpiFfn, pg8::StaticOrder, true, true>(ring, g, S, E);
    }
    SEAM(7);
    if (IN(8)) {
        pg8::Gemm g{(const bf16*)(ws + WS_R0), (const bf16*)(ws + WS_WD), MT, 1024, DFF}; pg8::StaticOrder S; S.init(MT, 1024, G, bid);
        pg8::EpiRes2 E{a.out + O_Y};
        pg8::gemm_phase<pg8::EpiRes2, pg8::StaticOrder, true, true>(ring, g, S, E);
    }
#undef IN
#undef SEAM
}

__global__ void dump_ws(const unsigned short* w, float* o, size_t n, size_t tot) {
    for (size_t i = blockIdx.x * (size_t)blockDim.x + threadIdx.x; i < n; i += (size_t)gridDim.x * blockDim.x) { unsigned s = 0; for (size_t j = i; j < tot; j += n) s += w[j]; o[i] = (float)s; }
}
constexpr int N_PHASES = 9;
extern "C" void kernel_launch(void* const* d_in, const int* in_sizes, int n_in, void* d_out, int out_size, void* d_ws, size_t ws_size, hipStream_t stream) {
    static int grid = 0;
    if (grid == 0) {
        if (n_in != 19 || (size_t)out_size != O_END || ws_size < WS_END) { fprintf(stderr, "kernel_launch: unexpected shapes: n_in %d out %d ws %zu (need %zu)\n", n_in, out_size, ws_size, (size_t)WS_END); grid = -1; return; }
        int dev = 0, cus = 0, per_cu = 0;
        if (hipGetDevice(&dev) != hipSuccess || hipDeviceGetAttribute(&cus, hipDeviceAttributeMultiprocessorCount, dev) != hipSuccess) { grid = -1; return; }
        if (hipFuncSetAttribute((const void*)mk_fwd, hipFuncAttributeMaxDynamicSharedMemorySize, LDS_BYTES) != hipSuccess) { fprintf(stderr, "kernel_launch: hipFuncSetAttribute failed\n"); grid = -1; return; }
        if (hipOccupancyMaxActiveBlocksPerMultiprocessor(&per_cu, (const void*)mk_fwd, NTHREADS, LDS_BYTES) != hipSuccess || per_cu < 1) { fprintf(stderr, "kernel_launch: occupancy query says %d\n", per_cu); (void)hipGetLastError(); grid = -1; return; }
        grid = cus;
    }
    if (grid < 0) return;
    Args a{};
    const float** ap = (const float**)&a;
    for (int i = 0; i < 19; ++i) ap[i] = (const float*)d_in[i];
    a.out = (float*)d_out; a.ws = (unsigned char*)d_ws;
#if MK_N_LAUNCHES == 1
    a.ph_lo = 0; a.ph_hi = N_PHASES;
    void* args[] = {&a};
    hipError_t e = hipLaunchCooperativeKernel((const void*)mk_fwd, dim3(grid), dim3(NTHREADS), args, LDS_BYTES, stream);
    if (e != hipSuccess) fprintf(stderr, "kernel_launch: cooperative launch failed: %s (grid %d)\n", hipGetErrorString(e), grid);
#else
#ifndef PROBE_K
#define PROBE_K 8
#endif
    for (int ph = 0; ph <= PROBE_K; ++ph) {
        a.ph_lo = ph; a.ph_hi = ph + 1;
        hipLaunchKernelGGL(mk_fwd, dim3(grid), dim3(NTHREADS), LDS_BYTES, stream, a);
    }
#if PROBE_K < 8
    hipLaunchKernelGGL(dump_ws, dim3(2048), dim3(256), 0, stream, (const unsigned short*)d_ws, (float*)d_out, (size_t)out_size, (size_t)(WS_END / 2));
#endif
#endif
}
```

```cpp
#include <hip/hip_runtime.h>
#include <hip/hip_cooperative_groups.h>
#include <cstdio>
#include <cstdint>
namespace cg = cooperative_groups;

#ifndef MK_N_LAUNCHES
#define MK_N_LAUNCHES 1
#endif

constexpr int DM = 1024, SEQ = 8192, NBATCH = 4, MP = NBATCH * SEQ, DEC_B = 128, DEC_T = 4, MS = DEC_B * DEC_T, MT = MP + MS;
constexpr int PW = 4864, DFF = 2816;
constexpr float EPS = 1e-6f;

constexpr size_t UB = (size_t)MT * 512 * 2;
constexpr size_t WS_W1T = 0;
constexpr size_t WS_WOH = WS_W1T + (size_t)PW * DM * 2;
constexpr size_t WS_WOA = WS_WOH + (size_t)1024 * 512 * 2;
constexpr size_t WS_WOUT = WS_WOA + (size_t)1024 * 512 * 2;
constexpr size_t WS_WGU = WS_WOUT + (size_t)1024 * 1024 * 2;
constexpr size_t WS_WD = WS_WGU + (size_t)2 * DFF * DM * 2;
constexpr size_t WS_MISC = WS_WD + (size_t)DM * DFF * 2;
constexpr size_t WS_LBV = WS_MISC;
constexpr size_t WS_SUMSQ = WS_MISC + 4096;
constexpr size_t WS_DT = WS_MISC + 512 * 1024;
constexpr size_t WS_BAR = WS_MISC + 1536 * 1024;
constexpr size_t WS_R0 = (size_t)32 << 20;
constexpr size_t WS_R1 = WS_R0 + 2 * UB;
constexpr size_t WS_R2 = WS_R1 + UB;
constexpr size_t WS_R3 = WS_R2 + UB;
constexpr size_t WS_R4 = WS_R3 + 2 * UB;
constexpr size_t WS_R5 = WS_R4 + UB;
constexpr size_t WS_R6 = WS_R5 + UB;
constexpr size_t WS_R7 = WS_R6 + UB;
constexpr size_t WS_R8 = WS_R7 + UB / 2;
constexpr size_t WS_R9 = WS_R8 + 2 * UB;
constexpr size_t WS_R10 = WS_R9 + 2 * UB;
constexpr size_t WS_YAS = WS_R10 + UB;
constexpr size_t WS_END = WS_YAS + (size_t)MS * 512 * 2;
static_assert(WS_MISC == ((size_t)30 << 20) && WS_END <= ((size_t)512 << 20), "d_ws map");
static_assert((size_t)MT * DFF * 2 <= 6 * UB, "ACT fits R0..R3");

constexpr size_t O_Y = 0;
constexpr size_t O_SP = (size_t)MT * DM;
constexpr size_t O_KP = O_SP + (size_t)4 * 4 * 128 * 128;
constexpr size_t O_VP = O_KP + (size_t)4 * 128 * 128;
constexpr size_t O_SS = O_VP + (size_t)4 * 128 * 128;
constexpr size_t O_KS = O_SS + (size_t)128 * 4 * 128 * 128;
constexpr size_t O_VS = O_KS + (size_t)128 * 128 * 128;
constexpr size_t O_END = O_VS + (size_t)128 * 128 * 128;

constexpr int LDS_BYTES = 131072;
constexpr int LDS_TOTAL = LDS_BYTES + 256;
constexpr int NTHREADS = 512;

#define LAS __attribute__((address_space(3)))
typedef unsigned short bf16;
typedef float f32x4 __attribute__((ext_vector_type(4)));
typedef float f32x2 __attribute__((ext_vector_type(2)));
typedef unsigned u32x4 __attribute__((ext_vector_type(4)));
typedef unsigned u32x2 __attribute__((ext_vector_type(2)));
typedef short bf16x8 __attribute__((ext_vector_type(8)));
typedef short s16x4 __attribute__((ext_vector_type(4)));

__device__ __forceinline__ float bf2f(unsigned short u) { return __uint_as_float((unsigned)u << 16); }
__device__ __forceinline__ float bflo(unsigned w) { return __uint_as_float(w << 16); }
__device__ __forceinline__ float bfhi(unsigned w) { return __uint_as_float(w & 0xffff0000u); }
typedef __bf16 bf16x2_t __attribute__((ext_vector_type(2)));
__device__ __forceinline__ unsigned pk2(float lo, float hi) { f32x2 v = {lo, hi}; bf16x2_t b = __builtin_convertvector(v, bf16x2_t); return __builtin_bit_cast(unsigned, b); }
__device__ __forceinline__ float sigm(float x) { return __builtin_amdgcn_rcpf(1.f + __expf(-x)); }
__device__ __forceinline__ s16x4 tr_read(const bf16* p) {
    return __builtin_bit_cast(s16x4, __builtin_amdgcn_ds_read_tr16_b64_v4i16((LAS s16x4*)(LAS void*)p));
}
__device__ __forceinline__ bf16x8 cat8(s16x4 a, s16x4 b) { return (bf16x8){a[0], a[1], a[2], a[3], b[0], b[1], b[2], b[3]}; }
__device__ __forceinline__ bf16x8 pk8(f32x4 a, f32x4 b) { u32x4 w; w.x = pk2(a[0], a[1]); w.y = pk2(a[2], a[3]); w.z = pk2(b[0], b[1]); w.w = pk2(b[2], b[3]); return __builtin_bit_cast(bf16x8, w); }
#define MFMA16(a, b, c) __builtin_amdgcn_mfma_f32_16x16x32_bf16((a), (b), (c), 0, 0, 0)

namespace pg8 {
#define PG8_LAS __attribute__((address_space(3)))
typedef unsigned short bf16_t;
typedef short bf16x8 __attribute__((ext_vector_type(8)));
typedef float f32x4 __attribute__((ext_vector_type(4)));
typedef unsigned u32x4 __attribute__((ext_vector_type(4)));
constexpr int BM = 256, BK = 64, HALF = 128, HTB = HALF * BK * 2  , STAGE_BYTES = 8 * HTB, NXCD = 8, WGM = 8;

__host__ __device__ __forceinline__ int lds_byte(int r, int c) { const int st = (r >> 4) * 2 + (c >> 5), rr = r & 15, cc = c & 31, ob = rr * 64 + cc * 2; return st * 1024 + (ob ^ (((ob >> 9) & 1) << 5)); }
__host__ __device__ __forceinline__ void stage_rc(int b, int& R, int& C) { const int st = b / 1024, sb = b % 1024, swz = sb ^ (((sb >> 9) & 1) << 5); R = (st >> 1) * 16 + swz / 64; C = (st & 1) * 32 + (swz % 64) / 2; }
__host__ __device__ __forceinline__ int perm32(int rho) { const int n = rho >> 4, i = rho & 15; return 8 * (i >> 2) + 4 * n + (i & 3); }

struct Unit { int pm, pn; };
struct Gemm { const bf16_t* A; const bf16_t* Bt; int M, N, K; const bf16_t* A2; int lda, kmid; };

struct StaticOrder {
    int nM, nN, nwg, G, c;
    __host__ __device__ void init(int M, int N, int G_, int c_) { nM = M / BM; nN = N / BM; nwg = nM * nN; G = G_; c = c_; }
    __host__ __device__ bool next(int i, Unit& u) const {
        const long L = (long)i * G + c; if (L >= nwg) return false;
        int wgid = (int)L; { const int q = nwg / NXCD, r = nwg % NXCD, xcd = wgid % NXCD, off = wgid / NXCD; wgid = (xcd < r ? xcd * (q + 1) : r * (q + 1) + (xcd - r) * q) + off; }
        const int nig = WGM * nN, gid = wgid / nig, fm = gid * WGM, gsz = (nM - fm) < WGM ? (nM - fm) : WGM;
        u.pm = fm + ((wgid % nig) % gsz); u.pn = (wgid % nig) / gsz; return true;
    }
    __device__ __forceinline__ void a_ready(const Unit&) const {}
    __device__ __forceinline__ void done(const Unit&) const {}
};

__device__ __forceinline__ unsigned cvt_pk_bf16(float lo, float hi) { unsigned r; asm volatile("v_cvt_pk_bf16_f32 %0, %1, %2" : "=v"(r) : "v"(lo), "v"(hi)); return r; }

struct EpiProj {
    static constexpr bool PERM = true, AFTER_DRAIN = false; static constexpr size_t MTR = 33280;
    bf16_t *QH, *KH, *VH, *OG, *QA, *KV, *GA, *GB; float* GH; const float* lbv;
    __device__ __forceinline__ void operator()(const f32x4 (&acc)[2][2][4][2], const Unit& u, int wr, int wc, int fr, int fq) const {
        const int pn = u.pn; int mode, ld, cb; bf16_t* dst; float sc = 1.f; bool hm = false;
        if (pn < 2)        { mode = 1; dst = QH; ld = 512;  cb = pn * 256; sc = 0.08838834764831845f; hm = true; }
        else if (pn < 4)   { mode = 3; dst = KH; ld = 512;  cb = (pn - 2) * 256; hm = true; }
        else if (pn < 6)   { mode = 0; dst = VH; ld = 512;  cb = (pn - 4) * 256; hm = true; }
        else if (pn < 8)   { mode = 1; dst = OG; ld = 512;  cb = (pn - 6) * 256; hm = true; }
        else if (pn < 10)  { mode = 0; dst = QA; ld = 512;  cb = (pn - 8) * 256; }
        else if (pn == 10) { mode = 0; dst = KV; ld = 256;  cb = 0; }
        else               { mode = 4; dst = GA; ld = 1024; cb = (pn - 11) * 128; }
        const int row0 = u.pm * BM + wr * 64 + fr, col0 = cb + wc * 32 + 8 * fq;
        if (mode == 4) {
#pragma unroll
            for (int ai = 0; ai < 2; ++ai)
#pragma unroll
                for (int m = 0; m < 4; ++m) {
                    const size_t off = (size_t)(row0 + ai * HALF + m * 16) * 1024 + col0;
                    f32x4 r0, r1, s0, s1;
#pragma unroll
                    for (int i = 0; i < 4; ++i) {
                        const float ea0 = __expf(-acc[ai][0][m][0][i]), eb0 = __expf(-acc[ai][1][m][0][i]), ea1 = __expf(-acc[ai][0][m][1][i]), eb1 = __expf(-acc[ai][1][m][1][i]);
                        s0[i] = __builtin_amdgcn_rcpf(1.f + eb0); s1[i] = __builtin_amdgcn_rcpf(1.f + eb1);
                        r0[i] = (1.f + eb0) * __builtin_amdgcn_rcpf(1.f + ea0); r1[i] = (1.f + eb1) * __builtin_amdgcn_rcpf(1.f + ea1);
                    }
                    u32x4 w; w.x = pk2(r0[0], r0[1]); w.y = pk2(r0[2], r0[3]); w.z = pk2(r1[0], r1[1]); w.w = pk2(r1[2], r1[3]);
                    *(u32x4*)(GA + off) = w;
                    w.x = pk2(s0[0], s0[1]); w.y = pk2(s0[2], s0[3]); w.z = pk2(s1[0], s1[1]); w.w = pk2(s1[2], s1[3]);
                    *(u32x4*)(GB + off) = w;
                }
            return;
        }
#pragma unroll
        for (int bj = 0; bj < 2; ++bj) {
            const int col = col0 + bj * HALF;
            f32x4 l0 = {0.f, 0.f, 0.f, 0.f}, l1 = l0;
            if (mode == 3) { l0 = *(const f32x4*)(lbv + col); l1 = *(const f32x4*)(lbv + col + 4); }
#pragma unroll
            for (int ai = 0; ai < 2; ++ai)
#pragma unroll
                for (int m = 0; m < 4; ++m) {
                    const size_t row = (size_t)(row0 + ai * HALF + m * 16);
                    f32x4 v0 = acc[ai][bj][m][0], v1 = acc[ai][bj][m][1];
                    if (mode == 1) {
#pragma unroll
                        for (int i = 0; i < 4; ++i) { v0[i] = v0[i] * sigm(v0[i]) * sc; v1[i] = v1[i] * sigm(v1[i]) * sc; }
                    } else if (mode == 2) {
#pragma unroll
                        for (int i = 0; i < 4; ++i) { v0[i] = sigm(v0[i]); v1[i] = sigm(v1[i]); }
                    } else if (mode == 3) {
                        f32x4 g0, g1;
#pragma unroll
                        for (int i = 0; i < 4; ++i) {
                            const float f0 = l0[i] + (1.f - l0[i]) * sigm(v0[i]), f1 = l1[i] + (1.f - l1[i]) * sigm(v1[i]);
                            g0[i] = __logf(f0); g1[i] = __logf(f1); v0[i] = 1.f - f0; v1[i] = 1.f - f1;
                        }
                        float* gp = GH + ((size_t)(col >> 7) * MTR + row) * 128 + (col & 127); *(f32x4*)gp = g0; *(f32x4*)(gp + 4) = g1;
                    }
                    u32x4 w; w.x = pk2(v0[0], v0[1]); w.y = pk2(v0[2], v0[3]); w.z = pk2(v1[0], v1[1]); w.w = pk2(v1[2], v1[3]);
                    *(u32x4*)(dst + (hm ? ((size_t)(col >> 7) * MTR + row) * 128 + (col & 127) : row * ld + col)) = w;
                }
        }
    }
};
template <bool ADD> struct EpiGate {
    static constexpr bool PERM = true, AFTER_DRAIN = false;
    const bf16_t* gate; const bf16_t* T; bf16_t* O;
    __device__ __forceinline__ void operator()(const f32x4 (&acc)[2][2][4][2], const Unit& u, int wr, int wc, int fr, int fq) const {
        const int row0 = u.pm * BM + wr * 64 + fr, col0 = u.pn * BM + wc * 32 + 8 * fq;
#pragma unroll
        for (int ai = 0; ai < 2; ++ai)
#pragma unroll
            for (int m = 0; m < 4; ++m)
#pragma unroll
                for (int bj = 0; bj < 2; ++bj) {
                    const size_t off = (size_t)(row0 + ai * HALF + m * 16) * 1024 + col0 + bj * HALF;
                    const u32x4 gw = *(const u32x4*)(gate + off);
                    f32x4 v0 = acc[ai][bj][m][0], v1 = acc[ai][bj][m][1];
                    v0[0] *= bflo(gw.x); v0[1] *= bfhi(gw.x); v0[2] *= bflo(gw.y); v0[3] *= bfhi(gw.y);
                    v1[0] *= bflo(gw.z); v1[1] *= bfhi(gw.z); v1[2] *= bflo(gw.w); v1[3] *= bfhi(gw.w);
                    if (ADD) { const u32x4 tw = *(const u32x4*)(T + off);
                        v0[0] += bflo(tw.x); v0[1] += bfhi(tw.x); v0[2] += bflo(tw.y); v0[3] += bfhi(tw.y);
                        v1[0] += bflo(tw.z); v1[1] += bfhi(tw.z); v1[2] += bflo(tw.w); v1[3] += bfhi(tw.w); }
                    u32x4 w; w.x = pk2(v0[0], v0[1]); w.y = pk2(v0[2], v0[3]); w.z = pk2(v1[0], v1[1]); w.w = pk2(v1[2], v1[3]);
                    *(u32x4*)(O + off) = w;
                }
    }
};
struct EpiMerge {
    static constexpr bool PERM = true, AFTER_DRAIN = false;
    const bf16_t* GA; const bf16_t* GB; bf16_t* O;
    __device__ __forceinline__ void mid(f32x4 (&acc)[2][2][4][2], const Unit& u, int wr, int wc, int fr, int fq) const {
        int lane_ = (int)(threadIdx.x & 63); asm volatile("" : "+v"(lane_));
        const int row0 = u.pm * BM + wr * 64 + (lane_ & 15), col0 = u.pn * BM + wc * 32 + 8 * (lane_ >> 4);
#pragma unroll
        for (int ai = 0; ai < 2; ++ai)
#pragma unroll
            for (int m = 0; m < 4; ++m)
#pragma unroll
                for (int bj = 0; bj < 2; ++bj) {
                    const u32x4 a = *(const u32x4*)(GA + (size_t)(row0 + ai * HALF + m * 16) * 1024 + col0 + bj * HALF);
                    acc[ai][bj][m][0] = acc[ai][bj][m][0] * (f32x4){bflo(a.x), bfhi(a.x), bflo(a.y), bfhi(a.y)};
                    acc[ai][bj][m][1] = acc[ai][bj][m][1] * (f32x4){bflo(a.z), bfhi(a.z), bflo(a.w), bfhi(a.w)};
                    if (m == 3 && bj == 1) __builtin_amdgcn_sched_barrier(0);
                }
    }
    __device__ __forceinline__ void operator()(const f32x4 (&acc)[2][2][4][2], const Unit& u, int wr, int wc, int fr, int fq) const {
        const int row0 = u.pm * BM + wr * 64 + fr, col0 = u.pn * BM + wc * 32 + 8 * fq;
#pragma unroll
        for (int ai = 0; ai < 2; ++ai)
#pragma unroll
            for (int m = 0; m < 4; ++m)
#pragma unroll
                for (int bj = 0; bj < 2; ++bj) {
                    const size_t off = (size_t)(row0 + ai * HALF + m * 16) * 1024 + col0 + bj * HALF;
                    const u32x4 gw = *(const u32x4*)(GB + off);
                    const f32x4 v0 = acc[ai][bj][m][0], v1 = acc[ai][bj][m][1];
                    u32x4 w; w.x = pk2(v0[0] * bflo(gw.x), v0[1] * bfhi(gw.x)); w.y = pk2(v0[2] * bflo(gw.y), v0[3] * bfhi(gw.y));
                    w.z = pk2(v1[0] * bflo(gw.z), v1[1] * bfhi(gw.z)); w.w = pk2(v1[2] * bflo(gw.w), v1[3] * bfhi(gw.w));
                    *(u32x4*)(O + off) = w;
                }
    }
};
struct EpiRes1 {
    static constexpr bool PERM = true, AFTER_DRAIN = false;
    const float* xp; bf16_t* X1B; float* sumsq;
    __device__ __forceinline__ void operator()(const f32x4 (&acc)[2][2][4][2], const Unit& u, int wr, int wc, int fr, int fq) const {
        const int row0 = u.pm * BM + wr * 64 + fr, col0 = u.pn * BM + wc * 32 + 8 * fq;
#pragma unroll
        for (int ai = 0; ai < 2; ++ai)
#pragma unroll
            for (int m = 0; m < 4; ++m) {
                const int row = row0 + ai * HALF + m * 16; float ss = 0.f;
#pragma unroll
                for (int bj = 0; bj < 2; ++bj) {
                    const size_t off = (size_t)row * 1024 + col0 + bj * HALF;
                    const f32x4 v0 = acc[ai][bj][m][0] + *(const f32x4*)(xp + off), v1 = acc[ai][bj][m][1] + *(const f32x4*)(xp + off + 4);
                    ss += (v0[0] * v0[0] + v0[1] * v0[1]) + (v0[2] * v0[2] + v0[3] * v0[3]) + (v1[0] * v1[0] + v1[1] * v1[1]) + (v1[2] * v1[2] + v1[3] * v1[3]);
                    u32x4 w; w.x = pk2(v0[0], v0[1]); w.y = pk2(v0[2], v0[3]); w.z = pk2(v1[0], v1[1]); w.w = pk2(v1[2], v1[3]);
                    *(u32x4*)(X1B + off) = w;
                }
                ss += __shfl_xor(ss, 16); ss += __shfl_xor(ss, 32);
                if (fq == 0) atomicAdd(sumsq + row, ss);
            }
    }
};
struct EpiFfn {
    static constexpr bool PERM = true, AFTER_DRAIN = false;
    const float* sumsq; bf16_t* ACT;
    __device__ __forceinline__ void operator()(const f32x4 (&acc)[2][2][4][2], const Unit& u, int wr, int wc, int fr, int fq) const {
        const int row0 = u.pm * BM + wr * 64 + fr, col0 = u.pn * HALF + wc * 32 + 8 * fq;
#pragma unroll
        for (int ai = 0; ai < 2; ++ai)
#pragma unroll
            for (int m = 0; m < 4; ++m) {
                const int row = row0 + ai * HALF + m * 16;
                const float r = __builtin_amdgcn_rsqf(sumsq[row] * (1.f / 1024.f) + 1e-6f);
                f32x4 o0, o1;
#pragma unroll
                for (int i = 0; i < 4; ++i) {
                    const float g0 = acc[ai][0][m][0][i] * r, g1 = acc[ai][0][m][1][i] * r;
                    o0[i] = g0 * sigm(g0) * (acc[ai][1][m][0][i] * r); o1[i] = g1 * sigm(g1) * (acc[ai][1][m][1][i] * r);
                }
                u32x4 w; w.x = pk2(o0[0], o0[1]); w.y = pk2(o0[2], o0[3]); w.z = pk2(o1[0], o1[1]); w.w = pk2(o1[2], o1[3]);
                *(u32x4*)(ACT + (size_t)row * 2816 + col0) = w;
            }
    }
};
struct EpiRes2 {
    static constexpr bool PERM = true, AFTER_DRAIN = false;
    const bf16_t* X1B; float* out;
    __device__ __forceinline__ void operator()(const f32x4 (&acc)[2][2][4][2], const Unit& u, int wr, int wc, int fr, int fq) const {
        const int row0 = u.pm * BM + wr * 64 + fr, col0 = u.pn * BM + wc * 32 + 8 * fq;
#pragma unroll
        for (int ai = 0; ai < 2; ++ai)
#pragma unroll
            for (int m = 0; m < 4; ++m)
#pragma unroll
                for (int bj = 0; bj < 2; ++bj) {
                    const size_t off = (size_t)(row0 + ai * HALF + m * 16) * 1024 + col0 + bj * HALF;
                    const u32x4 xw = *(const u32x4*)(X1B + off);
                    const f32x4 v0 = acc[ai][bj][m][0] + (f32x4){bflo(xw.x), bfhi(xw.x), bflo(xw.y), bfhi(xw.y)}, v1 = acc[ai][bj][m][1] + (f32x4){bflo(xw.z), bfhi(xw.z), bflo(xw.w), bfhi(xw.w)};
                    *(f32x4*)(out + off) = v0; *(f32x4*)(out + off + 4) = v1;
                }
    }
};
template <class Epi, class Sched, bool ALIGN_EPI = false, bool SP2 = false, bool MID = false>
__device__ __forceinline__ void gemm_phase(PG8_LAS unsigned char* lds, const Gemm g, const Sched& S, const Epi& E) {
    const int tid = threadIdx.x, wid = __builtin_amdgcn_readfirstlane(tid >> 6), lane = tid & 63, wr = wid >> 2, wc = wid & 3, fr = lane & 15, fq = lane >> 4;
    const int K = g.K, nt = K / BK;
    const int lda = g.lda ? g.lda : K, kmid = g.kmid ? g.kmid : nt;
    unsigned voffA[2], voffB[2];
#pragma unroll
    for (int i = 0; i < 2; ++i) { int R, C; stage_rc(tid * 16 + i * 8192, R, C); const int Rb = Epi::PERM ? ((R & ~31) + perm32(R & 31)) : R;
        voffA[i] = (unsigned)(R * lda + C) * 2u; voffB[i] = (unsigned)(Rb * K + C) * 2u; }
    const size_t kstep = (size_t)(BK * 2);
    const size_t hstepA = (size_t)HALF * lda * 2, hstepB = (size_t)HALF * K * 2;
    const size_t tstepA = 2 * hstepA, tstepB = 2 * hstepB;
    const long dA2 = g.A2 ? ((const char*)g.A2 - (const char*)g.A) - (long)kmid * (long)kstep : 0l;
    const unsigned ldsw = (unsigned)wid * 1024u;
    const int aoff = lds_byte(wr * 64 + fr, fq * 8), boff = lds_byte(wc * 32 + fr, fq * 8);
#define PG8_SA(b, h) (((b) * 2 + (h)) * HTB)
#define PG8_SB(b, h) ((4 + (b) * 2 + (h)) * HTB)
#define PG8_STAGE(bufoff, gbase, voff) do { _Pragma("unroll") for (int _i = 0; _i < 2; ++_i) \
        __builtin_amdgcn_global_load_lds((const unsigned*)((const char*)(gbase) + (voff)[_i]), (PG8_LAS unsigned*)(lds + (bufoff) + ldsw + _i * 8192), 16, 0, 0); } while (0)
#define PG8_LDA(dst, b, h) do { _Pragma("unroll") for (int m = 0; m < 4; ++m) _Pragma("unroll") for (int k = 0; k < 2; ++k) dst[m][k] = *(const PG8_LAS bf16x8*)(lds + PG8_SA(b, h) + aoff + m * 2048 + k * 1024); } while (0)
#define PG8_LDB(dst, b, h) do { _Pragma("unroll") for (int n = 0; n < 2; ++n) _Pragma("unroll") for (int k = 0; k < 2; ++k) dst[n][k] = *(const PG8_LAS bf16x8*)(lds + PG8_SB(b, h) + boff + n * 2048 + k * 1024); } while (0)
#define PG8_MMA(ai, bj, At, Bt) do { __builtin_amdgcn_s_setprio(1); _Pragma("unroll") for (int m = 0; m < 4; ++m) _Pragma("unroll") for (int n = 0; n < 2; ++n) _Pragma("unroll") for (int k = 0; k < 2; ++k) \
        acc[ai][bj][m][n] = __builtin_amdgcn_mfma_f32_16x16x32_bf16(Bt[n][k], At[m][k], acc[ai][bj][m][n], 0, 0, 0); __builtin_amdgcn_s_setprio(0); } while (0)
#define PG8_WAIT_V(n) asm volatile("s_waitcnt vmcnt(" #n ")" ::: "memory")
#define PG8_WAIT_L(n) asm volatile("s_waitcnt lgkmcnt(" #n ")" ::: "memory")
#define PG8_BAR __builtin_amdgcn_s_barrier()
#define PG8_SCHED __builtin_amdgcn_sched_barrier(0)
    Unit cur, nxt; int ui = 0;
    if (!S.next(0, cur)) return;
    f32x4 acc[2][2][4][2];
#pragma unroll
    for (int a = 0; a < 2; ++a)
#pragma unroll
        for (int b = 0; b < 2; ++b)
#pragma unroll
            for (int m = 0; m < 4; ++m)
#pragma unroll
                for (int n = 0; n < 2; ++n) acc[a][b][m][n] = (f32x4){0.f, 0.f, 0.f, 0.f};
    bf16x8 At[4][2], B0[2][2], B1[2][2];
    const char* cA = (const char*)g.A + (size_t)cur.pm * tstepA; const char* cB = (const char*)g.Bt + (size_t)cur.pn * tstepB;
    S.a_ready(cur);
    if constexpr (SP2) {
        PG8_STAGE(PG8_SB(0, 0), cB, voffB); PG8_STAGE(PG8_SB(0, 1), cB + hstepB, voffB); PG8_STAGE(PG8_SA(0, 0), cA, voffA); PG8_STAGE(PG8_SA(0, 1), cA + hstepA, voffA);
        if (wr == 1) PG8_BAR;
        PG8_WAIT_V(2); PG8_BAR;
        PG8_STAGE(PG8_SB(1, 0), cB + kstep, voffB); PG8_STAGE(PG8_SA(1, 0), cA + kstep, voffA); PG8_STAGE(PG8_SB(1, 1), cB + hstepB + kstep, voffB);
        PG8_WAIT_V(6); PG8_BAR;
    } else {
        PG8_STAGE(PG8_SB(0, 0), cB, voffB); PG8_STAGE(PG8_SA(0, 0), cA, voffA); PG8_STAGE(PG8_SB(0, 1), cB + hstepB, voffB); PG8_STAGE(PG8_SA(0, 1), cA + hstepA, voffA);
        if (wr == 1) PG8_BAR;
        PG8_WAIT_V(4); PG8_BAR;
        PG8_STAGE(PG8_SB(1, 0), cB + kstep, voffB); PG8_STAGE(PG8_SA(1, 0), cA + kstep, voffA); PG8_STAGE(PG8_SB(1, 1), cB + hstepB + kstep, voffB);
        PG8_WAIT_V(6); PG8_BAR;
    }
    for (;;) {
        const bool has_next = S.next(ui + 1, nxt);
        const char* nA = has_next ? (const char*)g.A + (size_t)nxt.pm * tstepA : cA; const char* nB = has_next ? (const char*)g.Bt + (size_t)nxt.pn * tstepB : cB;
        for (int t = 0; t < nt; t += 2) {
            const bool last = (t == nt - 2);
            const char* a1 = cA + ((t + 1 < kmid) ? 0l : dA2) + (size_t)(t + 1) * kstep;
            const char* a2 = last ? nA : cA + ((t + 2 < kmid) ? 0l : dA2) + (size_t)(t + 2) * kstep; const char* b2 = last ? nB : cB + (size_t)(t + 2) * kstep;
            if constexpr (MID) { if (t == kmid) E.mid(acc, cur, wr, wc, fr, fq); }
            const char* a3 = a2 + kstep; const char* b3 = b2 + kstep;
            if (last && has_next) S.a_ready(nxt);
            if constexpr (SP2) {
            PG8_LDB(B0, 0, 0); PG8_LDB(B1, 0, 1); PG8_SCHED; PG8_LDA(At, 0, 0); PG8_STAGE(PG8_SA(1, 1), a1 + hstepA, voffA);
            PG8_WAIT_V(8); PG8_WAIT_L(0); PG8_BAR; PG8_MMA(0, 0, At, B0); PG8_MMA(0, 1, At, B1); PG8_BAR; PG8_SCHED;
            PG8_LDA(At, 0, 1); PG8_STAGE(PG8_SB(0, 0), b2, voffB); PG8_STAGE(PG8_SB(0, 1), b2 + hstepB, voffB); PG8_STAGE(PG8_SA(0, 0), a2, voffA);
            PG8_WAIT_V(8); PG8_WAIT_L(0); PG8_BAR; PG8_MMA(1, 0, At, B0); PG8_MMA(1, 1, At, B1); PG8_BAR; PG8_SCHED;
            PG8_LDB(B0, 1, 0); PG8_LDB(B1, 1, 1); PG8_SCHED; PG8_LDA(At, 1, 0); PG8_STAGE(PG8_SA(0, 1), a2 + hstepA, voffA);
            PG8_WAIT_V(8); PG8_WAIT_L(0); PG8_BAR; PG8_MMA(0, 0, At, B0); PG8_MMA(0, 1, At, B1); PG8_BAR; PG8_SCHED;
            PG8_LDA(At, 1, 1); PG8_STAGE(PG8_SB(1, 0), b3, voffB); PG8_STAGE(PG8_SB(1, 1), b3 + hstepB, voffB); PG8_STAGE(PG8_SA(1, 0), a3, voffA);
            PG8_WAIT_V(8); PG8_WAIT_L(0); PG8_BAR; PG8_MMA(1, 0, At, B0); PG8_MMA(1, 1, At, B1); PG8_BAR; PG8_SCHED;
            } else {
            PG8_LDB(B0, 0, 0); PG8_SCHED; PG8_LDA(At, 0, 0); PG8_STAGE(PG8_SA(1, 1), a1 + hstepA, voffA);
            PG8_WAIT_L(8); PG8_BAR; PG8_WAIT_L(0); PG8_MMA(0, 0, At, B0); PG8_BAR; PG8_SCHED;
            PG8_LDB(B1, 0, 1); PG8_STAGE(PG8_SB(0, 0), b2, voffB);
            PG8_BAR; PG8_WAIT_L(0); PG8_MMA(0, 1, At, B1); PG8_BAR;
            PG8_LDA(At, 0, 1); PG8_STAGE(PG8_SA(0, 0), a2, voffA);
            PG8_BAR; PG8_WAIT_L(0); PG8_MMA(1, 0, At, B0); PG8_BAR; PG8_SCHED;
            PG8_STAGE(PG8_SB(0, 1), b2 + hstepB, voffB);
            PG8_WAIT_V(6); PG8_BAR; PG8_MMA(1, 1, At, B1); PG8_BAR;
            PG8_LDB(B0, 1, 0); PG8_SCHED; PG8_LDA(At, 1, 0); PG8_STAGE(PG8_SA(0, 1), a2 + hstepA, voffA);
            PG8_WAIT_L(8); PG8_BAR; PG8_WAIT_L(0); PG8_MMA(0, 0, At, B0); PG8_BAR; PG8_SCHED;
            PG8_LDB(B1, 1, 1); PG8_STAGE(PG8_SB(1, 0), b3, voffB);
            PG8_BAR; PG8_WAIT_L(0); PG8_MMA(0, 1, At, B1); PG8_BAR;
            PG8_LDA(At, 1, 1); PG8_STAGE(PG8_SA(1, 0), a3, voffA);
            PG8_BAR; PG8_WAIT_L(0); PG8_MMA(1, 0, At, B0); PG8_BAR; PG8_SCHED;
            PG8_STAGE(PG8_SB(1, 1), b3 + hstepB, voffB);
            PG8_WAIT_V(6); PG8_BAR; PG8_MMA(1, 1, At, B1); PG8_BAR;
            }
        }
        if constexpr (ALIGN_EPI) { if (wr == 0) PG8_BAR; }
        if constexpr (!Epi::AFTER_DRAIN) { E(acc, cur, wr, wc, fr, fq); S.done(cur); }
        if (!has_next) break;
#pragma unroll
        for (int a = 0; a < 2; ++a)
#pragma unroll
            for (int b = 0; b < 2; ++b)
#pragma unroll
                for (int m = 0; m < 4; ++m)
#pragma unroll
                    for (int n = 0; n < 2; ++n) acc[a][b][m][n] = (f32x4){0.f, 0.f, 0.f, 0.f};
        cur = nxt; cA = nA; cB = nB; ++ui;
        if constexpr (ALIGN_EPI) { if (wr == 1) PG8_BAR; }
    }
    PG8_WAIT_V(0);
    if constexpr (!ALIGN_EPI) { if (wr == 0) PG8_BAR; }
    PG8_BAR;
    if constexpr (Epi::AFTER_DRAIN) { E.fused(acc, cur, wr, wc, fr, fq, lds, wid, lane); S.done(cur); }
#undef PG8_SA
#undef PG8_SB
#undef PG8_STAGE
#undef PG8_LDA
#undef PG8_LDB
#undef PG8_MMA
#undef PG8_WAIT_V
#undef PG8_WAIT_L
#undef PG8_BAR
#undef PG8_SCHED
}
}

struct Args {
    const float *x_prompt, *x_sample, *state_hgrn, *cache_k, *cache_v, *norm1_w, *w_in, *lb_logits, *hgrn_norm_w, *q_norm_w, *k_norm_w, *sinks,
                *w_o_hgrn, *w_o_attn, *w_out, *norm2_w, *w_ffn_gate, *w_ffn_up, *w_ffn_down;
    float* out; unsigned char* ws; int ph_lo, ph_hi;
};

__device__ __forceinline__ float wave_sum(float v) {
#pragma unroll
    for (int o = 1; o < 64; o <<= 1) v += __shfl_xor(v, o);
    return v;
}

__device__ __forceinline__ void p0_transpose_item(const float* __restrict__ W, int ldw, int K, bf16* WT, int k0, int n0, int drow0, const float* __restrict__ ks, LAS float* scr, int lane, int kofs = 0) {
    float wv[32];
#pragma unroll
    for (int i = 0; i < 32; ++i) wv[i] = W[(size_t)(k0 + 2 * i + (lane >> 5)) * ldw + n0 + (lane & 31)];
#pragma unroll
    for (int i = 0; i < 32; ++i) { const int kk = 2 * i + (lane >> 5); const float s = ks ? ks[k0 + kk] : 1.f; scr[kk * 33 + (lane & 31)] = wv[i] * s; }
    asm volatile("s_waitcnt lgkmcnt(0)" ::: "memory");
    const int c = lane & 7;
#pragma unroll
    for (int j = 0; j < 4; ++j) { const int n = (lane >> 3) + 8 * j; const LAS float* s = scr + (8 * c) * 33 + n;
        u32x4 o; o.x = pk2(s[0 * 33], s[1 * 33]); o.y = pk2(s[2 * 33], s[3 * 33]); o.z = pk2(s[4 * 33], s[5 * 33]); o.w = pk2(s[6 * 33], s[7 * 33]);
        *(u32x4*)(WT + (size_t)(drow0 + n) * K + kofs + k0 + 8 * c) = o; }
    asm volatile("s_waitcnt lgkmcnt(0)" ::: "memory");
}

constexpr int P0_I1 = 16 * 152, P0_NITEMS = 16 * 152 + 2 * 8 * 32 + 16 * 32 + 2 * 16 * 88 + 44 * 32;
__device__ __forceinline__ void p0_weights(const Args& a, unsigned char* lds, int it_lo, int it_hi, int widx, int nwork) {
    const int tid = threadIdx.x, lane = tid & 63, wave = tid >> 6;
    LAS float* scr = (LAS float*)(LAS void*)(lds + wave * 16384);
    unsigned char* ws = a.ws;
    constexpr int I1 = 16 * 152, I2 = 8 * 32, I4 = 16 * 32, I5 = 16 * 88;
    for (int it = it_lo + widx; it < it_hi; it += nwork) {
        int r = it;
        if (r < I1) { const int n0 = 32 * (r % 152);
            const int dr = n0 < 2816 ? n0 : (n0 < 3840 ? 2816 + ((n0 - 2816) >> 7) * 256 + ((n0 - 2816) & 127) : 2816 + ((n0 - 3840) >> 7) * 256 + 128 + ((n0 - 3840) & 127));
            p0_transpose_item(a.w_in, PW, 1024, (bf16*)(ws + WS_W1T), 64 * (r / 152), n0, dr, a.norm1_w, scr, lane); continue; } r -= I1;
        if (r < I2) { p0_transpose_item(a.w_o_hgrn, 1024, 1024, (bf16*)(ws + WS_WOH), 64 * (r / 32), 32 * (r % 32), 32 * (r % 32), nullptr, scr, lane, 0); continue; } r -= I2;
        if (r < I2) { p0_transpose_item(a.w_o_attn, 1024, 1024, (bf16*)(ws + WS_WOH), 64 * (r / 32), 32 * (r % 32), 32 * (r % 32), nullptr, scr, lane, 512); continue; } r -= I2;
        if (r < I4) { p0_transpose_item(a.w_out, 1024, 1024, (bf16*)(ws + WS_WOUT), 64 * (r / 32), 32 * (r % 32), 32 * (r % 32), nullptr, scr, lane); continue; } r -= I4;
        if (r < I5) { const int n0 = 32 * (r % 88); p0_transpose_item(a.w_ffn_gate, DFF, 1024, (bf16*)(ws + WS_WGU), 64 * (r / 88), n0, (n0 >> 7) * 256 + (n0 & 127), a.norm2_w, scr, lane); continue; } r -= I5;
        if (r < I5) { const int n0 = 32 * (r % 88); p0_transpose_item(a.w_ffn_up, DFF, 1024, (bf16*)(ws + WS_WGU), 64 * (r / 88), n0, (n0 >> 7) * 256 + 128 + (n0 & 127), a.norm2_w, scr, lane); continue; } r -= I5;
        p0_transpose_item(a.w_ffn_down, 1024, DFF, (bf16*)(ws + WS_WD), 64 * (r / 32), 32 * (r % 32), 32 * (r % 32), nullptr, scr, lane);
    }
}
__device__ __forceinline__ void p0_prologue(const Args& a, unsigned char* lds, int w_hi) {
    const int tid = threadIdx.x, lane = tid & 63, wave = tid >> 6;
    const int gw = blockIdx.x * 8 + wave, NGW = gridDim.x * 8;
    unsigned char* ws = a.ws;
    p0_weights(a, lds, 0, w_hi, gw, NGW);
    bf16* XB = (bf16*)(ws + WS_R0);
    for (int m = gw; m < MT; m += 2 * NGW) {
        const int m1 = m + NGW; const bool has1 = m1 < MT;
        const float* xrow0 = (m < MP) ? a.x_prompt + (size_t)m * 1024 : a.x_sample + (size_t)(m - MP) * 1024;
        const float* xrow1 = !has1 ? xrow0 : (m1 < MP) ? a.x_prompt + (size_t)m1 * 1024 : a.x_sample + (size_t)(m1 - MP) * 1024;
        const f32x4* xr0 = (const f32x4*)xrow0 + lane; const f32x4* xr1 = (const f32x4*)xrow1 + lane;
        f32x4 v[4], u[4]; float s0 = 0.f, s1 = 0.f;
#pragma unroll
        for (int j = 0; j < 4; ++j) { v[j] = xr0[64 * j]; u[j] = xr1[64 * j]; }
#pragma unroll
        for (int j = 0; j < 4; ++j) { s0 += (v[j][0] * v[j][0] + v[j][1] * v[j][1]) + (v[j][2] * v[j][2] + v[j][3] * v[j][3]); s1 += (u[j][0] * u[j][0] + u[j][1] * u[j][1]) + (u[j][2] * u[j][2] + u[j][3] * u[j][3]); }
        const float r0 = __builtin_amdgcn_rsqf(wave_sum(s0) * (1.f / 1024.f) + EPS), r1 = __builtin_amdgcn_rsqf(wave_sum(s1) * (1.f / 1024.f) + EPS);
        u32x2* o0 = (u32x2*)(XB + (size_t)m * 1024) + lane; u32x2* o1 = (u32x2*)(XB + (size_t)m1 * 1024) + lane;
#pragma unroll
        for (int j = 0; j < 4; ++j) { u32x2 w; w.x = pk2(v[j][0] * r0, v[j][1] * r0); w.y = pk2(v[j][2] * r0, v[j][3] * r0); o0[64 * j] = w; }
        if (has1) {
#pragma unroll
            for (int j = 0; j < 4; ++j) { u32x2 w; w.x = pk2(u[j][0] * r1, u[j][1] * r1); w.y = pk2(u[j][2] * r1, u[j][3] * r1); o1[64 * j] = w; }
        }
    }
    float* sumsq = (float*)(ws + WS_SUMSQ);
    for (int i = blockIdx.x * NTHREADS + tid; i < MT; i += gridDim.x * NTHREADS) sumsq[i] = 0.f;
    if (blockIdx.x == 0) { float* lbv = (float*)(ws + WS_LBV); lbv[tid] = sigm(a.lb_logits[tid] - a.lb_logits[512 + tid]); }
}

__device__ __forceinline__ void hgrn_local_phase(const Args& a, unsigned char* lds) {
    const int tid = threadIdx.x, lane = tid & 63, wid = tid >> 6, G = gridDim.x;
    float* cumS = (float*)lds; float* segT = (float*)(lds + 32768); bf16* KdS = (bf16*)(lds + 34816); bf16* VS = (bf16*)(lds + 52224);
    unsigned char* ws = a.ws;
    constexpr int N_LOC = 512 * 4;
    f32x4 gr[4]; u32x4 vr[2];
    int it = blockIdx.x;
#define HL_LOAD(IT) do { const size_t r0_ = (size_t)((IT) >> 2) * 64; const int h_ = (IT) & 3; \
        const size_t ho_ = ((size_t)h_ * MT + r0_) * 128; const float* G_ = (const float*)(ws + WS_R3) + ho_; const bf16* V_ = (const bf16*)(ws + WS_R4) + ho_; \
        _Pragma("unroll") for (int i = 0; i < 4; ++i) { const int idx = tid + 512 * i; gr[i] = *(const f32x4*)(G_ + 4 * idx); } \
        _Pragma("unroll") for (int i = 0; i < 2; ++i) { const int idx = tid + 512 * i; vr[i] = *(const u32x4*)(V_ + 8 * idx); } } while (0)
    if (it < N_LOC) HL_LOAD(it);
    for (; it < N_LOC; it += G) {
        const int cidx = it >> 2, h = it & 3;
        const size_t r0 = (size_t)cidx * 64;
        float* Gp = (float*)(ws + WS_R3) + ((size_t)h * MT + r0) * 128;
#pragma unroll
        for (int i = 0; i < 4; ++i) { const int idx = tid + 512 * i, j = idx >> 5, k4 = (idx & 31) * 4; *(f32x4*)(cumS + j * 128 + k4) = gr[i]; }
        __syncthreads();
        {
            const int k = tid & 127, seg = tid >> 7; float v[16]; float run = 0.f;
#pragma unroll
            for (int i = 0; i < 16; ++i) { run += cumS[(seg * 16 + i) * 128 + k]; v[i] = run; }
            segT[seg * 128 + k] = run;
            __syncthreads();
            float off = 0.f;
#pragma unroll
            for (int s = 0; s < 3; ++s) off += (s < seg) ? segT[s * 128 + k] : 0.f;
#pragma unroll
            for (int i = 0; i < 16; ++i) cumS[(seg * 16 + i) * 128 + k] = v[i] + off;
        }
        __syncthreads();
#pragma unroll
        for (int i = 0; i < 4; ++i) { const int idx = tid + 512 * i; *(f32x4*)(Gp + 4 * idx) = *(const f32x4*)(cumS + 4 * idx); }
        if (tid < 128) ((float*)(ws + WS_DT))[(size_t)(cidx * 4 + h) * 128 + tid] = __expf(cumS[63 * 128 + tid]);
#pragma unroll
        for (int i = 0; i < 2; ++i) {
            const int idx = tid + 512 * i, j = idx >> 4, k8 = (idx & 15) * 8;
            const f32x4 c0 = *(const f32x4*)(cumS + j * 128 + k8), c1 = *(const f32x4*)(cumS + j * 128 + k8 + 4);
            const f32x4 z4 = {0.f, 0.f, 0.f, 0.f};
            const f32x4 p0 = j ? *(const f32x4*)(cumS + (j - 1) * 128 + k8) : z4, p1 = j ? *(const f32x4*)(cumS + (j - 1) * 128 + k8 + 4) : z4;
            const f32x4 l0 = *(const f32x4*)(cumS + 63 * 128 + k8), l1 = *(const f32x4*)(cumS + 63 * 128 + k8 + 4);
            float kk[8];
#pragma unroll
            for (int x = 0; x < 4; ++x) { kk[x] = 1.f - __expf(c0[x] - p0[x]); kk[4 + x] = 1.f - __expf(c1[x] - p1[x]); }
            u32x4 w;
            w.x = pk2(kk[0] * __expf(l0[0] - c0[0]), kk[1] * __expf(l0[1] - c0[1]));
            w.y = pk2(kk[2] * __expf(l0[2] - c0[2]), kk[3] * __expf(l0[3] - c0[3]));
            w.z = pk2(kk[4] * __expf(l1[0] - c1[0]), kk[5] * __expf(l1[1] - c1[1]));
            w.w = pk2(kk[6] * __expf(l1[2] - c1[2]), kk[7] * __expf(l1[3] - c1[3]));
            *(u32x4*)(KdS + j * 136 + k8) = w;
            *(u32x4*)(VS + j * 136 + k8) = vr[i];
        }
        __syncthreads();
        if (it + G < N_LOC) HL_LOAD(it + G);
        {
            const int i16 = lane & 15, g = lane >> 4, q = i16 >> 2, p = i16 & 3;
            bf16x8 af[2];
#pragma unroll
            for (int jc = 0; jc < 2; ++jc) af[jc] = cat8(tr_read(KdS + (32 * jc + 8 * g + q) * 136 + 16 * wid + 4 * p), tr_read(KdS + (32 * jc + 8 * g + 4 + q) * 136 + 16 * wid + 4 * p));
            bf16* SLT = (bf16*)(ws + WS_R0) + (size_t)(cidx * 4 + h) * 16384;
#pragma unroll
            for (int nt = 0; nt < 8; ++nt) {
                f32x4 acc = {0.f, 0.f, 0.f, 0.f};
#pragma unroll
                for (int jc = 0; jc < 2; ++jc) {
                    const bf16x8 bfr = cat8(tr_read(VS + (32 * jc + 8 * g + q) * 136 + 16 * nt + 4 * p), tr_read(VS + (32 * jc + 8 * g + 4 + q) * 136 + 16 * nt + 4 * p));
                    acc = MFMA16(af[jc], bfr, acc);
                }
                u32x2 w; w.x = pk2(acc[0], acc[1]); w.y = pk2(acc[2], acc[3]);
                *(u32x2*)(SLT + (size_t)(16 * nt + i16) * 128 + 16 * wid + 4 * g) = w;
            }
        }
        __syncthreads();
    }
#undef HL_LOAD
}

__device__ __forceinline__ void attn_prompt_item(const Args& a, int b, int qb, int kvh, unsigned char* lds) {
    const int tid = threadIdx.x, lane = tid & 63, wid = __builtin_amdgcn_readfirstlane(tid >> 6);
    bf16* KS = (bf16*)lds; bf16* VS = (bf16*)(lds + 36864);
    unsigned char* ws = a.ws;
    const bf16* QA = (const bf16*)(ws + WS_R6); const bf16* KV = (const bf16*)(ws + WS_R7); bf16* YB = (bf16*)(ws + WS_R10);
    {
        const int key = tid >> 1, half = tid & 1;
        u32x4 kw[4], vw[4];
        const bool zero = (qb == 0 && key < 128);
        const size_t row = (size_t)b * SEQ + (size_t)(qb - 1) * 128 + key;
#pragma unroll
        for (int c = 0; c < 4; ++c) {
            if (zero) { kw[c] = (u32x4){0u, 0u, 0u, 0u}; vw[c] = kw[c]; }
            else { kw[c] = *(const u32x4*)(KV + row * 256 + kvh * 64 + half * 32 + 8 * c); vw[c] = *(const u32x4*)(KV + row * 256 + 128 + kvh * 64 + half * 32 + 8 * c); }
        }
        float ss = 0.f;
#pragma unroll
        for (int c = 0; c < 4; ++c) { const float e0 = bflo(kw[c].x), e1 = bfhi(kw[c].x), e2 = bflo(kw[c].y), e3 = bfhi(kw[c].y), e4 = bflo(kw[c].z), e5 = bfhi(kw[c].z), e6 = bflo(kw[c].w), e7 = bfhi(kw[c].w);
            ss += (e0 * e0 + e1 * e1) + (e2 * e2 + e3 * e3) + (e4 * e4 + e5 * e5) + (e6 * e6 + e7 * e7); }
        ss += __shfl_xor(ss, 1);
        const float rstd = __builtin_amdgcn_rsqf(ss * (1.f / 64.f) + EPS);
        const bool wr_cache = (qb == SEQ / 128 - 1) && key >= 128;
        float* ck = a.out + O_KP + ((size_t)(b * 128 + (key - 128)) * 2 + kvh) * 64 + half * 32;
        float* cv = a.out + O_VP + ((size_t)(b * 128 + (key - 128)) * 2 + kvh) * 64 + half * 32;
#pragma unroll
        for (int c = 0; c < 4; ++c) {
            const f32x4 w0 = *(const f32x4*)(a.k_norm_w + half * 32 + 8 * c), w1 = *(const f32x4*)(a.k_norm_w + half * 32 + 8 * c + 4);
            f32x4 n0, n1;
            n0[0] = bflo(kw[c].x) * rstd * w0[0]; n0[1] = bfhi(kw[c].x) * rstd * w0[1]; n0[2] = bflo(kw[c].y) * rstd * w0[2]; n0[3] = bfhi(kw[c].y) * rstd * w0[3];
            n1[0] = bflo(kw[c].z) * rstd * w1[0]; n1[1] = bfhi(kw[c].z) * rstd * w1[1]; n1[2] = bflo(kw[c].w) * rstd * w1[2]; n1[3] = bfhi(kw[c].w) * rstd * w1[3];
            u32x4 w; w.x = pk2(n0[0], n0[1]); w.y = pk2(n0[2], n0[3]); w.z = pk2(n1[0], n1[1]); w.w = pk2(n1[2], n1[3]);
            *(u32x4*)(KS + key * 72 + half * 32 + 8 * c) = w;
            *(u32x4*)(VS + key * 72 + half * 32 + 8 * c) = vw[c];
            if (wr_cache) {
                *(f32x4*)(ck + 8 * c) = n0; *(f32x4*)(ck + 8 * c + 4) = n1;
                *(f32x4*)(cv + 8 * c) = (f32x4){bflo(vw[c].x), bfhi(vw[c].x), bflo(vw[c].y), bfhi(vw[c].y)};
                *(f32x4*)(cv + 8 * c + 4) = (f32x4){bflo(vw[c].z), bfhi(vw[c].z), bflo(vw[c].w), bfhi(vw[c].w)};
            }
        }
    }
    __syncthreads();
    const int i16 = lane & 15, g = lane >> 4, q = i16 >> 2, p = i16 & 3;
    const int qt = wid, t0 = qt > 0 ? qt - 1 : 0;
    const size_t row = (size_t)b * SEQ + (size_t)qb * 128 + 16 * qt + i16;
    f32x4 dl2[10];
    {
        const int qz = (qb == 0) ? -1 : 0, band0 = 16 * t0 + 4 * g, dist0 = 128 + 16 * qt + i16 - band0;
#pragma unroll
        for (int t = 0; t < 10; ++t)
#pragma unroll
            for (int r = 0; r < 4; ++r) {
                const int band = band0 + 16 * t + r, dist = dist0 - 16 * t - r;
                const int msk = ((dist | (127 - dist)) >> 31) | (((band - 128) >> 31) & qz);
                dl2[t][r] = msk ? 1e30f : (float)dist * 1.4426950408889634f;
            }
    }
    u32x4 qnx[2];
    qnx[0] = *(const u32x4*)(QA + row * 512 + kvh * 256 + 8 * g); qnx[1] = *(const u32x4*)(QA + row * 512 + kvh * 256 + 32 + 8 * g);
#pragma unroll 1
    for (int g4 = 0; g4 < 4; ++g4) {
        asm volatile("" ::: "memory");
        const int hq = kvh * 4 + g4;
        bf16x8 bq[2];
        {
            u32x4 qw[2]; float ss = 0.f;
            qw[0] = qnx[0]; qw[1] = qnx[1];
            if (g4 < 3) { qnx[0] = *(const u32x4*)(QA + row * 512 + (hq + 1) * 64 + 8 * g); qnx[1] = *(const u32x4*)(QA + row * 512 + (hq + 1) * 64 + 32 + 8 * g); }
#pragma unroll
            for (int c = 0; c < 2; ++c) {
                const float e0 = bflo(qw[c].x), e1 = bfhi(qw[c].x), e2 = bflo(qw[c].y), e3 = bfhi(qw[c].y), e4 = bflo(qw[c].z), e5 = bfhi(qw[c].z), e6 = bflo(qw[c].w), e7 = bfhi(qw[c].w);
                ss += (e0 * e0 + e1 * e1) + (e2 * e2 + e3 * e3) + (e4 * e4 + e5 * e5) + (e6 * e6 + e7 * e7); }
            ss += __shfl_xor(ss, 16); ss += __shfl_xor(ss, 32);
            const float rstd = __builtin_amdgcn_rsqf(ss * (1.f / 64.f) + EPS);
#pragma unroll
            for (int c = 0; c < 2; ++c) {
                const f32x4 w0 = *(const f32x4*)(a.q_norm_w + 32 * c + 8 * g), w1 = *(const f32x4*)(a.q_norm_w + 32 * c + 8 * g + 4);
                u32x4 w;
                w.x = pk2(bflo(qw[c].x) * rstd * w0[0], bfhi(qw[c].x) * rstd * w0[1]); w.y = pk2(bflo(qw[c].y) * rstd * w0[2], bfhi(qw[c].y) * rstd * w0[3]);
                w.z = pk2(bflo(qw[c].z) * rstd * w1[0], bfhi(qw[c].z) * rstd * w1[1]); w.w = pk2(bflo(qw[c].w) * rstd * w1[2], bfhi(qw[c].w) * rstd * w1[3]);
                bq[c] = __builtin_bit_cast(bf16x8, w);
            }
        }
        const float nslope = -exp2f(-(float)(hq + 1)), sink2 = a.sinks[hq] * 1.4426950408889634f;
        f32x4 sc[10]; float mx = -3.0e38f;
#pragma unroll
        for (int t = 0; t < 10; ++t) {
            f32x4 s = {0.f, 0.f, 0.f, 0.f};
#pragma unroll
            for (int c = 0; c < 2; ++c) s = MFMA16(*(const bf16x8*)(KS + (16 * (t0 + t) + i16) * 72 + 32 * c + 8 * g), bq[c], s);
#pragma unroll
            for (int r = 0; r < 4; ++r) { s[r] = fmaf(s[r], 0.125f * 1.4426950408889634f, nslope * dl2[t][r]); mx = fmaxf(mx, s[r]); }
            sc[t] = s;
        }
        mx = fmaxf(mx, __shfl_xor(mx, 16)); mx = fmaxf(mx, __shfl_xor(mx, 32)); mx = fmaxf(mx, sink2);
        float sum = 0.f;
#pragma unroll
        for (int t = 0; t < 10; ++t)
#pragma unroll
            for (int r = 0; r < 4; ++r) { const float e = __builtin_amdgcn_exp2f(sc[t][r] - mx); sc[t][r] = e; sum += e; }
        sum += __shfl_xor(sum, 16); sum += __shfl_xor(sum, 32);
        const float inv = 1.f / (sum + __builtin_amdgcn_exp2f(sink2 - mx));
        bf16x8 pb[5];
#pragma unroll
        for (int ch = 0; ch < 5; ++ch) pb[ch] = pk8(sc[2 * ch], sc[2 * ch + 1]);
#pragma unroll
        for (int dt = 0; dt < 4; ++dt) {
            f32x4 acc = {0.f, 0.f, 0.f, 0.f};
#pragma unroll
            for (int ch = 0; ch < 5; ++ch) {
                const bf16x8 av = cat8(tr_read(VS + (16 * (t0 + 2 * ch) + 4 * g + q) * 72 + 16 * dt + 4 * p), tr_read(VS + (16 * (t0 + 2 * ch + 1) + 4 * g + q) * 72 + 16 * dt + 4 * p));
                acc = MFMA16(av, pb[ch], acc);
            }
            u32x2 w; w.x = pk2(acc[0] * inv, acc[1] * inv); w.y = pk2(acc[2] * inv, acc[3] * inv);
            *(u32x2*)(YB + row * 512 + hq * 64 + 16 * dt + 4 * g) = w;
        }
    }
    __syncthreads();
}

__device__ __forceinline__ void attn_sample_item(const Args& a, int b, unsigned char* lds) {
    const int tid = threadIdx.x;
    float* qn = (float*)lds; float* knew = (float*)(lds + 8192); float* vnew = (float*)(lds + 10240); float* sc = (float*)(lds + 12288); float* invs = (float*)(lds + 29696); float* cb = (float*)(lds + 32768);
    unsigned char* ws = a.ws;
    const bf16* QA = (const bf16*)(ws + WS_R6); const bf16* KV = (const bf16*)(ws + WS_R7); bf16* YB = (bf16*)(ws + WS_R10);
    const size_t rb = (size_t)MP + (size_t)b * 4;
    const float* ck = a.cache_k + (size_t)b * 16384; const float* cv = a.cache_v + (size_t)b * 16384;
    f32x4 kreg[8];
#pragma unroll
    for (int i = 0; i < 8; ++i) kreg[i] = *(const f32x4*)(ck + 4 * (tid + 512 * i));
    {
        const int pair = tid >> 4, d4 = (tid & 15) * 4, hq = pair >> 2, t = pair & 3;
        const u32x2 w = *(const u32x2*)(QA + (rb + t) * 512 + hq * 64 + d4);
        const float e0 = bflo(w.x), e1 = bfhi(w.x), e2 = bflo(w.y), e3 = bfhi(w.y);
        float ss = (e0 * e0 + e1 * e1) + (e2 * e2 + e3 * e3);
        ss += __shfl_xor(ss, 1); ss += __shfl_xor(ss, 2); ss += __shfl_xor(ss, 4); ss += __shfl_xor(ss, 8);
        const float rstd = __builtin_amdgcn_rsqf(ss * (1.f / 64.f) + EPS);
        const f32x4 nw = *(const f32x4*)(a.q_norm_w + d4);
        *(f32x4*)(qn + pair * 64 + d4) = (f32x4){e0 * rstd * nw[0], e1 * rstd * nw[1], e2 * rstd * nw[2], e3 * rstd * nw[3]};
    }
    if (tid < 128) {
        const int t = tid >> 5, kvh = (tid >> 4) & 1, d4 = (tid & 15) * 4;
        const u32x2 w = *(const u32x2*)(KV + (rb + t) * 256 + kvh * 64 + d4);
        const float e0 = bflo(w.x), e1 = bfhi(w.x), e2 = bflo(w.y), e3 = bfhi(w.y);
        float ss = (e0 * e0 + e1 * e1) + (e2 * e2 + e3 * e3);
        ss += __shfl_xor(ss, 1); ss += __shfl_xor(ss, 2); ss += __shfl_xor(ss, 4); ss += __shfl_xor(ss, 8);
        const float rstd = __builtin_amdgcn_rsqf(ss * (1.f / 64.f) + EPS);
        const f32x4 nw = *(const f32x4*)(a.k_norm_w + d4);
        *(f32x4*)(knew + t * 128 + kvh * 64 + d4) = (f32x4){e0 * rstd * nw[0], e1 * rstd * nw[1], e2 * rstd * nw[2], e3 * rstd * nw[3]};
        const u32x2 v = *(const u32x2*)(KV + (rb + t) * 256 + 128 + kvh * 64 + d4);
        *(f32x4*)(vnew + t * 128 + kvh * 64 + d4) = (f32x4){bflo(v.x), bfhi(v.x), bflo(v.y), bfhi(v.y)};
    }
    {
        float* ok = a.out + O_KS + (size_t)b * 16384;
#pragma unroll
        for (int i = 0; i < 8; ++i) { const int f = 4 * (tid + 512 * i); *(f32x4*)(cb + f) = kreg[i];
            if (f >= 512) *(f32x4*)(ok + f - 512) = kreg[i]; }
    }
    __syncthreads();
    if (tid < 128) { const int f = 4 * tid;
        *(f32x4*)(a.out + O_KS + (size_t)b * 16384 + 124 * 128 + f) = *(const f32x4*)(knew + f); *(f32x4*)(a.out + O_VS + (size_t)b * 16384 + 124 * 128 + f) = *(const f32x4*)(vnew + f); }
    for (int idx = tid; idx < 132 * 32; idx += 512) {
        const int key = idx >> 5, pair = idx & 31, hq = pair >> 2, t = pair & 3, kvh = hq >> 2;
        const float* qp = qn + pair * 64; float dot = 0.f;
        const float* kp = key < 128 ? cb + (key * 2 + kvh) * 64 : knew + (key - 128) * 128 + kvh * 64;
#pragma unroll
        for (int d = 0; d < 64; d += 4) { const f32x4 kk = *(const f32x4*)(kp + d), qq = *(const f32x4*)(qp + d); dot += (kk[0] * qq[0] + kk[1] * qq[1]) + (kk[2] * qq[2] + kk[3] * qq[3]); }
        const int dist = key < 128 ? t + 128 - key : t - (key - 128);
        const bool valid = dist >= 0 && dist < 128;
        sc[pair * 136 + key] = valid ? dot * 0.125f - exp2f(-(float)(hq + 1)) * (float)dist : -1e30f;
    }
    __syncthreads();
    f32x4 vreg[8];
#pragma unroll
    for (int i = 0; i < 8; ++i) vreg[i] = *(const f32x4*)(cv + 4 * (tid + 512 * i));
    {
        const int pair = tid >> 4, l16 = tid & 15, hq = pair >> 2; const float sink = a.sinks[hq];
        float mx = -3.0e38f;
        for (int key = l16; key < 132; key += 16) mx = fmaxf(mx, sc[pair * 136 + key]);
        mx = fmaxf(mx, __shfl_xor(mx, 1)); mx = fmaxf(mx, __shfl_xor(mx, 2)); mx = fmaxf(mx, __shfl_xor(mx, 4)); mx = fmaxf(mx, __shfl_xor(mx, 8));
        mx = fmaxf(mx, sink);
        float sum = 0.f;
        for (int key = l16; key < 132; key += 16) { const float e = __expf(sc[pair * 136 + key] - mx); sc[pair * 136 + key] = e; sum += e; }
        sum += __shfl_xor(sum, 1); sum += __shfl_xor(sum, 2); sum += __shfl_xor(sum, 4); sum += __shfl_xor(sum, 8);
        if (l16 == 0) invs[pair] = 1.f / (sum + __expf(sink - mx));
    }
    { float* ov = a.out + O_VS + (size_t)b * 16384;
#pragma unroll
      for (int i = 0; i < 8; ++i) { const int f = 4 * (tid + 512 * i); *(f32x4*)(cb + f) = vreg[i]; if (f >= 512) *(f32x4*)(ov + f - 512) = vreg[i]; } }
    __syncthreads();
    {
        const int pair = tid >> 4, d4 = (tid & 15) * 4, hq = pair >> 2, t = pair & 3, kvh = hq >> 2;
        f32x4 acc = {0.f, 0.f, 0.f, 0.f};
#pragma unroll 8
        for (int key = 0; key < 128; ++key) { const float pv = sc[pair * 136 + key]; acc += pv * *(const f32x4*)(cb + (key * 2 + kvh) * 64 + d4); }
#pragma unroll
        for (int key = 0; key < 4; ++key) { const float pv = sc[pair * 136 + 128 + key]; acc += pv * *(const f32x4*)(vnew + key * 128 + kvh * 64 + d4); }
        const float inv = invs[pair];
        u32x2 w; w.x = pk2(acc[0] * inv, acc[1] * inv); w.y = pk2(acc[2] * inv, acc[3] * inv);
        *(u32x2*)(YB + (rb + t) * 512 + hq * 64 + d4) = w;
    }
    __syncthreads();
}

__device__ __forceinline__ void hgrn_scan(const Args& a, int sb, int ns, unsigned char* lds) {
    unsigned char* ws = a.ws;
    bf16* SLT = (bf16*)(ws + WS_R0); const float* DT = (const float*)(ws + WS_DT);
    float* dts = (float*)lds;
    for (int e0 = sb * NTHREADS; e0 < 4 * 4 * 128 * 16; e0 += ns * NTHREADS) {
        const int e = e0 + threadIdx.x;
        const int k8 = (e & 15) * 8, v = (e >> 4) & 127, h = (e0 >> 11) & 3, b = e0 >> 13;
        __syncthreads();
#pragma unroll
        for (int i = 0; i < 8; ++i) { const int idx = threadIdx.x + 512 * i, c = idx >> 5, k4 = (idx & 31) * 4; *(f32x4*)(dts + c * 128 + k4) = *(const f32x4*)(DT + (size_t)((b * 128 + c) * 4 + h) * 128 + k4); }
        __syncthreads();
        float st[8];
#pragma unroll
        for (int j = 0; j < 8; ++j) st[j] = 0.f;
        for (int c0 = 0; c0 < 128; c0 += 16) {
            u32x4 loc[16];
#pragma unroll
            for (int i = 0; i < 16; ++i) { const size_t ci = (size_t)((b * 128 + c0 + i) * 4 + h); loc[i] = *(const u32x4*)(SLT + (ci * 128 + v) * 128 + k8); }
#pragma unroll
            for (int i = 0; i < 16; ++i) { const size_t ci = (size_t)((b * 128 + c0 + i) * 4 + h);
                const f32x4 d0 = *(const f32x4*)(dts + (c0 + i) * 128 + k8), d1 = *(const f32x4*)(dts + (c0 + i) * 128 + k8 + 4);
                u32x4 w; w.x = pk2(st[0], st[1]); w.y = pk2(st[2], st[3]); w.z = pk2(st[4], st[5]); w.w = pk2(st[6], st[7]);
                *(u32x4*)(SLT + (ci * 128 + v) * 128 + k8) = w;
                st[0] = d0[0] * st[0] + bflo(loc[i].x); st[1] = d0[1] * st[1] + bfhi(loc[i].x); st[2] = d0[2] * st[2] + bflo(loc[i].y); st[3] = d0[3] * st[3] + bfhi(loc[i].y);
                st[4] = d1[0] * st[4] + bflo(loc[i].z); st[5] = d1[1] * st[5] + bfhi(loc[i].z); st[6] = d1[2] * st[6] + bflo(loc[i].w); st[7] = d1[3] * st[7] + bfhi(loc[i].w); }
        }
        float* o = a.out + O_SP + ((size_t)(b * 4 + h) * 128 + k8) * 128 + v;
#pragma unroll
        for (int j = 0; j < 8; ++j) o[j * 128] = st[j];
    }
}

__device__ __forceinline__ void hgrn_out_phase(const Args& a, unsigned char* lds) {
    const int tid = threadIdx.x, lane = tid & 63, wid = tid >> 6, G = gridDim.x;
    bf16* QdS = (bf16*)lds; bf16* KxS = (bf16*)(lds + 17408); bf16* VS = (bf16*)(lds + 34816); bf16* SS = (bf16*)(lds + 52224); float* red = (float*)(lds + 87040);
    unsigned char* ws = a.ws;
    constexpr int N_OUT = 512 * 4;
    f32x4 c0r[2], c1r[2]; u32x4 qr[2], kr[2], vr[2], sr[4];
#define HO_LOAD(IT) do { const size_t r0_ = (size_t)((IT) >> 2) * 64; const int h_ = (IT) & 3; \
        const size_t ho_ = ((size_t)h_ * MT + r0_) * 128; const float* CU_ = (const float*)(ws + WS_R3) + ho_; const bf16* Q_ = (const bf16*)(ws + WS_R1) + ho_; \
        const bf16* K_ = (const bf16*)(ws + WS_R2) + ho_; const bf16* V_ = (const bf16*)(ws + WS_R4) + ho_; const bf16* S_ = (const bf16*)(ws + WS_R0) + (size_t)(IT) * 16384; \
        _Pragma("unroll") for (int i = 0; i < 2; ++i) { const int idx = tid + 512 * i; \
            c0r[i] = *(const f32x4*)(CU_ + 8 * idx); c1r[i] = *(const f32x4*)(CU_ + 8 * idx + 4); \
            qr[i] = *(const u32x4*)(Q_ + 8 * idx); kr[i] = *(const u32x4*)(K_ + 8 * idx); vr[i] = *(const u32x4*)(V_ + 8 * idx); } \
        _Pragma("unroll") for (int i = 0; i < 4; ++i) { const int idx = tid + 512 * i, v = idx >> 4, c8 = (idx & 15) * 8; sr[i] = *(const u32x4*)(S_ + (size_t)v * 128 + c8); } } while (0)
    int it = blockIdx.x;
    if (it < N_OUT) HO_LOAD(it);
    for (; it < N_OUT; it += G) {
        const int cidx = it >> 2, h = it & 3;
        const size_t r0 = (size_t)cidx * 64;
        const bf16* OG = (const bf16*)(ws + WS_R5) + ((size_t)h * MT + r0) * 128;
        bf16* YA = (bf16*)(ws + WS_R6) + r0 * 512 + h * 128;
#pragma unroll
        for (int i = 0; i < 2; ++i) {
            const int idx = tid + 512 * i, j = idx >> 4, k8 = (idx & 15) * 8;
            const f32x4 c0 = c0r[i], c1 = c1r[i]; const u32x4 qw = qr[i], kw = kr[i];
            float e[8], ei[8];
#pragma unroll
            for (int x = 0; x < 4; ++x) { e[x] = __expf(c0[x]); e[4 + x] = __expf(c1[x]); ei[x] = __expf(-c0[x]); ei[4 + x] = __expf(-c1[x]); }
            u32x4 w;
            w.x = pk2(bflo(qw.x) * e[0], bfhi(qw.x) * e[1]); w.y = pk2(bflo(qw.y) * e[2], bfhi(qw.y) * e[3]); w.z = pk2(bflo(qw.z) * e[4], bfhi(qw.z) * e[5]); w.w = pk2(bflo(qw.w) * e[6], bfhi(qw.w) * e[7]);
            *(u32x4*)(QdS + j * 136 + k8) = w;
            w.x = pk2(bflo(kw.x) * ei[0], bfhi(kw.x) * ei[1]); w.y = pk2(bflo(kw.y) * ei[2], bfhi(kw.y) * ei[3]); w.z = pk2(bflo(kw.z) * ei[4], bfhi(kw.z) * ei[5]); w.w = pk2(bflo(kw.w) * ei[6], bfhi(kw.w) * ei[7]);
            *(u32x4*)(KxS + j * 136 + k8) = w;
            *(u32x4*)(VS + j * 136 + k8) = vr[i];
        }
#pragma unroll
        for (int i = 0; i < 4; ++i) { const int idx = tid + 512 * i, v = idx >> 4, c8 = (idx & 15) * 8; *(u32x4*)(SS + v * 136 + c8) = sr[i]; }
        __syncthreads();
        if (it + G < N_OUT) HO_LOAD(it + G);
        const int i16 = lane & 15, g = lane >> 4, q = i16 >> 2, p = i16 & 3, tt = wid & 3, vh = wid >> 2;
        u32x2 ogr[4];
#pragma unroll
        for (int vt = 0; vt < 4; ++vt) ogr[vt] = *(const u32x2*)(OG + (size_t)(16 * tt + i16) * 128 + vh * 64 + 16 * vt + 4 * g);
        bf16x8 bq[4];
#pragma unroll
        for (int kc = 0; kc < 4; ++kc) bq[kc] = *(const bf16x8*)(QdS + (16 * tt + i16) * 136 + 32 * kc + 8 * g);
        f32x4 sc[4];
#pragma unroll
        for (int jt = 0; jt < 4; ++jt) {
            f32x4 sv = {0.f, 0.f, 0.f, 0.f};
            if (jt <= tt) {
#pragma unroll
                for (int kc = 0; kc < 4; ++kc) sv = MFMA16(*(const bf16x8*)(KxS + (16 * jt + i16) * 136 + 32 * kc + 8 * g), bq[kc], sv);
                if (jt == tt) {
#pragma unroll
                    for (int r = 0; r < 4; ++r) sv[r] = (4 * g + r > i16) ? 0.f : sv[r];
                }
            }
            sc[jt] = sv;
        }
        bf16x8 pb[2];
        pb[0] = pk8(sc[0], sc[1]); pb[1] = pk8(sc[2], sc[3]);
        f32x4 acc[4]; float ss = 0.f;
#pragma unroll
        for (int vt = 0; vt < 4; ++vt) {
            const int v0 = vh * 64 + 16 * vt;
            f32x4 c = {0.f, 0.f, 0.f, 0.f};
#pragma unroll
            for (int kc = 0; kc < 4; ++kc) c = MFMA16(*(const bf16x8*)(SS + (v0 + i16) * 136 + 32 * kc + 8 * g), bq[kc], c);
#pragma unroll
            for (int jc = 0; jc < 2; ++jc) {
                const bf16x8 av = cat8(tr_read(VS + (32 * jc + 4 * g + q) * 136 + v0 + 4 * p), tr_read(VS + (32 * jc + 16 + 4 * g + q) * 136 + v0 + 4 * p));
                c = MFMA16(av, pb[jc], c);
            }
            acc[vt] = c; ss += (c[0] * c[0] + c[1] * c[1]) + (c[2] * c[2] + c[3] * c[3]);
        }
        ss += __shfl_xor(ss, 16); ss += __shfl_xor(ss, 32);
        if (g == 0) red[vh * 64 + 16 * tt + i16] = ss;
        __syncthreads();
        const float rstd = __builtin_amdgcn_rsqf((red[16 * tt + i16] + red[64 + 16 * tt + i16]) * (1.f / 128.f) + EPS);
#pragma unroll
        for (int vt = 0; vt < 4; ++vt) {
            const int col = vh * 64 + 16 * vt + 4 * g; const size_t t = (size_t)(16 * tt + i16);
            const u32x2 ow = ogr[vt]; const f32x4 nw = *(const f32x4*)(a.hgrn_norm_w + h * 128 + col);
            u32x2 w; w.x = pk2(acc[vt][0] * rstd * nw[0] * bflo(ow.x), acc[vt][1] * rstd * nw[1] * bfhi(ow.x)); w.y = pk2(acc[vt][2] * rstd * nw[2] * bflo(ow.y), acc[vt][3] * rstd * nw[3] * bfhi(ow.y));
            *(u32x2*)(YA + t * 512 + col) = w;
        }
        __syncthreads();
    }
#undef HO_LOAD
}

__device__ __forceinline__ void hgrn_sample_item(const Args& a, int b, int h, unsigned char* lds) {
    const int tid = threadIdx.x, lane = tid & 63, wid = tid >> 6;
    float* part = (float*)lds;
    float* wsum = (float*)(lds + 32768);
    unsigned char* ws = a.ws;
    const int v4 = (tid & 31) * 4, kg = tid >> 5;
    const float* S0 = a.state_hgrn + ((size_t)(b * 4 + h) * 128 + 8 * kg) * 128 + v4;
    float* S1 = a.out + O_SS + ((size_t)(b * 4 + h) * 128 + 8 * kg) * 128 + v4;
    f32x4 S[8];
#pragma unroll
    for (int e = 0; e < 8; ++e) S[e] = *(const f32x4*)(S0 + e * 128);
    const size_t rb = (size_t)MP + (size_t)b * 4;
#pragma unroll
    for (int t = 0; t < 4; ++t) {
        const size_t off = ((size_t)h * MT + rb + t) * 128;
        const f32x4 g0 = *(const f32x4*)((const float*)(ws + WS_R3) + off + 8 * kg), g1 = *(const f32x4*)((const float*)(ws + WS_R3) + off + 8 * kg + 4);
        const u32x4 kw = *(const u32x4*)((const bf16*)(ws + WS_R2) + off + 8 * kg), qw = *(const u32x4*)((const bf16*)(ws + WS_R1) + off + 8 * kg);
        const u32x2 vw = *(const u32x2*)((const bf16*)(ws + WS_R4) + off + v4);
        const f32x4 vv = {bflo(vw.x), bfhi(vw.x), bflo(vw.y), bfhi(vw.y)};
        const float f[8] = {__expf(g0[0]), __expf(g0[1]), __expf(g0[2]), __expf(g0[3]), __expf(g1[0]), __expf(g1[1]), __expf(g1[2]), __expf(g1[3])};
        const float kk[8] = {bflo(kw.x), bfhi(kw.x), bflo(kw.y), bfhi(kw.y), bflo(kw.z), bfhi(kw.z), bflo(kw.w), bfhi(kw.w)};
        const float qq[8] = {bflo(qw.x), bfhi(qw.x), bflo(qw.y), bfhi(qw.y), bflo(qw.z), bfhi(qw.z), bflo(qw.w), bfhi(qw.w)};
        f32x4 po = {0.f, 0.f, 0.f, 0.f};
#pragma unroll
        for (int e = 0; e < 8; ++e) { S[e] = f[e] * S[e] + kk[e] * vv; po += qq[e] * S[e]; }
        *(f32x4*)(part + (t * 16 + kg) * 128 + v4) = po;
    }
#pragma unroll
    for (int e = 0; e < 8; ++e) *(f32x4*)(S1 + e * 128) = S[e];
    __syncthreads();
    const int t = tid >> 7, v = tid & 127;
    float o = 0.f;
#pragma unroll
    for (int k = 0; k < 16; ++k) o += part[(t * 16 + k) * 128 + v];
    const float s2 = wave_sum(o * o);
    if (lane == 0) wsum[wid] = s2;
    __syncthreads();
    const float rstd = __builtin_amdgcn_rsqf((wsum[2 * t] + wsum[2 * t + 1]) * (1.f / 128.f) + EPS);
    const float y = o * rstd * a.hgrn_norm_w[h * 128 + v] * bf2f(((const bf16*)(ws + WS_R5))[((size_t)h * MT + rb + t) * 128 + v]);
    ((bf16*)(ws + WS_YAS))[((size_t)b * 4 + t) * 512 + h * 128 + v] = (bf16)(pk2(y, 0.f) & 0xffffu);
    __syncthreads();
}


template <int K, int LDW = K> __device__ __forceinline__ f32x4 mini_gemm(const bf16* __restrict__ X, const bf16* __restrict__ W, unsigned char* lds, f32x4 acc) {
    const int tid = threadIdx.x, lane = tid & 63, wid = tid >> 6, i16 = lane & 15, g = lane >> 4, rw = wid & 1, cw = wid >> 1;
    const int sr = tid >> 5, sc = (tid & 31) * 8;
    constexpr int NT = K / 256, P = 264, XB_ = 32 * P * 2, BUF = (32 + 64) * P * 2;
    static_assert(K % 256 == 0, "mini_gemm: K must be a multiple of 256");
    const bf16* xp = X + (size_t)sr * K + sc; const bf16* wp = W + (size_t)sr * LDW + sc;
    u32x4 xr[2], wv[4];
#pragma unroll
    for (int i = 0; i < 2; ++i) xr[i] = *(const u32x4*)(xp + (size_t)(16 * i) * K);
#pragma unroll
    for (int i = 0; i < 4; ++i) wv[i] = *(const u32x4*)(wp + (size_t)(16 * i) * LDW);
    __syncthreads();
#pragma unroll 1
    for (int kt = 0; kt < NT; ++kt) {
        unsigned char* b = lds + (kt & 1) * BUF;
#pragma unroll
        for (int i = 0; i < 2; ++i) *(u32x4*)(b + ((sr + 16 * i) * P + sc) * 2) = xr[i];
#pragma unroll
        for (int i = 0; i < 4; ++i) *(u32x4*)(b + XB_ + ((sr + 16 * i) * P + sc) * 2) = wv[i];
        __syncthreads();
        if (kt + 1 < NT) {
#pragma unroll
            for (int i = 0; i < 2; ++i) xr[i] = *(const u32x4*)(xp + (size_t)(16 * i) * K + 256 * (kt + 1));
#pragma unroll
            for (int i = 0; i < 4; ++i) wv[i] = *(const u32x4*)(wp + (size_t)(16 * i) * LDW + 256 * (kt + 1));
        }
        const bf16* xs = (const bf16*)b + (16 * rw + i16) * P + 8 * g; const bf16* wsm = (const bf16*)(b + XB_) + (16 * cw + i16) * P + 8 * g;
#pragma unroll
        for (int kc = 0; kc < 8; ++kc) acc = MFMA16(*(const bf16x8*)(wsm + 32 * kc), *(const bf16x8*)(xs + 32 * kc), acc);
    }
    return acc;
}
#define SAMPLE_TILE_VARS const int lane = threadIdx.x & 63, wid = threadIdx.x >> 6, i16 = lane & 15, g = lane >> 4; \
    const int row0 = MP + 32 * (tile & 15), colb = 64 * (tile >> 4), row = row0 + 16 * (wid & 1) + i16, col0 = colb + 16 * (wid >> 1); const size_t off = (size_t)row * 1024 + col0 + 4 * g
__device__ __forceinline__ void p5_sample(const Args& a, unsigned char* lds) {
    unsigned char* ws = a.ws;
    for (int tile = blockIdx.x; tile < 256; tile += gridDim.x) {
        SAMPLE_TILE_VARS;
        const f32x4 z = {0.f, 0.f, 0.f, 0.f};
        const f32x4 pa = mini_gemm<512, 1024>((const bf16*)(ws + WS_YAS) + (size_t)(row0 - MP) * 512, (const bf16*)(ws + WS_WOH) + (size_t)colb * 1024, lds, z);
        const f32x4 pb = mini_gemm<512, 1024>((const bf16*)(ws + WS_R10) + (size_t)row0 * 512, (const bf16*)(ws + WS_WOH) + (size_t)colb * 1024 + 512, lds, z);
        const u32x2 ga = *(const u32x2*)((const bf16*)(ws + WS_R8) + off), gb = *(const u32x2*)((const bf16*)(ws + WS_R9) + off);
        u32x2 w; w.x = pk2(bflo(gb.x) * (bflo(ga.x) * pa[0] + pb[0]), bfhi(gb.x) * (bfhi(ga.x) * pa[1] + pb[1])); w.y = pk2(bflo(gb.y) * (bflo(ga.y) * pa[2] + pb[2]), bfhi(gb.y) * (bfhi(ga.y) * pa[3] + pb[3]));
        *(u32x2*)((bf16*)(ws + WS_R3) + off) = w;
    }
    __syncthreads();
}
__device__ __forceinline__ void p6_sample(const Args& a, unsigned char* lds) {
    unsigned char* ws = a.ws;
    for (int tile = blockIdx.x; tile < 256; tile += gridDim.x) {
        SAMPLE_TILE_VARS;
        const f32x4 z = {0.f, 0.f, 0.f, 0.f};
        const f32x4 p = mini_gemm<1024>((const bf16*)(ws + WS_R3) + (size_t)row0 * 1024, (const bf16*)(ws + WS_WOUT) + (size_t)colb * 1024, lds, z);
        const f32x4 v = p + *(const f32x4*)(a.x_sample + off - (size_t)MP * 1024);
        u32x2 w; w.x = pk2(v[0], v[1]); w.y = pk2(v[2], v[3]);
        *(u32x2*)((bf16*)(ws + WS_R8) + off) = w;
        float ss = (v[0] * v[0] + v[1] * v[1]) + (v[2] * v[2] + v[3] * v[3]);
        ss += __shfl_xor(ss, 16); ss += __shfl_xor(ss, 32);
        if (g == 0) atomicAdd((float*)(ws + WS_SUMSQ) + row, ss);
    }
    __syncthreads();
}
__device__ __forceinline__ void p8_sample(const Args& a, unsigned char* lds) {
    unsigned char* ws = a.ws;
    for (int tile = blockIdx.x; tile < 256; tile += gridDim.x) {
        SAMPLE_TILE_VARS;
        const f32x4 z = {0.f, 0.f, 0.f, 0.f};
        const f32x4 p = mini_gemm<DFF>((const bf16*)(ws + WS_R0) + (size_t)row0 * DFF, (const bf16*)(ws + WS_WD) + (size_t)colb * DFF, lds, z);
        const u32x2 xw = *(const u32x2*)((const bf16*)(ws + WS_R8) + off);
        *(f32x4*)(a.out + O_Y + off) = (f32x4){p[0] + bflo(xw.x), p[1] + bfhi(xw.x), p[2] + bflo(xw.y), p[3] + bfhi(xw.y)};
    }
    __syncthreads();
}
#define XB_TMO      128
#define XB_XCNT(j)  (256  + 64 * (j))
#define XB_XSUB(j)  (1280 + 64 * (j))
#define XB_XGEN(j)  (2304 + 64 * (j))
#define XB_TOP      3328
#define XB_TOPGEN   3392
#define XCD_BAR_WORDS 3456
#define XB_SPIN_CAP (1u << 18)

__device__ __forceinline__ unsigned xb_ld(unsigned* p)              { return __hip_atomic_load(p, __ATOMIC_RELAXED, __HIP_MEMORY_SCOPE_AGENT); }
__device__ __forceinline__ unsigned xb_add(unsigned* p, unsigned v) { return __hip_atomic_fetch_add(p, v, __ATOMIC_RELAXED, __HIP_MEMORY_SCOPE_AGENT); }
__device__ __forceinline__ unsigned xb_xcc_id() { return (unsigned)__builtin_amdgcn_s_getreg((3 << 11) | 20) & 0xFu; }
#define XB_SPIN(cond, bar) do { unsigned _sp = 0; while (cond) { __builtin_amdgcn_s_sleep(1); \
    if ((++_sp & 255u) == 0u) { if (xb_ld(&(bar)[XB_TMO])) break; if (_sp > XB_SPIN_CAP) { atomicAdd(&(bar)[XB_TMO], 1u); break; } } } } while (0)

struct XcdBarrier {
    unsigned* bar; unsigned x;
    volatile LAS unsigned* st;
};

__device__ __forceinline__ XcdBarrier xcd_barrier_post(unsigned* bar, volatile LAS unsigned* st) {
    XcdBarrier b; b.bar = bar; b.x = xb_xcc_id(); b.st = st;
    if (threadIdx.x == 0) (void)xb_add(&bar[XB_XCNT(b.x)], 1u);
    return b;
}
__device__ __forceinline__ void xcd_barrier_complete(unsigned* bar, unsigned x, unsigned& nloc, unsigned& nx) {
    const unsigned G = gridDim.x * gridDim.y * gridDim.z;
    unsigned sum, cnt, mine, sp = 0u;
    for (;;) {
        sum = 0u; cnt = 0u; mine = 0u;
#pragma unroll
        for (unsigned j = 0; j < 16; ++j) { const unsigned c = xb_ld(&bar[XB_XCNT(j)]); sum += c; cnt += (c > 0u) ? 1u : 0u; mine = (j == x) ? c : mine; }
        if (sum == G) break;
        __builtin_amdgcn_s_sleep(1);
        if ((++sp & 255u) == 0u) { if (xb_ld(&bar[XB_TMO])) break; if (sp > XB_SPIN_CAP) { atomicAdd(&bar[XB_TMO], 1u); break; } }
    }
    nloc = mine > 0u ? mine : 1u; nx = cnt > 0u ? cnt : 1u;
}

__device__ __forceinline__ void xcd_barrier(const XcdBarrier& b) {
    asm volatile("s_waitcnt vmcnt(0)" ::: "memory");
    __syncthreads();
    if (threadIdx.x == 0) {
        unsigned* bar = b.bar;
        __builtin_amdgcn_s_waitcnt(0);
        unsigned nloc = b.st[0], nx = b.st[1];
        if (nloc == 0u) { xcd_barrier_complete(bar, b.x, nloc, nx); b.st[0] = nloc; b.st[1] = nx; }
        const unsigned old = xb_add(&bar[XB_XSUB(b.x)], 1u);
        const unsigned gen = old / nloc;
        if (old + 1u == (gen + 1u) * nloc) {
            __builtin_amdgcn_fence(__ATOMIC_RELEASE, "agent");
            asm volatile("s_waitcnt vmcnt(0)" ::: "memory");
            const unsigned og = xb_add(&bar[XB_TOP], 1u);
            const unsigned tg = og / nx;
            if (og + 1u == (tg + 1u) * nx) xb_add(&bar[XB_TOPGEN], 1u);
            else XB_SPIN(xb_ld(&bar[XB_TOPGEN]) == tg, bar);
            __builtin_amdgcn_fence(__ATOMIC_ACQUIRE, "agent");
            xb_add(&bar[XB_XGEN(b.x)], 1u);
            asm volatile("s_waitcnt vmcnt(0)" ::: "memory");
        } else {
            XB_SPIN(xb_ld(&bar[XB_XGEN(b.x)]) == gen, bar);
            __builtin_amdgcn_fence(__ATOMIC_ACQUIRE, "agent");
            asm volatile("s_waitcnt vmcnt(0)" ::: "memory");
        }
    }
    __syncthreads();
}


#ifndef PG_ALIGN_BIG
#define PG_ALIGN_BIG true
#endif
#ifndef PG_ALIGN_N1K
#define PG_ALIGN_N1K true
#endif
__global__ void __launch_bounds__(NTHREADS, 2) mk_fwd(Args a) {
    extern __shared__ __attribute__((aligned(16))) unsigned char lds[];
    cg::grid_group grid = cg::this_grid();
    const int lo = a.ph_lo, hi = a.ph_hi, G = gridDim.x, bid = blockIdx.x;
    unsigned char* ws = a.ws;
    LAS unsigned char* ring = (LAS unsigned char*)(LAS void*)lds;
#ifdef PH_MASK
#define IN(k) (((PH_MASK) >> (k)) & 1)
#else
#define IN(k) (lo <= (k) && (k) < hi)
#endif
#ifdef TPROBE_A
#define STAMP(k) do { if (bid == 0 && threadIdx.x == 0) ((volatile unsigned long long*)(lds + 131072 + 64))[k] = __builtin_amdgcn_s_memrealtime(); } while (0)
#else
#define STAMP(k) do { } while (0)
#endif
    if (threadIdx.x < 2) ((volatile LAS unsigned*)(LAS void*)(lds + LDS_BYTES))[threadIdx.x] = 0u;
    __syncthreads();
    XcdBarrier xbar = xcd_barrier_post((unsigned*)(ws + WS_BAR), (volatile LAS unsigned*)(LAS void*)(lds + LDS_BYTES));
#define SEAM(k) do { if (IN(k) && IN((k) + 1)) { if (hi > 1000) grid.sync(); else xcd_barrier(xbar); } STAMP((k) + 1); } while (0)
    STAMP(0);

    constexpr int P1_NWG = (MT / 256) * (PW / 256);
    const int p1_rem = P1_NWG % G;
    if (IN(0)) { p0_prologue(a, lds, (p1_rem != 0 && IN(1)) ? P0_I1 : P0_NITEMS); }
    SEAM(0);
    if (IN(1)) {
        pg8::Gemm g{(const bf16*)(ws + WS_R0), (const bf16*)(ws + WS_W1T), MT, PW, 1024}; pg8::StaticOrder S; S.init(MT, PW, G, bid);
        pg8::EpiProj E{(bf16*)(ws + WS_R1), (bf16*)(ws + WS_R2), (bf16*)(ws + WS_R4), (bf16*)(ws + WS_R5), (bf16*)(ws + WS_R6), (bf16*)(ws + WS_R7), (bf16*)(ws + WS_R8), (bf16*)(ws + WS_R9),
                       (float*)(ws + WS_R3), (const float*)(ws + WS_LBV)};
        pg8::gemm_phase<pg8::EpiProj, pg8::StaticOrder, PG_ALIGN_BIG, true>(ring, g, S, E);
        if (p1_rem != 0 && IN(0) && bid >= p1_rem) p0_weights(a, lds, P0_I1, P0_NITEMS, (bid - p1_rem) * 8 + (int)(threadIdx.x >> 6), (G - p1_rem) * 8);
    }
    SEAM(1);
    if (IN(2)) { hgrn_local_phase(a, lds); }
    SEAM(2);
    if (IN(3)) {
        constexpr int N_ATT = 4 * 64 * 2, N_SAT = DEC_B;
        const int ns = (G >= 128) ? 64 : 0;
        if (G == 256) {
            if (bid < ns) {
                hgrn_scan(a, bid, ns, lds); STAMP(10);
                __syncthreads();
                { const int r = 448 + bid; attn_prompt_item(a, r >> 7, (r >> 1) & 63, r & 1, lds); }
                for (int r = 320 + 3 * bid; r < 320 + 3 * bid + 3; ++r) hgrn_sample_item(a, r >> 2, r & 3, lds);
            } else {
                const int j = bid - ns;
                if (j < 128) { attn_sample_item(a, j, lds);
                    for (int r = 2 * j; r < 2 * j + 2; ++r) attn_prompt_item(a, r >> 7, (r >> 1) & 63, r & 1, lds);
                    for (int r = 2 * j; r < 2 * j + 2; ++r) hgrn_sample_item(a, r >> 2, r & 3, lds); }
                else { for (int r = 256 + 3 * (j - 128); r < 256 + 3 * (j - 128) + 3; ++r) attn_prompt_item(a, r >> 7, (r >> 1) & 63, r & 1, lds);
                    { const int r = 256 + (j - 128); hgrn_sample_item(a, r >> 2, r & 3, lds); } }
            }
        } else {
            if (ns == 0) hgrn_scan(a, bid, G, lds); else if (bid < ns) hgrn_scan(a, bid, ns, lds);
            __syncthreads();
            if (bid >= ns) {
                for (int it = bid - ns; it < N_ATT + N_SAT; it += G - ns) {
                    if (it < N_ATT) attn_prompt_item(a, it >> 7, (it >> 1) & 63, it & 1, lds);
                    else attn_sample_item(a, it - N_ATT, lds);
                }
                for (int r = bid - ns; r < DEC_B * 4; r += G - ns) hgrn_sample_item(a, r >> 2, r & 3, lds);
            }
        }
    }
    SEAM(3);
    if (IN(4)) {
        hgrn_out_phase(a, lds);
    }
    SEAM(4);
    if (IN(5)) {
        p5_sample(a, lds);
        pg8::StaticOrder S; S.init(MP, 1024, G, bid);
        pg8::Gemm g{(const bf16*)(ws + WS_R6), (const bf16*)(ws + WS_WOH), MP, 1024, 1024, (const bf16*)(ws + WS_R10), 512, 8};
        pg8::EpiMerge E{(const bf16*)(ws + WS_R8), (const bf16*)(ws + WS_R9), (bf16*)(ws + WS_R3)};
        pg8::gemm_phase<pg8::EpiMerge, pg8::StaticOrder, PG_ALIGN_N1K, true, true>(ring, g, S, E);
    }
    SEAM(5);
    if (IN(6)) {
        p6_sample(a, lds);
        pg8::Gemm g{(const bf16*)(ws + WS_R3), (const bf16*)(ws + WS_WOUT), MP, 1024, 1024}; pg8::StaticOrder S; S.init(MP, 1024, G, bid);
        pg8::EpiRes1 E{a.x_prompt, (bf16*)(ws + WS_R8), (float*)(ws + WS_SUMSQ)};
        pg8::gemm_phase<pg8::EpiRes1, pg8::StaticOrder, PG_ALIGN_N1K, true>(ring, g, S, E);
    }
    SEAM(6);
    if (IN(7)) {
        pg8::Gemm g{(const bf16*)(ws + WS_R8), (const bf16*)(ws + WS_WGU), MT, 2 * DFF, 1024}; pg8::StaticOrder S; S.init(MT, 2 * DFF, G, bid);
        pg8::EpiFfn E{(const float*)(ws + WS_SUMSQ), (bf16*)(ws + WS_R0)};
        pg8::gemm_phase<pg8::EpiFfn, pg8::StaticOrder, PG_ALIGN_BIG, true>(ring, g, S, E);
    }
    SEAM(7);
    if (IN(8)) {
        p8_sample(a, lds);
        pg8::Gemm g{(const bf16*)(ws + WS_R0), (const bf16*)(ws + WS_WD), MP, 1024, DFF}; pg8::StaticOrder S; S.init(MP, 1024, G, bid);
        pg8::EpiRes2 E{(const bf16*)(ws + WS_R8), a.out + O_Y};
        pg8::gemm_phase<pg8::EpiRes2, pg8::StaticOrder, PG_ALIGN_N1K, true>(ring, g, S, E);
    }
#ifdef TPROBE_A
    {
        grid.sync(); STAMP(9);
        unsigned long long* pw = (unsigned long long*)(ws + WS_MISC + 2048);
        if (bid == 0 && threadIdx.x == 0) { volatile unsigned long long* t = (volatile unsigned long long*)(lds + 131072 + 64);
            pw[0] = (TPROBE_A >= 0) ? t[TPROBE_A + 1] - t[TPROBE_A] : 0ull; pw[1] = (TPROBE_B == 10) ? t[10] - t[3] : t[TPROBE_B + 1] - t[TPROBE_B]; __threadfence(); }
        grid.sync();
        const unsigned long long dA = __hip_atomic_load(pw, __ATOMIC_RELAXED, __HIP_MEMORY_SCOPE_AGENT), dB = __hip_atomic_load(pw + 1, __ATOMIC_RELAXED, __HIP_MEMORY_SCOPE_AGENT);
        const float eps = sqrtf(2e-5f + (float)dB * 0.01f * (float)(TPROBE_KB));
        f32x4* cvs = (f32x4*)(a.out + O_VS);
        for (int i = bid * NTHREADS + threadIdx.x; i < 128 * 128 * 128 / 4; i += G * NTHREADS) cvs[i] = cvs[i] * (1.f + eps);
        const unsigned long long t0 = __builtin_amdgcn_s_memrealtime();
        while (__builtin_amdgcn_s_memrealtime() - t0 < 4ull * dA) __builtin_amdgcn_s_sleep(8);
    }
#endif
#undef IN
#undef SEAM
}

__global__ void dump_ws(const unsigned short* w, float* o, size_t n, size_t tot) {
    for (size_t i = blockIdx.x * (size_t)blockDim.x + threadIdx.x; i < n; i += (size_t)gridDim.x * blockDim.x) { unsigned s = 0; for (size_t j = i; j < tot; j += n) s += w[j]; o[i] = (float)s; }
}
constexpr int N_PHASES = 9;
extern "C" void kernel_launch(void* const* d_in, const int* in_sizes, int n_in, void* d_out, int out_size, void* d_ws, size_t ws_size, hipStream_t stream) {
    static int grid = 0;
    if (grid == 0) {
        if (n_in != 19 || (size_t)out_size != O_END || ws_size < WS_END) { fprintf(stderr, "kernel_launch: unexpected shapes: n_in %d out %d ws %zu (need %zu)\n", n_in, out_size, ws_size, (size_t)WS_END); grid = -1; return; }
        int dev = 0, cus = 0, per_cu = 0;
        if (hipGetDevice(&dev) != hipSuccess || hipDeviceGetAttribute(&cus, hipDeviceAttributeMultiprocessorCount, dev) != hipSuccess) { grid = -1; return; }
        if (hipFuncSetAttribute((const void*)mk_fwd, hipFuncAttributeMaxDynamicSharedMemorySize, LDS_TOTAL) != hipSuccess) { fprintf(stderr, "kernel_launch: hipFuncSetAttribute failed\n"); grid = -1; return; }
        if (hipOccupancyMaxActiveBlocksPerMultiprocessor(&per_cu, (const void*)mk_fwd, NTHREADS, LDS_TOTAL) != hipSuccess || per_cu < 1) { fprintf(stderr, "kernel_launch: occupancy query says %d\n", per_cu); (void)hipGetLastError(); grid = -1; return; }
        grid = cus;
    }
    if (grid < 0) return;
    Args a{};
    const float** ap = (const float**)&a;
    for (int i = 0; i < 19; ++i) ap[i] = (const float*)d_in[i];
    a.out = (float*)d_out; a.ws = (unsigned char*)d_ws;
#if MK_N_LAUNCHES == 1
    if (hipMemsetAsync((char*)d_ws + WS_BAR, 0, XCD_BAR_WORDS * 4, stream) != hipSuccess) { fprintf(stderr, "kernel_launch: memset of the barrier words failed\n"); return; }
    a.ph_lo = 0; a.ph_hi = N_PHASES;
    void* args[] = {&a};
    hipError_t e = hipLaunchCooperativeKernel((const void*)mk_fwd, dim3(grid), dim3(NTHREADS), args, LDS_TOTAL, stream);
    if (e != hipSuccess) fprintf(stderr, "kernel_launch: cooperative launch failed: %s (grid %d)\n", hipGetErrorString(e), grid);
#else
#ifndef PROBE_K
#define PROBE_K 8
#endif
    for (int ph = 0; ph <= PROBE_K; ++ph) {
        a.ph_lo = ph; a.ph_hi = ph + 1;
        hipLaunchKernelGGL(mk_fwd, dim3(grid), dim3(NTHREADS), LDS_TOTAL, stream, a);
    }
#if PROBE_K < 8
    hipLaunchKernelGGL(dump_ws, dim3(2048), dim3(256), 0, stream, (const unsigned short*)d_ws, (float*)d_out, (size_t)out_size, (size_t)(WS_END / 2));
#endif
#endif
}
```

```cpp
#include <hip/hip_runtime.h>
#include <hip/hip_cooperative_groups.h>
#include <cstdio>
#include <cstdint>
namespace cg = cooperative_groups;

#ifndef MK_N_LAUNCHES
#define MK_N_LAUNCHES 1
#endif

constexpr int DM = 1024, SEQ = 8192, NBATCH = 4, MP = NBATCH * SEQ, DEC_B = 128, DEC_T = 4, MS = DEC_B * DEC_T, MT = MP + MS;
constexpr int PW = 4864, DFF = 2816;
constexpr float EPS = 1e-6f;

constexpr size_t UB = (size_t)MT * 512 * 2;
constexpr size_t WS_W1T = 0;
constexpr size_t WS_WOH = WS_W1T + (size_t)PW * DM * 2;
constexpr size_t WS_WOA = WS_WOH + (size_t)1024 * 512 * 2;
constexpr size_t WS_WOUT = WS_WOA + (size_t)1024 * 512 * 2;
constexpr size_t WS_WGU = WS_WOUT + (size_t)1024 * 1024 * 2;
constexpr size_t WS_WD = WS_WGU + (size_t)2 * DFF * DM * 2;
constexpr size_t WS_MISC = WS_WD + (size_t)DM * DFF * 2;
constexpr size_t WS_LBV = WS_MISC;
constexpr size_t WS_SUMSQ = WS_MISC + 4096;
constexpr size_t WS_DT = WS_MISC + 512 * 1024;
constexpr size_t WS_BAR = WS_MISC + 1536 * 1024;
constexpr size_t WS_R0 = (size_t)32 << 20;
constexpr size_t WS_R1 = WS_R0 + 2 * UB;
constexpr size_t WS_R2 = WS_R1 + UB;
constexpr size_t WS_R3 = WS_R2 + UB;
constexpr size_t WS_R4 = WS_R3 + 2 * UB;
constexpr size_t WS_R5 = WS_R4 + UB;
constexpr size_t WS_R6 = WS_R5 + UB;
constexpr size_t WS_R7 = WS_R6 + UB;
constexpr size_t WS_R8 = WS_R7 + UB / 2;
constexpr size_t WS_R9 = WS_R8 + 2 * UB;
constexpr size_t WS_R10 = WS_R9 + 2 * UB;
constexpr size_t WS_YAS = WS_R10 + UB;
constexpr size_t WS_END = WS_YAS + (size_t)MS * 512 * 2;
static_assert(WS_MISC == ((size_t)30 << 20) && WS_END <= ((size_t)512 << 20), "d_ws map");
static_assert((size_t)MT * DFF * 2 <= 6 * UB, "ACT fits R0..R3");

constexpr size_t O_Y = 0;
constexpr size_t O_SP = (size_t)MT * DM;
constexpr size_t O_KP = O_SP + (size_t)4 * 4 * 128 * 128;
constexpr size_t O_VP = O_KP + (size_t)4 * 128 * 128;
constexpr size_t O_SS = O_VP + (size_t)4 * 128 * 128;
constexpr size_t O_KS = O_SS + (size_t)128 * 4 * 128 * 128;
constexpr size_t O_VS = O_KS + (size_t)128 * 128 * 128;
constexpr size_t O_END = O_VS + (size_t)128 * 128 * 128;

constexpr int LDS_BYTES = 131072;
constexpr int LDS_TOTAL = LDS_BYTES + 256;
constexpr int NTHREADS = 512;

#define LAS __attribute__((address_space(3)))
typedef unsigned short bf16;
typedef float f32x4 __attribute__((ext_vector_type(4)));
typedef float f32x2 __attribute__((ext_vector_type(2)));
typedef unsigned u32x4 __attribute__((ext_vector_type(4)));
typedef unsigned u32x2 __attribute__((ext_vector_type(2)));
typedef short bf16x8 __attribute__((ext_vector_type(8)));
typedef short s16x4 __attribute__((ext_vector_type(4)));

__device__ __forceinline__ float bf2f(unsigned short u) { return __uint_as_float((unsigned)u << 16); }
__device__ __forceinline__ float bflo(unsigned w) { return __uint_as_float(w << 16); }
__device__ __forceinline__ float bfhi(unsigned w) { return __uint_as_float(w & 0xffff0000u); }
typedef __bf16 bf16x2_t __attribute__((ext_vector_type(2)));
__device__ __forceinline__ unsigned pk2(float lo, float hi) { f32x2 v = {lo, hi}; bf16x2_t b = __builtin_convertvector(v, bf16x2_t); return __builtin_bit_cast(unsigned, b); }
__device__ __forceinline__ float sigm(float x) { return __builtin_amdgcn_rcpf(1.f + __expf(-x)); }
__device__ __forceinline__ s16x4 tr_read(const bf16* p) {
    return __builtin_bit_cast(s16x4, __builtin_amdgcn_ds_read_tr16_b64_v4i16((LAS s16x4*)(LAS void*)p));
}
__device__ __forceinline__ bf16x8 cat8(s16x4 a, s16x4 b) { return (bf16x8){a[0], a[1], a[2], a[3], b[0], b[1], b[2], b[3]}; }
__device__ __forceinline__ bf16x8 pk8(f32x4 a, f32x4 b) { u32x4 w; w.x = pk2(a[0], a[1]); w.y = pk2(a[2], a[3]); w.z = pk2(b[0], b[1]); w.w = pk2(b[2], b[3]); return __builtin_bit_cast(bf16x8, w); }
#define MFMA16(a, b, c) __builtin_amdgcn_mfma_f32_16x16x32_bf16((a), (b), (c), 0, 0, 0)

namespace pg8 {
#define PG8_LAS __attribute__((address_space(3)))
typedef unsigned short bf16_t;
typedef short bf16x8 __attribute__((ext_vector_type(8)));
typedef float f32x4 __attribute__((ext_vector_type(4)));
typedef unsigned u32x4 __attribute__((ext_vector_type(4)));
constexpr int BM = 256, BK = 64, HALF = 128, HTB = HALF * BK * 2  , STAGE_BYTES = 8 * HTB, NXCD = 8, WGM = 8;

__host__ __device__ __forceinline__ int lds_byte(int r, int c) { const int st = (r >> 4) * 2 + (c >> 5), rr = r & 15, cc = c & 31, ob = rr * 64 + cc * 2; return st * 1024 + (ob ^ (((ob >> 9) & 1) << 5)); }
__host__ __device__ __forceinline__ void stage_rc(int b, int& R, int& C) { const int st = b / 1024, sb = b % 1024, swz = sb ^ (((sb >> 9) & 1) << 5); R = (st >> 1) * 16 + swz / 64; C = (st & 1) * 32 + (swz % 64) / 2; }
__host__ __device__ __forceinline__ int perm32(int rho) { const int n = rho >> 4, i = rho & 15; return 8 * (i >> 2) + 4 * n + (i & 3); }

struct Unit { int pm, pn; };
struct Gemm { const bf16_t* A; const bf16_t* Bt; int M, N, K; const bf16_t* A2; int lda, kmid; };

struct StaticOrder {
    int nM, nN, nwg, G, c;
    __host__ __device__ void init(int M, int N, int G_, int c_) { nM = M / BM; nN = N / BM; nwg = nM * nN; G = G_; c = c_; }
    __host__ __device__ bool next(int i, Unit& u) const {
        const long L = (long)i * G + c; if (L >= nwg) return false;
        int wgid = (int)L; { const int q = nwg / NXCD, r = nwg % NXCD, xcd = wgid % NXCD, off = wgid / NXCD; wgid = (xcd < r ? xcd * (q + 1) : r * (q + 1) + (xcd - r) * q) + off; }
        const int nig = WGM * nN, gid = wgid / nig, fm = gid * WGM, gsz = (nM - fm) < WGM ? (nM - fm) : WGM;
        u.pm = fm + ((wgid % nig) % gsz); u.pn = (wgid % nig) / gsz; return true;
    }
    __device__ __forceinline__ void a_ready(const Unit&) const {}
    __device__ __forceinline__ void done(const Unit&) const {}
};

__device__ __forceinline__ unsigned cvt_pk_bf16(float lo, float hi) { unsigned r; asm volatile("v_cvt_pk_bf16_f32 %0, %1, %2" : "=v"(r) : "v"(lo), "v"(hi)); return r; }

__device__ __forceinline__ f32x4 vexp2(f32x4 t) { f32x4 r; r[0] = __builtin_amdgcn_exp2f(t[0]); r[1] = __builtin_amdgcn_exp2f(t[1]); r[2] = __builtin_amdgcn_exp2f(t[2]); r[3] = __builtin_amdgcn_exp2f(t[3]); return r; }
__device__ __forceinline__ f32x4 vrcp(f32x4 t) { f32x4 r; r[0] = __builtin_amdgcn_rcpf(t[0]); r[1] = __builtin_amdgcn_rcpf(t[1]); r[2] = __builtin_amdgcn_rcpf(t[2]); r[3] = __builtin_amdgcn_rcpf(t[3]); return r; }
__device__ __forceinline__ f32x4 vlog2(f32x4 t) { f32x4 r; r[0] = __builtin_amdgcn_logf(t[0]); r[1] = __builtin_amdgcn_logf(t[1]); r[2] = __builtin_amdgcn_logf(t[2]); r[3] = __builtin_amdgcn_logf(t[3]); return r; }
__device__ __forceinline__ f32x4 vsig(f32x4 v) { return vrcp(vexp2(v * -1.4426950408889634f) + 1.f); }
struct EpiProj {
    static constexpr bool PERM = true, AFTER_DRAIN = false; static constexpr size_t MTR = 33280;
    bf16_t *QH, *KH, *VH, *OG, *QA, *KV, *GA, *GB; float* GH; const float* lbv;
    __device__ __forceinline__ void operator()(const f32x4 (&acc)[2][2][4][2], const Unit& u, int wr, int wc, int fr, int fq) const {
        const int pn = u.pn; int mode, ld, cb; bf16_t* dst; float sc = 1.f; bool hm = false;
        if (pn < 2)        { mode = 1; dst = QH; ld = 512;  cb = pn * 256; sc = 0.08838834764831845f; hm = true; }
        else if (pn < 4)   { mode = 3; dst = KH; ld = 512;  cb = (pn - 2) * 256; hm = true; }
        else if (pn < 6)   { mode = 0; dst = VH; ld = 512;  cb = (pn - 4) * 256; hm = true; }
        else if (pn < 8)   { mode = 1; dst = OG; ld = 512;  cb = (pn - 6) * 256; hm = true; }
        else if (pn < 10)  { mode = 0; dst = QA; ld = 512;  cb = (pn - 8) * 256; }
        else if (pn == 10) { mode = 0; dst = KV; ld = 256;  cb = 0; }
        else               { mode = 4; dst = GA; ld = 1024; cb = (pn - 11) * 128; }
        const int row0 = u.pm * BM + wr * 64 + fr, col0 = cb + wc * 32 + 8 * fq;
        if (mode == 4) {
#pragma unroll
            for (int ai = 0; ai < 2; ++ai)
#pragma unroll
                for (int m = 0; m < 4; ++m) {
                    const size_t off = (size_t)(row0 + ai * HALF + m * 16) * 1024 + col0;
                    const f32x4 A0 = vexp2(acc[ai][0][m][0] * -1.4426950408889634f) + 1.f, A1 = vexp2(acc[ai][0][m][1] * -1.4426950408889634f) + 1.f;
                    const f32x4 B0 = vexp2(acc[ai][1][m][0] * -1.4426950408889634f) + 1.f, B1 = vexp2(acc[ai][1][m][1] * -1.4426950408889634f) + 1.f;
                    const f32x4 s0 = vrcp(B0), s1 = vrcp(B1), r0 = B0 * vrcp(A0), r1 = B1 * vrcp(A1);
                    u32x4 w; w.x = pk2(r0[0], r0[1]); w.y = pk2(r0[2], r0[3]); w.z = pk2(r1[0], r1[1]); w.w = pk2(r1[2], r1[3]);
                    *(u32x4*)(GA + off) = w;
                    w.x = pk2(s0[0], s0[1]); w.y = pk2(s0[2], s0[3]); w.z = pk2(s1[0], s1[1]); w.w = pk2(s1[2], s1[3]);
                    *(u32x4*)(GB + off) = w;
                }
            return;
        }
#pragma unroll
        for (int bj = 0; bj < 2; ++bj) {
            const int col = col0 + bj * HALF;
            f32x4 l0 = {0.f, 0.f, 0.f, 0.f}, l1 = l0;
            if (mode == 3) { l0 = *(const f32x4*)(lbv + col); l1 = *(const f32x4*)(lbv + col + 4); }
#pragma unroll
            for (int ai = 0; ai < 2; ++ai)
#pragma unroll
                for (int m = 0; m < 4; ++m) {
                    const size_t row = (size_t)(row0 + ai * HALF + m * 16);
                    f32x4 v0 = acc[ai][bj][m][0], v1 = acc[ai][bj][m][1];
                    if (mode == 1) {
                        v0 = (v0 * sc) * vsig(v0); v1 = (v1 * sc) * vsig(v1);
                    } else if (mode == 3) {
                        const f32x4 f0 = l0 + (1.f - l0) * vsig(v0), f1 = l1 + (1.f - l1) * vsig(v1);
                        const f32x4 g0 = vlog2(f0) * 0.6931471805599453f, g1 = vlog2(f1) * 0.6931471805599453f;
                        v0 = 1.f - f0; v1 = 1.f - f1;
                        float* gp = GH + ((size_t)(col >> 7) * MTR + row) * 128 + (col & 127); *(f32x4*)gp = g0; *(f32x4*)(gp + 4) = g1;
                    }
                    u32x4 w; w.x = pk2(v0[0], v0[1]); w.y = pk2(v0[2], v0[3]); w.z = pk2(v1[0], v1[1]); w.w = pk2(v1[2], v1[3]);
                    *(u32x4*)(dst + (hm ? ((size_t)(col >> 7) * MTR + row) * 128 + (col & 127) : row * ld + col)) = w;
                }
        }
    }
};
template <bool ADD> struct EpiGate {
    static constexpr bool PERM = true, AFTER_DRAIN = false;
    const bf16_t* gate; const bf16_t* T; bf16_t* O;
    __device__ __forceinline__ void operator()(const f32x4 (&acc)[2][2][4][2], const Unit& u, int wr, int wc, int fr, int fq) const {
        const int row0 = u.pm * BM + wr * 64 + fr, col0 = u.pn * BM + wc * 32 + 8 * fq;
#pragma unroll
        for (int ai = 0; ai < 2; ++ai)
#pragma unroll
            for (int m = 0; m < 4; ++m)
#pragma unroll
                for (int bj = 0; bj < 2; ++bj) {
                    const size_t off = (size_t)(row0 + ai * HALF + m * 16) * 1024 + col0 + bj * HALF;
                    const u32x4 gw = *(const u32x4*)(gate + off);
                    f32x4 v0 = acc[ai][bj][m][0], v1 = acc[ai][bj][m][1];
                    v0[0] *= bflo(gw.x); v0[1] *= bfhi(gw.x); v0[2] *= bflo(gw.y); v0[3] *= bfhi(gw.y);
                    v1[0] *= bflo(gw.z); v1[1] *= bfhi(gw.z); v1[2] *= bflo(gw.w); v1[3] *= bfhi(gw.w);
                    if (ADD) { const u32x4 tw = *(const u32x4*)(T + off);
                        v0[0] += bflo(tw.x); v0[1] += bfhi(tw.x); v0[2] += bflo(tw.y); v0[3] += bfhi(tw.y);
                        v1[0] += bflo(tw.z); v1[1] += bfhi(tw.z); v1[2] += bflo(tw.w); v1[3] += bfhi(tw.w); }
                    u32x4 w; w.x = pk2(v0[0], v0[1]); w.y = pk2(v0[2], v0[3]); w.z = pk2(v1[0], v1[1]); w.w = pk2(v1[2], v1[3]);
                    *(u32x4*)(O + off) = w;
                }
    }
};
struct EpiMerge {
    static constexpr bool PERM = true, AFTER_DRAIN = false;
    const bf16_t* GA; const bf16_t* GB; bf16_t* O;
    __device__ __forceinline__ void mid(f32x4 (&acc)[2][2][4][2], const Unit& u, int wr, int wc, int fr, int fq) const {
        int lane_ = (int)(threadIdx.x & 63); asm volatile("" : "+v"(lane_));
        const int row0 = u.pm * BM + wr * 64 + (lane_ & 15), col0 = u.pn * BM + wc * 32 + 8 * (lane_ >> 4);
#pragma unroll
        for (int ai = 0; ai < 2; ++ai)
#pragma unroll
            for (int m = 0; m < 4; ++m)
#pragma unroll
                for (int bj = 0; bj < 2; ++bj) {
                    const u32x4 a = *(const u32x4*)(GA + (size_t)(row0 + ai * HALF + m * 16) * 1024 + col0 + bj * HALF);
                    acc[ai][bj][m][0] = acc[ai][bj][m][0] * (f32x4){bflo(a.x), bfhi(a.x), bflo(a.y), bfhi(a.y)};
                    acc[ai][bj][m][1] = acc[ai][bj][m][1] * (f32x4){bflo(a.z), bfhi(a.z), bflo(a.w), bfhi(a.w)};
                    if (m == 3 && bj == 1) __builtin_amdgcn_sched_barrier(0);
                }
    }
    __device__ __forceinline__ void operator()(const f32x4 (&acc)[2][2][4][2], const Unit& u, int wr, int wc, int fr, int fq) const {
        const int row0 = u.pm * BM + wr * 64 + fr, col0 = u.pn * BM + wc * 32 + 8 * fq;
#pragma unroll
        for (int ai = 0; ai < 2; ++ai)
#pragma unroll
            for (int m = 0; m < 4; ++m)
#pragma unroll
                for (int bj = 0; bj < 2; ++bj) {
                    const size_t off = (size_t)(row0 + ai * HALF + m * 16) * 1024 + col0 + bj * HALF;
                    const u32x4 gw = *(const u32x4*)(GB + off);
                    const f32x4 v0 = acc[ai][bj][m][0], v1 = acc[ai][bj][m][1];
                    u32x4 w; w.x = pk2(v0[0] * bflo(gw.x), v0[1] * bfhi(gw.x)); w.y = pk2(v0[2] * bflo(gw.y), v0[3] * bfhi(gw.y));
                    w.z = pk2(v1[0] * bflo(gw.z), v1[1] * bfhi(gw.z)); w.w = pk2(v1[2] * bflo(gw.w), v1[3] * bfhi(gw.w));
                    *(u32x4*)(O + off) = w;
                }
    }
};
struct EpiRes1 {
    static constexpr bool PERM = true, AFTER_DRAIN = false;
    const float* xp; bf16_t* X1B; float* sumsq;
    __device__ __forceinline__ void operator()(const f32x4 (&acc)[2][2][4][2], const Unit& u, int wr, int wc, int fr, int fq) const {
        const int row0 = u.pm * BM + wr * 64 + fr, col0 = u.pn * BM + wc * 32 + 8 * fq;
#pragma unroll
        for (int ai = 0; ai < 2; ++ai)
#pragma unroll
            for (int m = 0; m < 4; ++m) {
                const int row = row0 + ai * HALF + m * 16; float ss = 0.f;
#pragma unroll
                for (int bj = 0; bj < 2; ++bj) {
                    const size_t off = (size_t)row * 1024 + col0 + bj * HALF;
                    const f32x4 v0 = acc[ai][bj][m][0] + *(const f32x4*)(xp + off), v1 = acc[ai][bj][m][1] + *(const f32x4*)(xp + off + 4);
                    ss += (v0[0] * v0[0] + v0[1] * v0[1]) + (v0[2] * v0[2] + v0[3] * v0[3]) + (v1[0] * v1[0] + v1[1] * v1[1]) + (v1[2] * v1[2] + v1[3] * v1[3]);
                    u32x4 w; w.x = pk2(v0[0], v0[1]); w.y = pk2(v0[2], v0[3]); w.z = pk2(v1[0], v1[1]); w.w = pk2(v1[2], v1[3]);
                    *(u32x4*)(X1B + off) = w;
                }
                ss += __shfl_xor(ss, 16); ss += __shfl_xor(ss, 32);
                if (fq == 0) atomicAdd(sumsq + row, ss);
            }
    }
};
struct EpiFfn {
    static constexpr bool PERM = true, AFTER_DRAIN = false;
    const float* sumsq; bf16_t* ACT;
    __device__ __forceinline__ void operator()(const f32x4 (&acc)[2][2][4][2], const Unit& u, int wr, int wc, int fr, int fq) const {
        const int row0 = u.pm * BM + wr * 64 + fr, col0 = u.pn * HALF + wc * 32 + 8 * fq;
        float sq[2][4];
#pragma unroll
        for (int ai = 0; ai < 2; ++ai)
#pragma unroll
            for (int m = 0; m < 4; ++m) sq[ai][m] = sumsq[row0 + ai * HALF + m * 16];
#pragma unroll
        for (int ai = 0; ai < 2; ++ai)
#pragma unroll
            for (int m = 0; m < 4; ++m) {
                const int row = row0 + ai * HALF + m * 16;
                const float r = __builtin_amdgcn_rsqf(sq[ai][m] * (1.f / 1024.f) + 1e-6f);
                const float nrl = r * -1.4426950408889634f, r2 = r * r;
                f32x4 o[2];
#pragma unroll
                for (int n = 0; n < 2; ++n) {
                    const f32x4 g = acc[ai][0][m][n], uu = acc[ai][1][m][n];
                    const f32x4 t = g * nrl;
                    f32x4 ex; ex[0] = __builtin_amdgcn_exp2f(t[0]); ex[1] = __builtin_amdgcn_exp2f(t[1]); ex[2] = __builtin_amdgcn_exp2f(t[2]); ex[3] = __builtin_amdgcn_exp2f(t[3]);
                    const f32x4 d = ex + 1.f;
                    f32x4 s; s[0] = __builtin_amdgcn_rcpf(d[0]); s[1] = __builtin_amdgcn_rcpf(d[1]); s[2] = __builtin_amdgcn_rcpf(d[2]); s[3] = __builtin_amdgcn_rcpf(d[3]);
                    o[n] = (g * uu) * (s * r2);
                }
                u32x4 w; w.x = pk2(o[0][0], o[0][1]); w.y = pk2(o[0][2], o[0][3]); w.z = pk2(o[1][0], o[1][1]); w.w = pk2(o[1][2], o[1][3]);
                *(u32x4*)(ACT + (size_t)row * 2816 + col0) = w;
            }
    }
};
struct EpiRes2 {
    static constexpr bool PERM = true, AFTER_DRAIN = false;
    const bf16_t* X1B; float* out;
    __device__ __forceinline__ void operator()(const f32x4 (&acc)[2][2][4][2], const Unit& u, int wr, int wc, int fr, int fq) const {
        const int row0 = u.pm * BM + wr * 64 + fr, col0 = u.pn * BM + wc * 32 + 8 * fq;
#pragma unroll
        for (int ai = 0; ai < 2; ++ai)
#pragma unroll
            for (int m = 0; m < 4; ++m)
#pragma unroll
                for (int bj = 0; bj < 2; ++bj) {
                    const size_t off = (size_t)(row0 + ai * HALF + m * 16) * 1024 + col0 + bj * HALF;
                    const u32x4 xw = *(const u32x4*)(X1B + off);
                    const f32x4 v0 = acc[ai][bj][m][0] + (f32x4){bflo(xw.x), bfhi(xw.x), bflo(xw.y), bfhi(xw.y)}, v1 = acc[ai][bj][m][1] + (f32x4){bflo(xw.z), bfhi(xw.z), bflo(xw.w), bfhi(xw.w)};
                    *(f32x4*)(out + off) = v0; *(f32x4*)(out + off + 4) = v1;
                }
    }
};
template <class Epi, class Sched, bool ALIGN_EPI = false, bool SP2 = false, bool MID = false>
__device__ __forceinline__ void gemm_phase(PG8_LAS unsigned char* lds, const Gemm g, const Sched& S, const Epi& E) {
    const int tid = threadIdx.x, wid = __builtin_amdgcn_readfirstlane(tid >> 6), lane = tid & 63, wr = wid >> 2, wc = wid & 3, fr = lane & 15, fq = lane >> 4;
    const int K = g.K, nt = K / BK;
    const int lda = g.lda ? g.lda : K, kmid = g.kmid ? g.kmid : nt;
    unsigned voffA[2], voffB[2];
#pragma unroll
    for (int i = 0; i < 2; ++i) { int R, C; stage_rc(tid * 16 + i * 8192, R, C); const int Rb = Epi::PERM ? ((R & ~31) + perm32(R & 31)) : R;
        voffA[i] = (unsigned)(R * lda + C) * 2u; voffB[i] = (unsigned)(Rb * K + C) * 2u; }
    const size_t kstep = (size_t)(BK * 2);
    const size_t hstepA = (size_t)HALF * lda * 2, hstepB = (size_t)HALF * K * 2;
    const size_t tstepA = 2 * hstepA, tstepB = 2 * hstepB;
    const long dA2 = g.A2 ? ((const char*)g.A2 - (const char*)g.A) - (long)kmid * (long)kstep : 0l;
    const unsigned ldsw = (unsigned)wid * 1024u;
    const int aoff = lds_byte(wr * 64 + fr, fq * 8), boff = lds_byte(wc * 32 + fr, fq * 8);
#define PG8_SA(b, h) (((b) * 2 + (h)) * HTB)
#define PG8_SB(b, h) ((4 + (b) * 2 + (h)) * HTB)
#define PG8_STAGE(bufoff, gbase, voff) do { _Pragma("unroll") for (int _i = 0; _i < 2; ++_i) \
        __builtin_amdgcn_global_load_lds((const unsigned*)((const char*)(gbase) + (voff)[_i]), (PG8_LAS unsigned*)(lds + (bufoff) + ldsw + _i * 8192), 16, 0, 0); } while (0)
#define PG8_LDA(dst, b, h) do { _Pragma("unroll") for (int m = 0; m < 4; ++m) _Pragma("unroll") for (int k = 0; k < 2; ++k) dst[m][k] = *(const PG8_LAS bf16x8*)(lds + PG8_SA(b, h) + aoff + m * 2048 + k * 1024); } while (0)
#define PG8_LDB(dst, b, h) do { _Pragma("unroll") for (int n = 0; n < 2; ++n) _Pragma("unroll") for (int k = 0; k < 2; ++k) dst[n][k] = *(const PG8_LAS bf16x8*)(lds + PG8_SB(b, h) + boff + n * 2048 + k * 1024); } while (0)
#define PG8_MMA(ai, bj, At, Bt) do { __builtin_amdgcn_s_setprio(1); _Pragma("unroll") for (int m = 0; m < 4; ++m) _Pragma("unroll") for (int n = 0; n < 2; ++n) _Pragma("unroll") for (int k = 0; k < 2; ++k) \
        acc[ai][bj][m][n] = __builtin_amdgcn_mfma_f32_16x16x32_bf16(Bt[n][k], At[m][k], acc[ai][bj][m][n], 0, 0, 0); __builtin_amdgcn_s_setprio(0); } while (0)
#define PG8_WAIT_V(n) asm volatile("s_waitcnt vmcnt(" #n ")" ::: "memory")
#define PG8_WAIT_L(n) asm volatile("s_waitcnt lgkmcnt(" #n ")" ::: "memory")
#define PG8_BAR __builtin_amdgcn_s_barrier()
#define PG8_SCHED __builtin_amdgcn_sched_barrier(0)
    Unit cur, nxt; int ui = 0;
    if (!S.next(0, cur)) return;
    f32x4 acc[2][2][4][2];
#pragma unroll
    for (int a = 0; a < 2; ++a)
#pragma unroll
        for (int b = 0; b < 2; ++b)
#pragma unroll
            for (int m = 0; m < 4; ++m)
#pragma unroll
                for (int n = 0; n < 2; ++n) acc[a][b][m][n] = (f32x4){0.f, 0.f, 0.f, 0.f};
    bf16x8 At[4][2], B0[2][2], B1[2][2];
    const char* cA = (const char*)g.A + (size_t)cur.pm * tstepA; const char* cB = (const char*)g.Bt + (size_t)cur.pn * tstepB;
    S.a_ready(cur);
    if constexpr (SP2) {
        PG8_STAGE(PG8_SB(0, 0), cB, voffB); PG8_STAGE(PG8_SB(0, 1), cB + hstepB, voffB); PG8_STAGE(PG8_SA(0, 0), cA, voffA); PG8_STAGE(PG8_SA(0, 1), cA + hstepA, voffA);
        if (wr == 1) PG8_BAR;
        PG8_WAIT_V(2); PG8_BAR;
        PG8_STAGE(PG8_SB(1, 0), cB + kstep, voffB); PG8_STAGE(PG8_SA(1, 0), cA + kstep, voffA); PG8_STAGE(PG8_SB(1, 1), cB + hstepB + kstep, voffB);
        PG8_WAIT_V(6); PG8_BAR;
    } else {
        PG8_STAGE(PG8_SB(0, 0), cB, voffB); PG8_STAGE(PG8_SA(0, 0), cA, voffA); PG8_STAGE(PG8_SB(0, 1), cB + hstepB, voffB); PG8_STAGE(PG8_SA(0, 1), cA + hstepA, voffA);
        if (wr == 1) PG8_BAR;
        PG8_WAIT_V(4); PG8_BAR;
        PG8_STAGE(PG8_SB(1, 0), cB + kstep, voffB); PG8_STAGE(PG8_SA(1, 0), cA + kstep, voffA); PG8_STAGE(PG8_SB(1, 1), cB + hstepB + kstep, voffB);
        PG8_WAIT_V(6); PG8_BAR;
    }
    for (;;) {
        const bool has_next = S.next(ui + 1, nxt);
        const char* nA = has_next ? (const char*)g.A + (size_t)nxt.pm * tstepA : cA; const char* nB = has_next ? (const char*)g.Bt + (size_t)nxt.pn * tstepB : cB;
        for (int t = 0; t < nt; t += 2) {
            const bool last = (t == nt - 2);
            const char* a1 = cA + ((t + 1 < kmid) ? 0l : dA2) + (size_t)(t + 1) * kstep;
            const char* a2 = last ? nA : cA + ((t + 2 < kmid) ? 0l : dA2) + (size_t)(t + 2) * kstep; const char* b2 = last ? nB : cB + (size_t)(t + 2) * kstep;
            if constexpr (MID) { if (t == kmid) E.mid(acc, cur, wr, wc, fr, fq); }
            const char* a3 = a2 + kstep; const char* b3 = b2 + kstep;
            if (last && has_next) S.a_ready(nxt);
            if constexpr (SP2) {
            PG8_LDB(B0, 0, 0); PG8_LDB(B1, 0, 1); PG8_SCHED; PG8_LDA(At, 0, 0); PG8_STAGE(PG8_SA(1, 1), a1 + hstepA, voffA);
            PG8_WAIT_V(8); PG8_WAIT_L(0); PG8_BAR; PG8_MMA(0, 0, At, B0); PG8_MMA(0, 1, At, B1); PG8_BAR; PG8_SCHED;
            PG8_LDA(At, 0, 1); PG8_STAGE(PG8_SB(0, 0), b2, voffB); PG8_STAGE(PG8_SB(0, 1), b2 + hstepB, voffB); PG8_STAGE(PG8_SA(0, 0), a2, voffA);
            PG8_WAIT_V(8); PG8_WAIT_L(0); PG8_BAR; PG8_MMA(1, 0, At, B0); PG8_MMA(1, 1, At, B1); PG8_BAR; PG8_SCHED;
            PG8_LDB(B0, 1, 0); PG8_LDB(B1, 1, 1); PG8_SCHED; PG8_LDA(At, 1, 0); PG8_STAGE(PG8_SA(0, 1), a2 + hstepA, voffA);
            PG8_WAIT_V(8); PG8_WAIT_L(0); PG8_BAR; PG8_MMA(0, 0, At, B0); PG8_MMA(0, 1, At, B1); PG8_BAR; PG8_SCHED;
            PG8_LDA(At, 1, 1); PG8_STAGE(PG8_SB(1, 0), b3, voffB); PG8_STAGE(PG8_SB(1, 1), b3 + hstepB, voffB); PG8_STAGE(PG8_SA(1, 0), a3, voffA);
            PG8_WAIT_V(8); PG8_WAIT_L(0); PG8_BAR; PG8_MMA(1, 0, At, B0); PG8_MMA(1, 1, At, B1); PG8_BAR; PG8_SCHED;
            } else {
            PG8_LDB(B0, 0, 0); PG8_SCHED; PG8_LDA(At, 0, 0); PG8_STAGE(PG8_SA(1, 1), a1 + hstepA, voffA);
            PG8_WAIT_L(8); PG8_BAR; PG8_WAIT_L(0); PG8_MMA(0, 0, At, B0); PG8_BAR; PG8_SCHED;
            PG8_LDB(B1, 0, 1); PG8_STAGE(PG8_SB(0, 0), b2, voffB);
            PG8_BAR; PG8_WAIT_L(0); PG8_MMA(0, 1, At, B1); PG8_BAR;
            PG8_LDA(At, 0, 1); PG8_STAGE(PG8_SA(0, 0), a2, voffA);
            PG8_BAR; PG8_WAIT_L(0); PG8_MMA(1, 0, At, B0); PG8_BAR; PG8_SCHED;
            PG8_STAGE(PG8_SB(0, 1), b2 + hstepB, voffB);
            PG8_WAIT_V(6); PG8_BAR; PG8_MMA(1, 1, At, B1); PG8_BAR;
            PG8_LDB(B0, 1, 0); PG8_SCHED; PG8_LDA(At, 1, 0); PG8_STAGE(PG8_SA(0, 1), a2 + hstepA, voffA);
            PG8_WAIT_L(8); PG8_BAR; PG8_WAIT_L(0); PG8_MMA(0, 0, At, B0); PG8_BAR; PG8_SCHED;
            PG8_LDB(B1, 1, 1); PG8_STAGE(PG8_SB(1, 0), b3, voffB);
            PG8_BAR; PG8_WAIT_L(0); PG8_MMA(0, 1, At, B1); PG8_BAR;
            PG8_LDA(At, 1, 1); PG8_STAGE(PG8_SA(1, 0), a3, voffA);
            PG8_BAR; PG8_WAIT_L(0); PG8_MMA(1, 0, At, B0); PG8_BAR; PG8_SCHED;
            PG8_STAGE(PG8_SB(1, 1), b3 + hstepB, voffB);
            PG8_WAIT_V(6); PG8_BAR; PG8_MMA(1, 1, At, B1); PG8_BAR;
            }
        }
        if constexpr (ALIGN_EPI) { if (wr == 0) PG8_BAR; }
        if constexpr (!Epi::AFTER_DRAIN) { E(acc, cur, wr, wc, fr, fq); S.done(cur); }
        if (!has_next) break;
#pragma unroll
        for (int a = 0; a < 2; ++a)
#pragma unroll
            for (int b = 0; b < 2; ++b)
#pragma unroll
                for (int m = 0; m < 4; ++m)
#pragma unroll
                    for (int n = 0; n < 2; ++n) acc[a][b][m][n] = (f32x4){0.f, 0.f, 0.f, 0.f};
        cur = nxt; cA = nA; cB = nB; ++ui;
        if constexpr (ALIGN_EPI) { if (wr == 1) PG8_BAR; }
    }
    PG8_WAIT_V(0);
    if constexpr (!ALIGN_EPI) { if (wr == 0) PG8_BAR; }
    PG8_BAR;
    if constexpr (Epi::AFTER_DRAIN) { E.fused(acc, cur, wr, wc, fr, fq, lds, wid, lane); S.done(cur); }
#undef PG8_SA
#undef PG8_SB
#undef PG8_STAGE
#undef PG8_LDA
#undef PG8_LDB
#undef PG8_MMA
#undef PG8_WAIT_V
#undef PG8_WAIT_L
#undef PG8_BAR
#undef PG8_SCHED
}
}

struct Args {
    const float *x_prompt, *x_sample, *state_hgrn, *cache_k, *cache_v, *norm1_w, *w_in, *lb_logits, *hgrn_norm_w, *q_norm_w, *k_norm_w, *sinks,
                *w_o_hgrn, *w_o_attn, *w_out, *norm2_w, *w_ffn_gate, *w_ffn_up, *w_ffn_down;
    float* out; unsigned char* ws; int ph_lo, ph_hi;
};

__device__ __forceinline__ float wave_sum(float v) {
#pragma unroll
    for (int o = 1; o < 64; o <<= 1) v += __shfl_xor(v, o);
    return v;
}

__device__ __forceinline__ void p0_transpose_item(const float* __restrict__ W, int ldw, int K, bf16* WT, int k0, int n0, int drow0, const float* __restrict__ ks, LAS float* scr, int lane, int kofs = 0) {
    float wv[32];
#pragma unroll
    for (int i = 0; i < 32; ++i) wv[i] = W[(size_t)(k0 + 2 * i + (lane >> 5)) * ldw + n0 + (lane & 31)];
#pragma unroll
    for (int i = 0; i < 32; ++i) { const int kk = 2 * i + (lane >> 5); const float s = ks ? ks[k0 + kk] : 1.f; scr[kk * 33 + (lane & 31)] = wv[i] * s; }
    asm volatile("s_waitcnt lgkmcnt(0)" ::: "memory");
    const int c = lane & 7;
#pragma unroll
    for (int j = 0; j < 4; ++j) { const int n = (lane >> 3) + 8 * j; const LAS float* s = scr + (8 * c) * 33 + n;
        u32x4 o; o.x = pk2(s[0 * 33], s[1 * 33]); o.y = pk2(s[2 * 33], s[3 * 33]); o.z = pk2(s[4 * 33], s[5 * 33]); o.w = pk2(s[6 * 33], s[7 * 33]);
        *(u32x4*)(WT + (size_t)(drow0 + n) * K + kofs + k0 + 8 * c) = o; }
    asm volatile("s_waitcnt lgkmcnt(0)" ::: "memory");
}

constexpr int P0_I1 = 16 * 152, P0_NITEMS = 16 * 152 + 2 * 8 * 32 + 16 * 32 + 2 * 16 * 88 + 44 * 32;
__device__ __forceinline__ void p0_weights(const Args& a, unsigned char* lds, int it_lo, int it_hi, int widx, int nwork) {
    const int tid = threadIdx.x, lane = tid & 63, wave = tid >> 6;
    LAS float* scr = (LAS float*)(LAS void*)(lds + wave * 16384);
    unsigned char* ws = a.ws;
    constexpr int I1 = 16 * 152, I2 = 8 * 32, I4 = 16 * 32, I5 = 16 * 88;
    for (int it = it_lo + widx; it < it_hi; it += nwork) {
        int r = it;
        if (r < I1) { const int n0 = 32 * (r % 152);
            const int dr = n0 < 2816 ? n0 : (n0 < 3840 ? 2816 + ((n0 - 2816) >> 7) * 256 + ((n0 - 2816) & 127) : 2816 + ((n0 - 3840) >> 7) * 256 + 128 + ((n0 - 3840) & 127));
            p0_transpose_item(a.w_in, PW, 1024, (bf16*)(ws + WS_W1T), 64 * (r / 152), n0, dr, a.norm1_w, scr, lane); continue; } r -= I1;
        if (r < I2) { p0_transpose_item(a.w_o_hgrn, 1024, 1024, (bf16*)(ws + WS_WOH), 64 * (r / 32), 32 * (r % 32), 32 * (r % 32), nullptr, scr, lane, 0); continue; } r -= I2;
        if (r < I2) { p0_transpose_item(a.w_o_attn, 1024, 1024, (bf16*)(ws + WS_WOH), 64 * (r / 32), 32 * (r % 32), 32 * (r % 32), nullptr, scr, lane, 512); continue; } r -= I2;
        if (r < I4) { p0_transpose_item(a.w_out, 1024, 1024, (bf16*)(ws + WS_WOUT), 64 * (r / 32), 32 * (r % 32), 32 * (r % 32), nullptr, scr, lane); continue; } r -= I4;
        if (r < I5) { const int n0 = 32 * (r % 88); p0_transpose_item(a.w_ffn_gate, DFF, 1024, (bf16*)(ws + WS_WGU), 64 * (r / 88), n0, (n0 >> 7) * 256 + (n0 & 127), a.norm2_w, scr, lane); continue; } r -= I5;
        if (r < I5) { const int n0 = 32 * (r % 88); p0_transpose_item(a.w_ffn_up, DFF, 1024, (bf16*)(ws + WS_WGU), 64 * (r / 88), n0, (n0 >> 7) * 256 + 128 + (n0 & 127), a.norm2_w, scr, lane); continue; } r -= I5;
        p0_transpose_item(a.w_ffn_down, 1024, DFF, (bf16*)(ws + WS_WD), 64 * (r / 32), 32 * (r % 32), 32 * (r % 32), nullptr, scr, lane);
    }
}
__device__ __forceinline__ void p0_prologue(const Args& a, unsigned char* lds, int w_hi) {
    const int tid = threadIdx.x, lane = tid & 63, wave = tid >> 6;
    const int gw = blockIdx.x * 8 + wave, NGW = gridDim.x * 8;
    unsigned char* ws = a.ws;
    p0_weights(a, lds, 0, w_hi, gw, NGW);
    bf16* XB = (bf16*)(ws + WS_R0);
    for (int m = gw; m < MT; m += 2 * NGW) {
        const int m1 = m + NGW; const bool has1 = m1 < MT;
        const float* xrow0 = (m < MP) ? a.x_prompt + (size_t)m * 1024 : a.x_sample + (size_t)(m - MP) * 1024;
        const float* xrow1 = !has1 ? xrow0 : (m1 < MP) ? a.x_prompt + (size_t)m1 * 1024 : a.x_sample + (size_t)(m1 - MP) * 1024;
        const f32x4* xr0 = (const f32x4*)xrow0 + lane; const f32x4* xr1 = (const f32x4*)xrow1 + lane;
        f32x4 v[4], u[4]; float s0 = 0.f, s1 = 0.f;
#pragma unroll
        for (int j = 0; j < 4; ++j) { v[j] = xr0[64 * j]; u[j] = xr1[64 * j]; }
#pragma unroll
        for (int j = 0; j < 4; ++j) { s0 += (v[j][0] * v[j][0] + v[j][1] * v[j][1]) + (v[j][2] * v[j][2] + v[j][3] * v[j][3]); s1 += (u[j][0] * u[j][0] + u[j][1] * u[j][1]) + (u[j][2] * u[j][2] + u[j][3] * u[j][3]); }
        const float r0 = __builtin_amdgcn_rsqf(wave_sum(s0) * (1.f / 1024.f) + EPS), r1 = __builtin_amdgcn_rsqf(wave_sum(s1) * (1.f / 1024.f) + EPS);
        u32x2* o0 = (u32x2*)(XB + (size_t)m * 1024) + lane; u32x2* o1 = (u32x2*)(XB + (size_t)m1 * 1024) + lane;
#pragma unroll
        for (int j = 0; j < 4; ++j) { u32x2 w; w.x = pk2(v[j][0] * r0, v[j][1] * r0); w.y = pk2(v[j][2] * r0, v[j][3] * r0); o0[64 * j] = w; }
        if (has1) {
#pragma unroll
            for (int j = 0; j < 4; ++j) { u32x2 w; w.x = pk2(u[j][0] * r1, u[j][1] * r1); w.y = pk2(u[j][2] * r1, u[j][3] * r1); o1[64 * j] = w; }
        }
    }
    float* sumsq = (float*)(ws + WS_SUMSQ);
    for (int i = blockIdx.x * NTHREADS + tid; i < MT; i += gridDim.x * NTHREADS) sumsq[i] = 0.f;
    if (blockIdx.x == 0) { float* lbv = (float*)(ws + WS_LBV); lbv[tid] = sigm(a.lb_logits[tid] - a.lb_logits[512 + tid]); }
}

__device__ __forceinline__ void hgrn_local_phase(const Args& a, unsigned char* lds) {
    const int tid = threadIdx.x, lane = tid & 63, wid = tid >> 6, G = gridDim.x;
    float* cumS = (float*)lds; float* segT = (float*)(lds + 32768); bf16* KdS = (bf16*)(lds + 34816); bf16* VS = (bf16*)(lds + 52224);
    unsigned char* ws = a.ws;
    constexpr int N_LOC = 512 * 4;
    f32x4 gr[4]; u32x4 vr[2];
    int it = blockIdx.x;
#define HL_LOAD(IT) do { const size_t r0_ = (size_t)((IT) >> 2) * 64; const int h_ = (IT) & 3; \
        const size_t ho_ = ((size_t)h_ * MT + r0_) * 128; const float* G_ = (const float*)(ws + WS_R3) + ho_; const bf16* V_ = (const bf16*)(ws + WS_R4) + ho_; \
        _Pragma("unroll") for (int i = 0; i < 4; ++i) { const int idx = tid + 512 * i; gr[i] = *(const f32x4*)(G_ + 4 * idx); } \
        _Pragma("unroll") for (int i = 0; i < 2; ++i) { const int idx = tid + 512 * i; vr[i] = *(const u32x4*)(V_ + 8 * idx); } } while (0)
    if (it < N_LOC) HL_LOAD(it);
    for (; it < N_LOC; it += G) {
        const int cidx = it >> 2, h = it & 3;
        const size_t r0 = (size_t)cidx * 64;
        float* Gp = (float*)(ws + WS_R3) + ((size_t)h * MT + r0) * 128;
#pragma unroll
        for (int i = 0; i < 4; ++i) { const int idx = tid + 512 * i, j = idx >> 5, k4 = (idx & 31) * 4; *(f32x4*)(cumS + j * 128 + k4) = gr[i]; }
        __syncthreads();
        {
            const int k = tid & 127, seg = tid >> 7; float v[16]; float run = 0.f;
#pragma unroll
            for (int i = 0; i < 16; ++i) { run += cumS[(seg * 16 + i) * 128 + k]; v[i] = run; }
            segT[seg * 128 + k] = run;
            __syncthreads();
            float off = 0.f;
#pragma unroll
            for (int s = 0; s < 3; ++s) off += (s < seg) ? segT[s * 128 + k] : 0.f;
#pragma unroll
            for (int i = 0; i < 16; ++i) cumS[(seg * 16 + i) * 128 + k] = v[i] + off;
        }
        __syncthreads();
#pragma unroll
        for (int i = 0; i < 4; ++i) { const int idx = tid + 512 * i; *(f32x4*)(Gp + 4 * idx) = *(const f32x4*)(cumS + 4 * idx); }
        if (tid < 128) ((float*)(ws + WS_DT))[(size_t)(cidx * 4 + h) * 128 + tid] = __expf(cumS[63 * 128 + tid]);
#pragma unroll
        for (int i = 0; i < 2; ++i) {
            const int idx = tid + 512 * i, j = idx >> 4, k8 = (idx & 15) * 8;
            const f32x4 c0 = *(const f32x4*)(cumS + j * 128 + k8), c1 = *(const f32x4*)(cumS + j * 128 + k8 + 4);
            const f32x4 z4 = {0.f, 0.f, 0.f, 0.f};
            const f32x4 p0 = j ? *(const f32x4*)(cumS + (j - 1) * 128 + k8) : z4, p1 = j ? *(const f32x4*)(cumS + (j - 1) * 128 + k8 + 4) : z4;
            const f32x4 l0 = *(const f32x4*)(cumS + 63 * 128 + k8), l1 = *(const f32x4*)(cumS + 63 * 128 + k8 + 4);
            float kk[8];
#pragma unroll
            for (int x = 0; x < 4; ++x) { kk[x] = 1.f - __expf(c0[x] - p0[x]); kk[4 + x] = 1.f - __expf(c1[x] - p1[x]); }
            u32x4 w;
            w.x = pk2(kk[0] * __expf(l0[0] - c0[0]), kk[1] * __expf(l0[1] - c0[1]));
            w.y = pk2(kk[2] * __expf(l0[2] - c0[2]), kk[3] * __expf(l0[3] - c0[3]));
            w.z = pk2(kk[4] * __expf(l1[0] - c1[0]), kk[5] * __expf(l1[1] - c1[1]));
            w.w = pk2(kk[6] * __expf(l1[2] - c1[2]), kk[7] * __expf(l1[3] - c1[3]));
            *(u32x4*)(KdS + j * 136 + k8) = w;
            *(u32x4*)(VS + j * 136 + k8) = vr[i];
        }
        __syncthreads();
        if (it + G < N_LOC) HL_LOAD(it + G);
        {
            const int i16 = lane & 15, g = lane >> 4, q = i16 >> 2, p = i16 & 3;
            bf16x8 af[2];
#pragma unroll
            for (int jc = 0; jc < 2; ++jc) af[jc] = cat8(tr_read(KdS + (32 * jc + 8 * g + q) * 136 + 16 * wid + 4 * p), tr_read(KdS + (32 * jc + 8 * g + 4 + q) * 136 + 16 * wid + 4 * p));
            bf16* SLT = (bf16*)(ws + WS_R0) + (size_t)(cidx * 4 + h) * 16384;
#pragma unroll
            for (int nt = 0; nt < 8; ++nt) {
                f32x4 acc = {0.f, 0.f, 0.f, 0.f};
#pragma unroll
                for (int jc = 0; jc < 2; ++jc) {
                    const bf16x8 bfr = cat8(tr_read(VS + (32 * jc + 8 * g + q) * 136 + 16 * nt + 4 * p), tr_read(VS + (32 * jc + 8 * g + 4 + q) * 136 + 16 * nt + 4 * p));
                    acc = MFMA16(af[jc], bfr, acc);
                }
                u32x2 w; w.x = pk2(acc[0], acc[1]); w.y = pk2(acc[2], acc[3]);
                *(u32x2*)(SLT + (size_t)(16 * nt + i16) * 128 + 16 * wid + 4 * g) = w;
            }
        }
        __syncthreads();
    }
#undef HL_LOAD
}

__device__ __forceinline__ void attn_prompt_item(const Args& a, int b, int qb, int kvh, unsigned char* lds) {
    const int tid = threadIdx.x, lane = tid & 63, wid = __builtin_amdgcn_readfirstlane(tid >> 6);
    bf16* KS = (bf16*)lds; bf16* VS = (bf16*)(lds + 36864);
    unsigned char* ws = a.ws;
    const bf16* QA = (const bf16*)(ws + WS_R6); const bf16* KV = (const bf16*)(ws + WS_R7); bf16* YB = (bf16*)(ws + WS_R10);
    {
        const int key = tid >> 1, half = tid & 1;
        u32x4 kw[4], vw[4];
        const bool zero = (qb == 0 && key < 128);
        const size_t row = (size_t)b * SEQ + (size_t)(qb - 1) * 128 + key;
#pragma unroll
        for (int c = 0; c < 4; ++c) {
            if (zero) { kw[c] = (u32x4){0u, 0u, 0u, 0u}; vw[c] = kw[c]; }
            else { kw[c] = *(const u32x4*)(KV + row * 256 + kvh * 64 + half * 32 + 8 * c); vw[c] = *(const u32x4*)(KV + row * 256 + 128 + kvh * 64 + half * 32 + 8 * c); }
        }
        float ss = 0.f;
#pragma unroll
        for (int c = 0; c < 4; ++c) { const float e0 = bflo(kw[c].x), e1 = bfhi(kw[c].x), e2 = bflo(kw[c].y), e3 = bfhi(kw[c].y), e4 = bflo(kw[c].z), e5 = bfhi(kw[c].z), e6 = bflo(kw[c].w), e7 = bfhi(kw[c].w);
            ss += (e0 * e0 + e1 * e1) + (e2 * e2 + e3 * e3) + (e4 * e4 + e5 * e5) + (e6 * e6 + e7 * e7); }
        ss += __shfl_xor(ss, 1);
        const float rstd = __builtin_amdgcn_rsqf(ss * (1.f / 64.f) + EPS);
        const bool wr_cache = (qb == SEQ / 128 - 1) && key >= 128;
        float* ck = a.out + O_KP + ((size_t)(b * 128 + (key - 128)) * 2 + kvh) * 64 + half * 32;
        float* cv = a.out + O_VP + ((size_t)(b * 128 + (key - 128)) * 2 + kvh) * 64 + half * 32;
#pragma unroll
        for (int c = 0; c < 4; ++c) {
            const f32x4 w0 = *(const f32x4*)(a.k_norm_w + half * 32 + 8 * c), w1 = *(const f32x4*)(a.k_norm_w + half * 32 + 8 * c + 4);
            f32x4 n0, n1;
            n0[0] = bflo(kw[c].x) * rstd * w0[0]; n0[1] = bfhi(kw[c].x) * rstd * w0[1]; n0[2] = bflo(kw[c].y) * rstd * w0[2]; n0[3] = bfhi(kw[c].y) * rstd * w0[3];
            n1[0] = bflo(kw[c].z) * rstd * w1[0]; n1[1] = bfhi(kw[c].z) * rstd * w1[1]; n1[2] = bflo(kw[c].w) * rstd * w1[2]; n1[3] = bfhi(kw[c].w) * rstd * w1[3];
            u32x4 w; w.x = pk2(n0[0], n0[1]); w.y = pk2(n0[2], n0[3]); w.z = pk2(n1[0], n1[1]); w.w = pk2(n1[2], n1[3]);
            *(u32x4*)(KS + key * 72 + half * 32 + 8 * c) = w;
            *(u32x4*)(VS + key * 72 + half * 32 + 8 * c) = vw[c];
            if (wr_cache) {
                *(f32x4*)(ck + 8 * c) = n0; *(f32x4*)(ck + 8 * c + 4) = n1;
                *(f32x4*)(cv + 8 * c) = (f32x4){bflo(vw[c].x), bfhi(vw[c].x), bflo(vw[c].y), bfhi(vw[c].y)};
                *(f32x4*)(cv + 8 * c + 4) = (f32x4){bflo(vw[c].z), bfhi(vw[c].z), bflo(vw[c].w), bfhi(vw[c].w)};
            }
        }
    }
    __syncthreads();
    const int i16 = lane & 15, g = lane >> 4, q = i16 >> 2, p = i16 & 3;
    const int qt = wid, t0 = qt > 0 ? qt - 1 : 0;
    const size_t row = (size_t)b * SEQ + (size_t)qb * 128 + 16 * qt + i16;
    f32x4 dl2[10];
    {
        const int qz = (qb == 0) ? -1 : 0, band0 = 16 * t0 + 4 * g, dist0 = 128 + 16 * qt + i16 - band0;
#pragma unroll
        for (int t = 0; t < 10; ++t)
#pragma unroll
            for (int r = 0; r < 4; ++r) {
                const int band = band0 + 16 * t + r, dist = dist0 - 16 * t - r;
                const int msk = ((dist | (127 - dist)) >> 31) | (((band - 128) >> 31) & qz);
                dl2[t][r] = msk ? 1e30f : (float)dist * 1.4426950408889634f;
            }
    }
    u32x4 qnx[2];
    qnx[0] = *(const u32x4*)(QA + row * 512 + kvh * 256 + 8 * g); qnx[1] = *(const u32x4*)(QA + row * 512 + kvh * 256 + 32 + 8 * g);
#pragma unroll 1
    for (int g4 = 0; g4 < 4; ++g4) {
        asm volatile("" ::: "memory");
        const int hq = kvh * 4 + g4;
        bf16x8 bq[2];
        {
            u32x4 qw[2]; float ss = 0.f;
            qw[0] = qnx[0]; qw[1] = qnx[1];
            if (g4 < 3) { qnx[0] = *(const u32x4*)(QA + row * 512 + (hq + 1) * 64 + 8 * g); qnx[1] = *(const u32x4*)(QA + row * 512 + (hq + 1) * 64 + 32 + 8 * g); }
#pragma unroll
            for (int c = 0; c < 2; ++c) {
                const float e0 = bflo(qw[c].x), e1 = bfhi(qw[c].x), e2 = bflo(qw[c].y), e3 = bfhi(qw[c].y), e4 = bflo(qw[c].z), e5 = bfhi(qw[c].z), e6 = bflo(qw[c].w), e7 = bfhi(qw[c].w);
                ss += (e0 * e0 + e1 * e1) + (e2 * e2 + e3 * e3) + (e4 * e4 + e5 * e5) + (e6 * e6 + e7 * e7); }
            ss += __shfl_xor(ss, 16); ss += __shfl_xor(ss, 32);
            const float rstd = __builtin_amdgcn_rsqf(ss * (1.f / 64.f) + EPS);
#pragma unroll
            for (int c = 0; c < 2; ++c) {
                const f32x4 w0 = *(const f32x4*)(a.q_norm_w + 32 * c + 8 * g), w1 = *(const f32x4*)(a.q_norm_w + 32 * c + 8 * g + 4);
                u32x4 w;
                w.x = pk2(bflo(qw[c].x) * rstd * w0[0], bfhi(qw[c].x) * rstd * w0[1]); w.y = pk2(bflo(qw[c].y) * rstd * w0[2], bfhi(qw[c].y) * rstd * w0[3]);
                w.z = pk2(bflo(qw[c].z) * rstd * w1[0], bfhi(qw[c].z) * rstd * w1[1]); w.w = pk2(bflo(qw[c].w) * rstd * w1[2], bfhi(qw[c].w) * rstd * w1[3]);
                bq[c] = __builtin_bit_cast(bf16x8, w);
            }
        }
        const float nslope = -exp2f(-(float)(hq + 1)), sink2 = a.sinks[hq] * 1.4426950408889634f;
        f32x4 sc[10]; float mx = -3.0e38f;
#pragma unroll
        for (int t = 0; t < 10; ++t) {
            f32x4 s = {0.f, 0.f, 0.f, 0.f};
#pragma unroll
            for (int c = 0; c < 2; ++c) s = MFMA16(*(const bf16x8*)(KS + (16 * (t0 + t) + i16) * 72 + 32 * c + 8 * g), bq[c], s);
#pragma unroll
            for (int r = 0; r < 4; ++r) { s[r] = fmaf(s[r], 0.125f * 1.4426950408889634f, nslope * dl2[t][r]); mx = fmaxf(mx, s[r]); }
            sc[t] = s;
        }
        mx = fmaxf(mx, __shfl_xor(mx, 16)); mx = fmaxf(mx, __shfl_xor(mx, 32)); mx = fmaxf(mx, sink2);
        float sum = 0.f;
#pragma unroll
        for (int t = 0; t < 10; ++t)
#pragma unroll
            for (int r = 0; r < 4; ++r) { const float e = __builtin_amdgcn_exp2f(sc[t][r] - mx); sc[t][r] = e; sum += e; }
        sum += __shfl_xor(sum, 16); sum += __shfl_xor(sum, 32);
        const float inv = 1.f / (sum + __builtin_amdgcn_exp2f(sink2 - mx));
        bf16x8 pb[5];
#pragma unroll
        for (int ch = 0; ch < 5; ++ch) pb[ch] = pk8(sc[2 * ch], sc[2 * ch + 1]);
#pragma unroll
        for (int dt = 0; dt < 4; ++dt) {
            f32x4 acc = {0.f, 0.f, 0.f, 0.f};
#pragma unroll
            for (int ch = 0; ch < 5; ++ch) {
                const bf16x8 av = cat8(tr_read(VS + (16 * (t0 + 2 * ch) + 4 * g + q) * 72 + 16 * dt + 4 * p), tr_read(VS + (16 * (t0 + 2 * ch + 1) + 4 * g + q) * 72 + 16 * dt + 4 * p));
                acc = MFMA16(av, pb[ch], acc);
            }
            u32x2 w; w.x = pk2(acc[0] * inv, acc[1] * inv); w.y = pk2(acc[2] * inv, acc[3] * inv);
            *(u32x2*)(YB + row * 512 + hq * 64 + 16 * dt + 4 * g) = w;
        }
    }
    __syncthreads();
}

__device__ __forceinline__ void attn_sample_item(const Args& a, int b, unsigned char* lds) {
    const int tid = threadIdx.x;
    float* qn = (float*)lds; float* knew = (float*)(lds + 8192); float* vnew = (float*)(lds + 10240); float* sc = (float*)(lds + 12288); float* invs = (float*)(lds + 29696); float* cb = (float*)(lds + 32768);
    unsigned char* ws = a.ws;
    const bf16* QA = (const bf16*)(ws + WS_R6); const bf16* KV = (const bf16*)(ws + WS_R7); bf16* YB = (bf16*)(ws + WS_R10);
    const size_t rb = (size_t)MP + (size_t)b * 4;
    const float* ck = a.cache_k + (size_t)b * 16384; const float* cv = a.cache_v + (size_t)b * 16384;
    f32x4 kreg[8];
#pragma unroll
    for (int i = 0; i < 8; ++i) kreg[i] = *(const f32x4*)(ck + 4 * (tid + 512 * i));
    {
        const int pair = tid >> 4, d4 = (tid & 15) * 4, hq = pair >> 2, t = pair & 3;
        const u32x2 w = *(const u32x2*)(QA + (rb + t) * 512 + hq * 64 + d4);
        const float e0 = bflo(w.x), e1 = bfhi(w.x), e2 = bflo(w.y), e3 = bfhi(w.y);
        float ss = (e0 * e0 + e1 * e1) + (e2 * e2 + e3 * e3);
        ss += __shfl_xor(ss, 1); ss += __shfl_xor(ss, 2); ss += __shfl_xor(ss, 4); ss += __shfl_xor(ss, 8);
        const float rstd = __builtin_amdgcn_rsqf(ss * (1.f / 64.f) + EPS);
        const f32x4 nw = *(const f32x4*)(a.q_norm_w + d4);
        *(f32x4*)(qn + pair * 64 + d4) = (f32x4){e0 * rstd * nw[0], e1 * rstd * nw[1], e2 * rstd * nw[2], e3 * rstd * nw[3]};
    }
    if (tid < 128) {
        const int t = tid >> 5, kvh = (tid >> 4) & 1, d4 = (tid & 15) * 4;
        const u32x2 w = *(const u32x2*)(KV + (rb + t) * 256 + kvh * 64 + d4);
        const float e0 = bflo(w.x), e1 = bfhi(w.x), e2 = bflo(w.y), e3 = bfhi(w.y);
        float ss = (e0 * e0 + e1 * e1) + (e2 * e2 + e3 * e3);
        ss += __shfl_xor(ss, 1); ss += __shfl_xor(ss, 2); ss += __shfl_xor(ss, 4); ss += __shfl_xor(ss, 8);
        const float rstd = __builtin_amdgcn_rsqf(ss * (1.f / 64.f) + EPS);
        const f32x4 nw = *(const f32x4*)(a.k_norm_w + d4);
        *(f32x4*)(knew + t * 128 + kvh * 64 + d4) = (f32x4){e0 * rstd * nw[0], e1 * rstd * nw[1], e2 * rstd * nw[2], e3 * rstd * nw[3]};
        const u32x2 v = *(const u32x2*)(KV + (rb + t) * 256 + 128 + kvh * 64 + d4);
        *(f32x4*)(vnew + t * 128 + kvh * 64 + d4) = (f32x4){bflo(v.x), bfhi(v.x), bflo(v.y), bfhi(v.y)};
    }
    {
        float* ok = a.out + O_KS + (size_t)b * 16384;
#pragma unroll
        for (int i = 0; i < 8; ++i) { const int f = 4 * (tid + 512 * i); *(f32x4*)(cb + f) = kreg[i];
            if (f >= 512) *(f32x4*)(ok + f - 512) = kreg[i]; }
    }
    __syncthreads();
    if (tid < 128) { const int f = 4 * tid;
        *(f32x4*)(a.out + O_KS + (size_t)b * 16384 + 124 * 128 + f) = *(const f32x4*)(knew + f); *(f32x4*)(a.out + O_VS + (size_t)b * 16384 + 124 * 128 + f) = *(const f32x4*)(vnew + f); }
    for (int idx = tid; idx < 132 * 32; idx += 512) {
        const int key = idx >> 5, pair = idx & 31, hq = pair >> 2, t = pair & 3, kvh = hq >> 2;
        const float* qp = qn + pair * 64; float dot = 0.f;
        const float* kp = key < 128 ? cb + (key * 2 + kvh) * 64 : knew + (key - 128) * 128 + kvh * 64;
#pragma unroll
        for (int d = 0; d < 64; d += 4) { const f32x4 kk = *(const f32x4*)(kp + d), qq = *(const f32x4*)(qp + d); dot += (kk[0] * qq[0] + kk[1] * qq[1]) + (kk[2] * qq[2] + kk[3] * qq[3]); }
        const int dist = key < 128 ? t + 128 - key : t - (key - 128);
        const bool valid = dist >= 0 && dist < 128;
        sc[pair * 136 + key] = valid ? dot * 0.125f - exp2f(-(float)(hq + 1)) * (float)dist : -1e30f;
    }
    __syncthreads();
    f32x4 vreg[8];
#pragma unroll
    for (int i = 0; i < 8; ++i) vreg[i] = *(const f32x4*)(cv + 4 * (tid + 512 * i));
    {
        const int pair = tid >> 4, l16 = tid & 15, hq = pair >> 2; const float sink = a.sinks[hq];
        float mx = -3.0e38f;
        for (int key = l16; key < 132; key += 16) mx = fmaxf(mx, sc[pair * 136 + key]);
        mx = fmaxf(mx, __shfl_xor(mx, 1)); mx = fmaxf(mx, __shfl_xor(mx, 2)); mx = fmaxf(mx, __shfl_xor(mx, 4)); mx = fmaxf(mx, __shfl_xor(mx, 8));
        mx = fmaxf(mx, sink);
        float sum = 0.f;
        for (int key = l16; key < 132; key += 16) { const float e = __expf(sc[pair * 136 + key] - mx); sc[pair * 136 + key] = e; sum += e; }
        sum += __shfl_xor(sum, 1); sum += __shfl_xor(sum, 2); sum += __shfl_xor(sum, 4); sum += __shfl_xor(sum, 8);
        if (l16 == 0) invs[pair] = 1.f / (sum + __expf(sink - mx));
    }
    { float* ov = a.out + O_VS + (size_t)b * 16384;
#pragma unroll
      for (int i = 0; i < 8; ++i) { const int f = 4 * (tid + 512 * i); *(f32x4*)(cb + f) = vreg[i]; if (f >= 512) *(f32x4*)(ov + f - 512) = vreg[i]; } }
    __syncthreads();
    {
        const int pair = tid >> 4, d4 = (tid & 15) * 4, hq = pair >> 2, t = pair & 3, kvh = hq >> 2;
        f32x4 acc = {0.f, 0.f, 0.f, 0.f};
#pragma unroll 8
        for (int key = 0; key < 128; ++key) { const float pv = sc[pair * 136 + key]; acc += pv * *(const f32x4*)(cb + (key * 2 + kvh) * 64 + d4); }
#pragma unroll
        for (int key = 0; key < 4; ++key) { const float pv = sc[pair * 136 + 128 + key]; acc += pv * *(const f32x4*)(vnew + key * 128 + kvh * 64 + d4); }
        const float inv = invs[pair];
        u32x2 w; w.x = pk2(acc[0] * inv, acc[1] * inv); w.y = pk2(acc[2] * inv, acc[3] * inv);
        *(u32x2*)(YB + (rb + t) * 512 + hq * 64 + d4) = w;
    }
    __syncthreads();
}

__device__ __forceinline__ void hgrn_scan(const Args& a, int sb, int ns, unsigned char* lds) {
    unsigned char* ws = a.ws;
    bf16* SLT = (bf16*)(ws + WS_R0); const float* DT = (const float*)(ws + WS_DT);
    float* dts = (float*)lds;
    for (int e0 = sb * NTHREADS; e0 < 4 * 4 * 128 * 16; e0 += ns * NTHREADS) {
        const int e = e0 + threadIdx.x;
        const int k8 = (e & 15) * 8, v = (e >> 4) & 127, h = (e0 >> 11) & 3, b = e0 >> 13;
        __syncthreads();
#pragma unroll
        for (int i = 0; i < 8; ++i) { const int idx = threadIdx.x + 512 * i, c = idx >> 5, k4 = (idx & 31) * 4; *(f32x4*)(dts + c * 128 + k4) = *(const f32x4*)(DT + (size_t)((b * 128 + c) * 4 + h) * 128 + k4); }
        __syncthreads();
        float st[8];
#pragma unroll
        for (int j = 0; j < 8; ++j) st[j] = 0.f;
        for (int c0 = 0; c0 < 128; c0 += 16) {
            u32x4 loc[16];
#pragma unroll
            for (int i = 0; i < 16; ++i) { const size_t ci = (size_t)((b * 128 + c0 + i) * 4 + h); loc[i] = *(const u32x4*)(SLT + (ci * 128 + v) * 128 + k8); }
#pragma unroll
            for (int i = 0; i < 16; ++i) { const size_t ci = (size_t)((b * 128 + c0 + i) * 4 + h);
                const f32x4 d0 = *(const f32x4*)(dts + (c0 + i) * 128 + k8), d1 = *(const f32x4*)(dts + (c0 + i) * 128 + k8 + 4);
                u32x4 w; w.x = pk2(st[0], st[1]); w.y = pk2(st[2], st[3]); w.z = pk2(st[4], st[5]); w.w = pk2(st[6], st[7]);
                *(u32x4*)(SLT + (ci * 128 + v) * 128 + k8) = w;
                st[0] = d0[0] * st[0] + bflo(loc[i].x); st[1] = d0[1] * st[1] + bfhi(loc[i].x); st[2] = d0[2] * st[2] + bflo(loc[i].y); st[3] = d0[3] * st[3] + bfhi(loc[i].y);
                st[4] = d1[0] * st[4] + bflo(loc[i].z); st[5] = d1[1] * st[5] + bfhi(loc[i].z); st[6] = d1[2] * st[6] + bflo(loc[i].w); st[7] = d1[3] * st[7] + bfhi(loc[i].w); }
        }
        float* o = a.out + O_SP + ((size_t)(b * 4 + h) * 128 + k8) * 128 + v;
#pragma unroll
        for (int j = 0; j < 8; ++j) o[j * 128] = st[j];
    }
}

__device__ __forceinline__ void hgrn_out_phase(const Args& a, unsigned char* lds) {
    const int tid = threadIdx.x, lane = tid & 63, wid = tid >> 6, G = gridDim.x;
    bf16* QdS = (bf16*)lds; bf16* KxS = (bf16*)(lds + 17408); bf16* VS = (bf16*)(lds + 34816); bf16* SS = (bf16*)(lds + 52224); float* red = (float*)(lds + 87040);
    unsigned char* ws = a.ws;
    constexpr int N_OUT = 512 * 4;
    f32x4 c0r[2], c1r[2]; u32x4 qr[2], kr[2], vr[2], sr[4];
#define HO_LOAD(IT) do { const size_t r0_ = (size_t)((IT) >> 2) * 64; const int h_ = (IT) & 3; \
        const size_t ho_ = ((size_t)h_ * MT + r0_) * 128; const float* CU_ = (const float*)(ws + WS_R3) + ho_; const bf16* Q_ = (const bf16*)(ws + WS_R1) + ho_; \
        const bf16* K_ = (const bf16*)(ws + WS_R2) + ho_; const bf16* V_ = (const bf16*)(ws + WS_R4) + ho_; const bf16* S_ = (const bf16*)(ws + WS_R0) + (size_t)(IT) * 16384; \
        _Pragma("unroll") for (int i = 0; i < 2; ++i) { const int idx = tid + 512 * i; \
            c0r[i] = *(const f32x4*)(CU_ + 8 * idx); c1r[i] = *(const f32x4*)(CU_ + 8 * idx + 4); \
            qr[i] = *(const u32x4*)(Q_ + 8 * idx); kr[i] = *(const u32x4*)(K_ + 8 * idx); vr[i] = *(const u32x4*)(V_ + 8 * idx); } \
        _Pragma("unroll") for (int i = 0; i < 4; ++i) { const int idx = tid + 512 * i, v = idx >> 4, c8 = (idx & 15) * 8; sr[i] = *(const u32x4*)(S_ + (size_t)v * 128 + c8); } } while (0)
    int it = blockIdx.x;
    if (it < N_OUT) HO_LOAD(it);
    for (; it < N_OUT; it += G) {
        const int cidx = it >> 2, h = it & 3;
        const size_t r0 = (size_t)cidx * 64;
        const bf16* OG = (const bf16*)(ws + WS_R5) + ((size_t)h * MT + r0) * 128;
        bf16* YA = (bf16*)(ws + WS_R6) + r0 * 512 + h * 128;
#pragma unroll
        for (int i = 0; i < 2; ++i) {
            const int idx = tid + 512 * i, j = idx >> 4, k8 = (idx & 15) * 8;
            const f32x4 c0 = c0r[i], c1 = c1r[i]; const u32x4 qw = qr[i], kw = kr[i];
            float e[8], ei[8];
#pragma unroll
            for (int x = 0; x < 4; ++x) { e[x] = __expf(c0[x]); e[4 + x] = __expf(c1[x]); ei[x] = __expf(-c0[x]); ei[4 + x] = __expf(-c1[x]); }
            u32x4 w;
            w.x = pk2(bflo(qw.x) * e[0], bfhi(qw.x) * e[1]); w.y = pk2(bflo(qw.y) * e[2], bfhi(qw.y) * e[3]); w.z = pk2(bflo(qw.z) * e[4], bfhi(qw.z) * e[5]); w.w = pk2(bflo(qw.w) * e[6], bfhi(qw.w) * e[7]);
            *(u32x4*)(QdS + j * 136 + k8) = w;
            w.x = pk2(bflo(kw.x) * ei[0], bfhi(kw.x) * ei[1]); w.y = pk2(bflo(kw.y) * ei[2], bfhi(kw.y) * ei[3]); w.z = pk2(bflo(kw.z) * ei[4], bfhi(kw.z) * ei[5]); w.w = pk2(bflo(kw.w) * ei[6], bfhi(kw.w) * ei[7]);
            *(u32x4*)(KxS + j * 136 + k8) = w;
            *(u32x4*)(VS + j * 136 + k8) = vr[i];
        }
#pragma unroll
        for (int i = 0; i < 4; ++i) { const int idx = tid + 512 * i, v = idx >> 4, c8 = (idx & 15) * 8; *(u32x4*)(SS + v * 136 + c8) = sr[i]; }
        __syncthreads();
        if (it + G < N_OUT) HO_LOAD(it + G);
        const int i16 = lane & 15, g = lane >> 4, q = i16 >> 2, p = i16 & 3, tt = wid & 3, vh = wid >> 2;
        u32x2 ogr[4];
#pragma unroll
        for (int vt = 0; vt < 4; ++vt) ogr[vt] = *(const u32x2*)(OG + (size_t)(16 * tt + i16) * 128 + vh * 64 + 16 * vt + 4 * g);
        bf16x8 bq[4];
#pragma unroll
        for (int kc = 0; kc < 4; ++kc) bq[kc] = *(const bf16x8*)(QdS + (16 * tt + i16) * 136 + 32 * kc + 8 * g);
        f32x4 sc[4];
#pragma unroll
        for (int jt = 0; jt < 4; ++jt) {
            f32x4 sv = {0.f, 0.f, 0.f, 0.f};
            if (jt <= tt) {
#pragma unroll
                for (int kc = 0; kc < 4; ++kc) sv = MFMA16(*(const bf16x8*)(KxS + (16 * jt + i16) * 136 + 32 * kc + 8 * g), bq[kc], sv);
                if (jt == tt) {
#pragma unroll
                    for (int r = 0; r < 4; ++r) sv[r] = (4 * g + r > i16) ? 0.f : sv[r];
                }
            }
            sc[jt] = sv;
        }
        bf16x8 pb[2];
        pb[0] = pk8(sc[0], sc[1]); pb[1] = pk8(sc[2], sc[3]);
        f32x4 acc[4]; float ss = 0.f;
#pragma unroll
        for (int vt = 0; vt < 4; ++vt) {
            const int v0 = vh * 64 + 16 * vt;
            f32x4 c = {0.f, 0.f, 0.f, 0.f};
#pragma unroll
            for (int kc = 0; kc < 4; ++kc) c = MFMA16(*(const bf16x8*)(SS + (v0 + i16) * 136 + 32 * kc + 8 * g), bq[kc], c);
#pragma unroll
            for (int jc = 0; jc < 2; ++jc) {
                const bf16x8 av = cat8(tr_read(VS + (32 * jc + 4 * g + q) * 136 + v0 + 4 * p), tr_read(VS + (32 * jc + 16 + 4 * g + q) * 136 + v0 + 4 * p));
                c = MFMA16(av, pb[jc], c);
            }
            acc[vt] = c; ss += (c[0] * c[0] + c[1] * c[1]) + (c[2] * c[2] + c[3] * c[3]);
        }
        ss += __shfl_xor(ss, 16); ss += __shfl_xor(ss, 32);
        if (g == 0) red[vh * 64 + 16 * tt + i16] = ss;
        __syncthreads();
        const float rstd = __builtin_amdgcn_rsqf((red[16 * tt + i16] + red[64 + 16 * tt + i16]) * (1.f / 128.f) + EPS);
#pragma unroll
        for (int vt = 0; vt < 4; ++vt) {
            const int col = vh * 64 + 16 * vt + 4 * g; const size_t t = (size_t)(16 * tt + i16);
            const u32x2 ow = ogr[vt]; const f32x4 nw = *(const f32x4*)(a.hgrn_norm_w + h * 128 + col);
            u32x2 w; w.x = pk2(acc[vt][0] * rstd * nw[0] * bflo(ow.x), acc[vt][1] * rstd * nw[1] * bfhi(ow.x)); w.y = pk2(acc[vt][2] * rstd * nw[2] * bflo(ow.y), acc[vt][3] * rstd * nw[3] * bfhi(ow.y));
            *(u32x2*)(YA + t * 512 + col) = w;
        }
        __syncthreads();
    }
#undef HO_LOAD
}

__device__ __forceinline__ void hgrn_sample_item(const Args& a, int b, int h, unsigned char* lds) {
    const int tid = threadIdx.x, lane = tid & 63, wid = tid >> 6;
    float* part = (float*)lds;
    float* wsum = (float*)(lds + 32768);
    unsigned char* ws = a.ws;
    const int v4 = (tid & 31) * 4, kg = tid >> 5;
    const float* S0 = a.state_hgrn + ((size_t)(b * 4 + h) * 128 + 8 * kg) * 128 + v4;
    float* S1 = a.out + O_SS + ((size_t)(b * 4 + h) * 128 + 8 * kg) * 128 + v4;
    f32x4 S[8];
#pragma unroll
    for (int e = 0; e < 8; ++e) S[e] = *(const f32x4*)(S0 + e * 128);
    const size_t rb = (size_t)MP + (size_t)b * 4;
#pragma unroll
    for (int t = 0; t < 4; ++t) {
        const size_t off = ((size_t)h * MT + rb + t) * 128;
        const f32x4 g0 = *(const f32x4*)((const float*)(ws + WS_R3) + off + 8 * kg), g1 = *(const f32x4*)((const float*)(ws + WS_R3) + off + 8 * kg + 4);
        const u32x4 kw = *(const u32x4*)((const bf16*)(ws + WS_R2) + off + 8 * kg), qw = *(const u32x4*)((const bf16*)(ws + WS_R1) + off + 8 * kg);
        const u32x2 vw = *(const u32x2*)((const bf16*)(ws + WS_R4) + off + v4);
        const f32x4 vv = {bflo(vw.x), bfhi(vw.x), bflo(vw.y), bfhi(vw.y)};
        const float f[8] = {__expf(g0[0]), __expf(g0[1]), __expf(g0[2]), __expf(g0[3]), __expf(g1[0]), __expf(g1[1]), __expf(g1[2]), __expf(g1[3])};
        const float kk[8] = {bflo(kw.x), bfhi(kw.x), bflo(kw.y), bfhi(kw.y), bflo(kw.z), bfhi(kw.z), bflo(kw.w), bfhi(kw.w)};
        const float qq[8] = {bflo(qw.x), bfhi(qw.x), bflo(qw.y), bfhi(qw.y), bflo(qw.z), bfhi(qw.z), bflo(qw.w), bfhi(qw.w)};
        f32x4 po = {0.f, 0.f, 0.f, 0.f};
#pragma unroll
        for (int e = 0; e < 8; ++e) { S[e] = f[e] * S[e] + kk[e] * vv; po += qq[e] * S[e]; }
        *(f32x4*)(part + (t * 16 + kg) * 128 + v4) = po;
    }
#pragma unroll
    for (int e = 0; e < 8; ++e) *(f32x4*)(S1 + e * 128) = S[e];
    __syncthreads();
    const int t = tid >> 7, v = tid & 127;
    float o = 0.f;
#pragma unroll
    for (int k = 0; k < 16; ++k) o += part[(t * 16 + k) * 128 + v];
    const float s2 = wave_sum(o * o);
    if (lane == 0) wsum[wid] = s2;
    __syncthreads();
    const float rstd = __builtin_amdgcn_rsqf((wsum[2 * t] + wsum[2 * t + 1]) * (1.f / 128.f) + EPS);
    const float y = o * rstd * a.hgrn_norm_w[h * 128 + v] * bf2f(((const bf16*)(ws + WS_R5))[((size_t)h * MT + rb + t) * 128 + v]);
    ((bf16*)(ws + WS_YAS))[((size_t)b * 4 + t) * 512 + h * 128 + v] = (bf16)(pk2(y, 0.f) & 0xffffu);
    __syncthreads();
}


template <int K, int LDW = K> __device__ __forceinline__ f32x4 mini_gemm(const bf16* __restrict__ X, const bf16* __restrict__ W, unsigned char* lds, f32x4 acc) {
    const int tid = threadIdx.x, lane = tid & 63, wid = tid >> 6, i16 = lane & 15, g = lane >> 4, rw = wid & 1, cw = wid >> 1;
    const int sr = tid >> 5, sc = (tid & 31) * 8;
    constexpr int NT = K / 256, P = 264, XB_ = 32 * P * 2, BUF = (32 + 64) * P * 2;
    static_assert(K % 256 == 0, "mini_gemm: K must be a multiple of 256");
    const bf16* xp = X + (size_t)sr * K + sc; const bf16* wp = W + (size_t)sr * LDW + sc;
    u32x4 xr[2], wv[4];
#pragma unroll
    for (int i = 0; i < 2; ++i) xr[i] = *(const u32x4*)(xp + (size_t)(16 * i) * K);
#pragma unroll
    for (int i = 0; i < 4; ++i) wv[i] = *(const u32x4*)(wp + (size_t)(16 * i) * LDW);
    __syncthreads();
#pragma unroll 1
    for (int kt = 0; kt < NT; ++kt) {
        unsigned char* b = lds + (kt & 1) * BUF;
#pragma unroll
        for (int i = 0; i < 2; ++i) *(u32x4*)(b + ((sr + 16 * i) * P + sc) * 2) = xr[i];
#pragma unroll
        for (int i = 0; i < 4; ++i) *(u32x4*)(b + XB_ + ((sr + 16 * i) * P + sc) * 2) = wv[i];
        __syncthreads();
        if (kt + 1 < NT) {
#pragma unroll
            for (int i = 0; i < 2; ++i) xr[i] = *(const u32x4*)(xp + (size_t)(16 * i) * K + 256 * (kt + 1));
#pragma unroll
            for (int i = 0; i < 4; ++i) wv[i] = *(const u32x4*)(wp + (size_t)(16 * i) * LDW + 256 * (kt + 1));
        }
        const bf16* xs = (const bf16*)b + (16 * rw + i16) * P + 8 * g; const bf16* wsm = (const bf16*)(b + XB_) + (16 * cw + i16) * P + 8 * g;
#pragma unroll
        for (int kc = 0; kc < 8; ++kc) acc = MFMA16(*(const bf16x8*)(wsm + 32 * kc), *(const bf16x8*)(xs + 32 * kc), acc);
    }
    return acc;
}
#define SAMPLE_TILE_VARS const int lane = threadIdx.x & 63, wid = threadIdx.x >> 6, i16 = lane & 15, g = lane >> 4; \
    const int row0 = MP + 32 * (tile & 15), colb = 64 * (tile >> 4), row = row0 + 16 * (wid & 1) + i16, col0 = colb + 16 * (wid >> 1); const size_t off = (size_t)row * 1024 + col0 + 4 * g
__device__ __forceinline__ void p5_sample(const Args& a, unsigned char* lds) {
    unsigned char* ws = a.ws;
    for (int tile = blockIdx.x; tile < 256; tile += gridDim.x) {
        SAMPLE_TILE_VARS;
        const f32x4 z = {0.f, 0.f, 0.f, 0.f};
        const f32x4 pa = mini_gemm<512, 1024>((const bf16*)(ws + WS_YAS) + (size_t)(row0 - MP) * 512, (const bf16*)(ws + WS_WOH) + (size_t)colb * 1024, lds, z);
        const f32x4 pb = mini_gemm<512, 1024>((const bf16*)(ws + WS_R10) + (size_t)row0 * 512, (const bf16*)(ws + WS_WOH) + (size_t)colb * 1024 + 512, lds, z);
        const u32x2 ga = *(const u32x2*)((const bf16*)(ws + WS_R8) + off), gb = *(const u32x2*)((const bf16*)(ws + WS_R9) + off);
        u32x2 w; w.x = pk2(bflo(gb.x) * (bflo(ga.x) * pa[0] + pb[0]), bfhi(gb.x) * (bfhi(ga.x) * pa[1] + pb[1])); w.y = pk2(bflo(gb.y) * (bflo(ga.y) * pa[2] + pb[2]), bfhi(gb.y) * (bfhi(ga.y) * pa[3] + pb[3]));
        *(u32x2*)((bf16*)(ws + WS_R3) + off) = w;
    }
    __syncthreads();
}
__device__ __forceinline__ void p6_sample(const Args& a, unsigned char* lds) {
    unsigned char* ws = a.ws;
    for (int tile = blockIdx.x; tile < 256; tile += gridDim.x) {
        SAMPLE_TILE_VARS;
        const f32x4 z = {0.f, 0.f, 0.f, 0.f};
        const f32x4 p = mini_gemm<1024>((const bf16*)(ws + WS_R3) + (size_t)row0 * 1024, (const bf16*)(ws + WS_WOUT) + (size_t)colb * 1024, lds, z);
        const f32x4 v = p + *(const f32x4*)(a.x_sample + off - (size_t)MP * 1024);
        u32x2 w; w.x = pk2(v[0], v[1]); w.y = pk2(v[2], v[3]);
        *(u32x2*)((bf16*)(ws + WS_R8) + off) = w;
        float ss = (v[0] * v[0] + v[1] * v[1]) + (v[2] * v[2] + v[3] * v[3]);
        ss += __shfl_xor(ss, 16); ss += __shfl_xor(ss, 32);
        if (g == 0) atomicAdd((float*)(ws + WS_SUMSQ) + row, ss);
    }
    __syncthreads();
}
__device__ __forceinline__ void p8_sample(const Args& a, unsigned char* lds) {
    unsigned char* ws = a.ws;
    for (int tile = blockIdx.x; tile < 256; tile += gridDim.x) {
        SAMPLE_TILE_VARS;
        const f32x4 z = {0.f, 0.f, 0.f, 0.f};
        const f32x4 p = mini_gemm<DFF>((const bf16*)(ws + WS_R0) + (size_t)row0 * DFF, (const bf16*)(ws + WS_WD) + (size_t)colb * DFF, lds, z);
        const u32x2 xw = *(const u32x2*)((const bf16*)(ws + WS_R8) + off);
        *(f32x4*)(a.out + O_Y + off) = (f32x4){p[0] + bflo(xw.x), p[1] + bfhi(xw.x), p[2] + bflo(xw.y), p[3] + bfhi(xw.y)};
    }
    __syncthreads();
}
#define XB_TMO      128
#define XB_XCNT(j)  (256  + 64 * (j))
#define XB_XSUB(j)  (1280 + 64 * (j))
#define XB_XGEN(j)  (2304 + 64 * (j))
#define XB_TOP      3328
#define XB_TOPGEN   3392
#define XCD_BAR_WORDS 3456
#define XB_SPIN_CAP (1u << 18)

__device__ __forceinline__ unsigned xb_ld(unsigned* p)              { return __hip_atomic_load(p, __ATOMIC_RELAXED, __HIP_MEMORY_SCOPE_AGENT); }
__device__ __forceinline__ unsigned xb_add(unsigned* p, unsigned v) { return __hip_atomic_fetch_add(p, v, __ATOMIC_RELAXED, __HIP_MEMORY_SCOPE_AGENT); }
__device__ __forceinline__ unsigned xb_xcc_id() { return (unsigned)__builtin_amdgcn_s_getreg((3 << 11) | 20) & 0xFu; }
#define XB_SPIN(cond, bar) do { unsigned _sp = 0; while (cond) { __builtin_amdgcn_s_sleep(1); \
    if ((++_sp & 255u) == 0u) { if (xb_ld(&(bar)[XB_TMO])) break; if (_sp > XB_SPIN_CAP) { atomicAdd(&(bar)[XB_TMO], 1u); break; } } } } while (0)

struct XcdBarrier {
    unsigned* bar; unsigned x;
    volatile LAS unsigned* st;
};

__device__ __forceinline__ XcdBarrier xcd_barrier_post(unsigned* bar, volatile LAS unsigned* st) {
    XcdBarrier b; b.bar = bar; b.x = xb_xcc_id(); b.st = st;
    if (threadIdx.x == 0) (void)xb_add(&bar[XB_XCNT(b.x)], 1u);
    return b;
}
__device__ __forceinline__ void xcd_barrier_complete(unsigned* bar, unsigned x, unsigned& nloc, unsigned& nx) {
    const unsigned G = gridDim.x * gridDim.y * gridDim.z;
    unsigned sum, cnt, mine, sp = 0u;
    for (;;) {
        sum = 0u; cnt = 0u; mine = 0u;
#pragma unroll
        for (unsigned j = 0; j < 16; ++j) { const unsigned c = xb_ld(&bar[XB_XCNT(j)]); sum += c; cnt += (c > 0u) ? 1u : 0u; mine = (j == x) ? c : mine; }
        if (sum == G) break;
        __builtin_amdgcn_s_sleep(1);
        if ((++sp & 255u) == 0u) { if (xb_ld(&bar[XB_TMO])) break; if (sp > XB_SPIN_CAP) { atomicAdd(&bar[XB_TMO], 1u); break; } }
    }
    nloc = mine > 0u ? mine : 1u; nx = cnt > 0u ? cnt : 1u;
}

__device__ __forceinline__ void xcd_barrier(const XcdBarrier& b) {
    asm volatile("s_waitcnt vmcnt(0)" ::: "memory");
    __syncthreads();
    if (threadIdx.x == 0) {
        unsigned* bar = b.bar;
        __builtin_amdgcn_s_waitcnt(0);
        unsigned nloc = b.st[0], nx = b.st[1];
        if (nloc == 0u) { xcd_barrier_complete(bar, b.x, nloc, nx); b.st[0] = nloc; b.st[1] = nx; }
        const unsigned old = xb_add(&bar[XB_XSUB(b.x)], 1u);
        const unsigned gen = old / nloc;
        if (old + 1u == (gen + 1u) * nloc) {
            __builtin_amdgcn_fence(__ATOMIC_RELEASE, "agent");
            asm volatile("s_waitcnt vmcnt(0)" ::: "memory");
            const unsigned og = xb_add(&bar[XB_TOP], 1u);
            const unsigned tg = og / nx;
            if (og + 1u == (tg + 1u) * nx) xb_add(&bar[XB_TOPGEN], 1u);
            else XB_SPIN(xb_ld(&bar[XB_TOPGEN]) == tg, bar);
            __builtin_amdgcn_fence(__ATOMIC_ACQUIRE, "agent");
            xb_add(&bar[XB_XGEN(b.x)], 1u);
            asm volatile("s_waitcnt vmcnt(0)" ::: "memory");
        } else {
            XB_SPIN(xb_ld(&bar[XB_XGEN(b.x)]) == gen, bar);
            __builtin_amdgcn_fence(__ATOMIC_ACQUIRE, "agent");
            asm volatile("s_waitcnt vmcnt(0)" ::: "memory");
        }
    }
    __syncthreads();
}


#ifndef PG_ALIGN_BIG
#define PG_ALIGN_BIG true
#endif
#ifndef PG_ALIGN_N1K
#define PG_ALIGN_N1K true
#endif
__global__ void __launch_bounds__(NTHREADS, 2) mk_fwd(Args a) {
    extern __shared__ __attribute__((aligned(16))) unsigned char lds[];
    cg::grid_group grid = cg::this_grid();
    const int lo = a.ph_lo, hi = a.ph_hi, G = gridDim.x, bid = blockIdx.x;
    unsigned char* ws = a.ws;
    LAS unsigned char* ring = (LAS unsigned char*)(LAS void*)lds;
#ifdef PH_MASK
#define IN(k) (((PH_MASK) >> (k)) & 1)
#else
#define IN(k) (lo <= (k) && (k) < hi)
#endif
#ifdef TPROBE_A
#define STAMP(k) do { if (bid == 0 && threadIdx.x == 0) ((volatile unsigned long long*)(lds + 131072 + 64))[k] = __builtin_amdgcn_s_memrealtime(); } while (0)
#else
#define STAMP(k) do { } while (0)
#endif
    if (threadIdx.x < 2) ((volatile LAS unsigned*)(LAS void*)(lds + LDS_BYTES))[threadIdx.x] = 0u;
    __syncthreads();
    XcdBarrier xbar = xcd_barrier_post((unsigned*)(ws + WS_BAR), (volatile LAS unsigned*)(LAS void*)(lds + LDS_BYTES));
#define SEAM(k) do { if (IN(k) && IN((k) + 1)) { if (hi > 1000) grid.sync(); else xcd_barrier(xbar); } STAMP((k) + 1); } while (0)
    STAMP(0);

    constexpr int P1_NWG = (MT / 256) * (PW / 256);
    const int p1_rem = P1_NWG % G;
    if (IN(0)) { p0_prologue(a, lds, (p1_rem != 0 && IN(1)) ? P0_I1 : P0_NITEMS); }
    SEAM(0);
    if (IN(1)) {
        pg8::Gemm g{(const bf16*)(ws + WS_R0), (const bf16*)(ws + WS_W1T), MT, PW, 1024}; pg8::StaticOrder S; S.init(MT, PW, G, bid);
        pg8::EpiProj E{(bf16*)(ws + WS_R1), (bf16*)(ws + WS_R2), (bf16*)(ws + WS_R4), (bf16*)(ws + WS_R5), (bf16*)(ws + WS_R6), (bf16*)(ws + WS_R7), (bf16*)(ws + WS_R8), (bf16*)(ws + WS_R9),
                       (float*)(ws + WS_R3), (const float*)(ws + WS_LBV)};
        pg8::gemm_phase<pg8::EpiProj, pg8::StaticOrder, PG_ALIGN_BIG, true>(ring, g, S, E);
        if (p1_rem != 0 && IN(0) && bid >= p1_rem) p0_weights(a, lds, P0_I1, P0_NITEMS, (bid - p1_rem) * 8 + (int)(threadIdx.x >> 6), (G - p1_rem) * 8);
    }
    SEAM(1);
    if (IN(2)) { hgrn_local_phase(a, lds); }
    SEAM(2);
    if (IN(3)) {
        constexpr int N_ATT = 4 * 64 * 2, N_SAT = DEC_B;
        const int ns = (G >= 128) ? 64 : 0;
        if (G == 256) {
            if (bid < ns) {
                hgrn_scan(a, bid, ns, lds); STAMP(10);
                __syncthreads();
                { const int r = 448 + bid; attn_prompt_item(a, r >> 7, (r >> 1) & 63, r & 1, lds); }
                for (int r = 320 + 3 * bid; r < 320 + 3 * bid + 3; ++r) hgrn_sample_item(a, r >> 2, r & 3, lds);
            } else {
                const int j = bid - ns;
                if (j < 128) { attn_sample_item(a, j, lds);
                    for (int r = 2 * j; r < 2 * j + 2; ++r) attn_prompt_item(a, r >> 7, (r >> 1) & 63, r & 1, lds);
                    for (int r = 2 * j; r < 2 * j + 2; ++r) hgrn_sample_item(a, r >> 2, r & 3, lds); }
                else { for (int r = 256 + 3 * (j - 128); r < 256 + 3 * (j - 128) + 3; ++r) attn_prompt_item(a, r >> 7, (r >> 1) & 63, r & 1, lds);
                    { const int r = 256 + (j - 128); hgrn_sample_item(a, r >> 2, r & 3, lds); } }
            }
        } else {
            if (ns == 0) hgrn_scan(a, bid, G, lds); else if (bid < ns) hgrn_scan(a, bid, ns, lds);
            __syncthreads();
            if (bid >= ns) {
                for (int it = bid - ns; it < N_ATT + N_SAT; it += G - ns) {
                    if (it < N_ATT) attn_prompt_item(a, it >> 7, (it >> 1) & 63, it & 1, lds);
                    else attn_sample_item(a, it - N_ATT, lds);
                }
                for (int r = bid - ns; r < DEC_B * 4; r += G - ns) hgrn_sample_item(a, r >> 2, r & 3, lds);
            }
        }
    }
    SEAM(3);
    if (IN(4)) {
        hgrn_out_phase(a, lds);
    }
    SEAM(4);
    if (IN(5)) {
        p5_sample(a, lds);
        pg8::StaticOrder S; S.init(MP, 1024, G, bid);
        pg8::Gemm g{(const bf16*)(ws + WS_R6), (const bf16*)(ws + WS_WOH), MP, 1024, 1024, (const bf16*)(ws + WS_R10), 512, 8};
        pg8::EpiMerge E{(const bf16*)(ws + WS_R8), (const bf16*)(ws + WS_R9), (bf16*)(ws + WS_R3)};
        pg8::gemm_phase<pg8::EpiMerge, pg8::StaticOrder, PG_ALIGN_N1K, true, true>(ring, g, S, E);
    }
    SEAM(5);
    if (IN(6)) {
        p6_sample(a, lds);
        pg8::Gemm g{(const bf16*)(ws + WS_R3), (const bf16*)(ws + WS_WOUT), MP, 1024, 1024}; pg8::StaticOrder S; S.init(MP, 1024, G, bid);
        pg8::EpiRes1 E{a.x_prompt, (bf16*)(ws + WS_R8), (float*)(ws + WS_SUMSQ)};
        pg8::gemm_phase<pg8::EpiRes1, pg8::StaticOrder, PG_ALIGN_N1K, true>(ring, g, S, E);
    }
    SEAM(6);
    if (IN(7)) {
        pg8::Gemm g{(const bf16*)(ws + WS_R8), (const bf16*)(ws + WS_WGU), MT, 2 * DFF, 1024}; pg8::StaticOrder S; S.init(MT, 2 * DFF, G, bid);
        pg8::EpiFfn E{(const float*)(ws + WS_SUMSQ), (bf16*)(ws + WS_R0)};
        pg8::gemm_phase<pg8::EpiFfn, pg8::StaticOrder, PG_ALIGN_BIG, true>(ring, g, S, E);
    }
    SEAM(7);
    if (IN(8)) {
        p8_sample(a, lds);
        pg8::Gemm g{(const bf16*)(ws + WS_R0), (const bf16*)(ws + WS_WD), MP, 1024, DFF}; pg8::StaticOrder S; S.init(MP, 1024, G, bid);
        pg8::EpiRes2 E{(const bf16*)(ws + WS_R8), a.out + O_Y};
        pg8::gemm_phase<pg8::EpiRes2, pg8::StaticOrder, PG_ALIGN_N1K, true>(ring, g, S, E);
    }
#ifdef TPROBE_A
    {
        grid.sync(); STAMP(9);
        unsigned long long* pw = (unsigned long long*)(ws + WS_MISC + 2048);
        if (bid == 0 && threadIdx.x == 0) { volatile unsigned long long* t = (volatile unsigned long long*)(lds + 131072 + 64);
            pw[0] = (TPROBE_A >= 0) ? t[TPROBE_A + 1] - t[TPROBE_A] : 0ull; pw[1] = (TPROBE_B == 10) ? t[10] - t[3] : t[TPROBE_B + 1] - t[TPROBE_B]; __threadfence(); }
        grid.sync();
        const unsigned long long dA = __hip_atomic_load(pw, __ATOMIC_RELAXED, __HIP_MEMORY_SCOPE_AGENT), dB = __hip_atomic_load(pw + 1, __ATOMIC_RELAXED, __HIP_MEMORY_SCOPE_AGENT);
        const float eps = sqrtf(2e-5f + (float)dB * 0.01f * (float)(TPROBE_KB));
        f32x4* cvs = (f32x4*)(a.out + O_VS);
        for (int i = bid * NTHREADS + threadIdx.x; i < 128 * 128 * 128 / 4; i += G * NTHREADS) cvs[i] = cvs[i] * (1.f + eps);
        const unsigned long long t0 = __builtin_amdgcn_s_memrealtime();
        while (__builtin_amdgcn_s_memrealtime() - t0 < 4ull * dA) __builtin_amdgcn_s_sleep(8);
    }
#endif
#undef IN
#undef SEAM
}

__global__ void dump_ws(const unsigned short* w, float* o, size_t n, size_t tot) {
    for (size_t i = blockIdx.x * (size_t)blockDim.x + threadIdx.x; i < n; i += (size_t)gridDim.x * blockDim.x) { unsigned s = 0; for (size_t j = i; j < tot; j += n) s += w[j]; o[i] = (float)s; }
}
constexpr int N_PHASES = 9;
extern "C" void kernel_launch(void* const* d_in, const int* in_sizes, int n_in, void* d_out, int out_size, void* d_ws, size_t ws_size, hipStream_t stream) {
    static int grid = 0;
    if (grid == 0) {
        if (n_in != 19 || (size_t)out_size != O_END || ws_size < WS_END) { fprintf(stderr, "kernel_launch: unexpected shapes: n_in %d out %d ws %zu (need %zu)\n", n_in, out_size, ws_size, (size_t)WS_END); grid = -1; return; }
        int dev = 0, cus = 0, per_cu = 0;
        if (hipGetDevice(&dev) != hipSuccess || hipDeviceGetAttribute(&cus, hipDeviceAttributeMultiprocessorCount, dev) != hipSuccess) { grid = -1; return; }
        if (hipFuncSetAttribute((const void*)mk_fwd, hipFuncAttributeMaxDynamicSharedMemorySize, LDS_TOTAL) != hipSuccess) { fprintf(stderr, "kernel_launch: hipFuncSetAttribute failed\n"); grid = -1; return; }
        if (hipOccupancyMaxActiveBlocksPerMultiprocessor(&per_cu, (const void*)mk_fwd, NTHREADS, LDS_TOTAL) != hipSuccess || per_cu < 1) { fprintf(stderr, "kernel_launch: occupancy query says %d\n", per_cu); (void)hipGetLastError(); grid = -1; return; }
        grid = cus;
    }
    if (grid < 0) return;
    Args a{};
    const float** ap = (const float**)&a;
    for (int i = 0; i < 19; ++i) ap[i] = (const float*)d_in[i];
    a.out = (float*)d_out; a.ws = (unsigned char*)d_ws;
#if MK_N_LAUNCHES == 1
    if (hipMemsetAsync((char*)d_ws + WS_BAR, 0, XCD_BAR_WORDS * 4, stream) != hipSuccess) { fprintf(stderr, "kernel_launch: memset of the barrier words failed\n"); return; }
    a.ph_lo = 0; a.ph_hi = N_PHASES;
    void* args[] = {&a};
    hipError_t e = hipLaunchCooperativeKernel((const void*)mk_fwd, dim3(grid), dim3(NTHREADS), args, LDS_TOTAL, stream);
    if (e != hipSuccess) fprintf(stderr, "kernel_launch: cooperative launch failed: %s (grid %d)\n", hipGetErrorString(e), grid);
#else
#ifndef PROBE_K
#define PROBE_K 8
#endif
    for (int ph = 0; ph <= PROBE_K; ++ph) {
        a.ph_lo = ph; a.ph_hi = ph + 1;
        hipLaunchKernelGGL(mk_fwd, dim3(grid), dim3(NTHREADS), LDS_TOTAL, stream, a);
    }
#if PROBE_K < 8
    hipLaunchKernelGGL(dump_ws, dim3(2048), dim3(256), 0, stream, (const unsigned short*)d_ws, (float*)d_out, (size_t)out_size, (size_t)(WS_END / 2));
#endif
#endif
}
```

```cpp
#include <hip/hip_runtime.h>
#include <hip/hip_cooperative_groups.h>
#include <cstdio>
#include <cstdint>
namespace cg = cooperative_groups;

#ifndef MK_N_LAUNCHES
#define MK_N_LAUNCHES 1
#endif

constexpr int DM = 1024, SEQ = 8192, NBATCH = 4, MP = NBATCH * SEQ, DEC_B = 128, DEC_T = 4, MS = DEC_B * DEC_T, MT = MP + MS;
constexpr int PW = 4864, DFF = 2816;
constexpr float EPS = 1e-6f;

constexpr size_t UB = (size_t)MT * 512 * 2;
constexpr size_t WS_W1T = 0;
constexpr size_t WS_WOH = WS_W1T + (size_t)PW * DM * 2;
constexpr size_t WS_WOA = WS_WOH + (size_t)1024 * 512 * 2;
constexpr size_t WS_WOUT = WS_WOA + (size_t)1024 * 512 * 2;
constexpr size_t WS_WGU = WS_WOUT + (size_t)1024 * 1024 * 2;
constexpr size_t WS_WD = WS_WGU + (size_t)2 * DFF * DM * 2;
constexpr size_t WS_MISC = WS_WD + (size_t)DM * DFF * 2;
constexpr size_t WS_LBV = WS_MISC;
constexpr size_t WS_SUMSQ = WS_MISC + 4096;
constexpr size_t WS_DT = WS_MISC + 512 * 1024;
constexpr size_t WS_BAR = WS_MISC + 1536 * 1024;
constexpr size_t WS_R0 = (size_t)32 << 20;
constexpr size_t WS_R1 = WS_R0 + 2 * UB;
constexpr size_t WS_R2 = WS_R1 + UB;
constexpr size_t WS_R3 = WS_R2 + UB;
constexpr size_t WS_R4 = WS_R3 + 2 * UB;
constexpr size_t WS_R5 = WS_R4 + UB;
constexpr size_t WS_R6 = WS_R5 + UB;
constexpr size_t WS_R7 = WS_R6 + UB;
constexpr size_t WS_R8 = WS_R7 + UB / 2;
constexpr size_t WS_R9 = WS_R8 + 2 * UB;
constexpr size_t WS_R10 = WS_R9 + 2 * UB;
constexpr size_t WS_YAS = WS_R10 + UB;
constexpr size_t WS_END = WS_YAS + (size_t)MS * 512 * 2;
static_assert(WS_MISC == ((size_t)30 << 20) && WS_END <= ((size_t)512 << 20), "d_ws map");
static_assert((size_t)MT * DFF * 2 <= 6 * UB, "ACT fits R0..R3");

constexpr size_t O_Y = 0;
constexpr size_t O_SP = (size_t)MT * DM;
constexpr size_t O_KP = O_SP + (size_t)4 * 4 * 128 * 128;
constexpr size_t O_VP = O_KP + (size_t)4 * 128 * 128;
constexpr size_t O_SS = O_VP + (size_t)4 * 128 * 128;
constexpr size_t O_KS = O_SS + (size_t)128 * 4 * 128 * 128;
constexpr size_t O_VS = O_KS + (size_t)128 * 128 * 128;
constexpr size_t O_END = O_VS + (size_t)128 * 128 * 128;

constexpr int LDS_BYTES = 131072;
constexpr int LDS_TOTAL = LDS_BYTES + 256;
constexpr int NTHREADS = 512;

#define LAS __attribute__((address_space(3)))
typedef unsigned short bf16;
typedef float f32x4 __attribute__((ext_vector_type(4)));
typedef float f32x2 __attribute__((ext_vector_type(2)));
typedef unsigned u32x4 __attribute__((ext_vector_type(4)));
typedef unsigned u32x2 __attribute__((ext_vector_type(2)));
typedef short bf16x8 __attribute__((ext_vector_type(8)));
typedef short s16x4 __attribute__((ext_vector_type(4)));

__device__ __forceinline__ float bf2f(unsigned short u) { return __uint_as_float((unsigned)u << 16); }
__device__ __forceinline__ float bflo(unsigned w) { return __uint_as_float(w << 16); }
__device__ __forceinline__ float bfhi(unsigned w) { return __uint_as_float(w & 0xffff0000u); }
typedef __bf16 bf16x2_t __attribute__((ext_vector_type(2)));
__device__ __forceinline__ unsigned pk2(float lo, float hi) { f32x2 v = {lo, hi}; bf16x2_t b = __builtin_convertvector(v, bf16x2_t); return __builtin_bit_cast(unsigned, b); }
__device__ __forceinline__ float sigm(float x) { return __builtin_amdgcn_rcpf(1.f + __expf(-x)); }
__device__ __forceinline__ s16x4 tr_read(const bf16* p) {
    return __builtin_bit_cast(s16x4, __builtin_amdgcn_ds_read_tr16_b64_v4i16((LAS s16x4*)(LAS void*)p));
}
__device__ __forceinline__ bf16x8 cat8(s16x4 a, s16x4 b) { return (bf16x8){a[0], a[1], a[2], a[3], b[0], b[1], b[2], b[3]}; }
__device__ __forceinline__ bf16x8 pk8(f32x4 a, f32x4 b) { u32x4 w; w.x = pk2(a[0], a[1]); w.y = pk2(a[2], a[3]); w.z = pk2(b[0], b[1]); w.w = pk2(b[2], b[3]); return __builtin_bit_cast(bf16x8, w); }
#define MFMA16(a, b, c) __builtin_amdgcn_mfma_f32_16x16x32_bf16((a), (b), (c), 0, 0, 0)

namespace pg8 {
#define PG8_LAS __attribute__((address_space(3)))
typedef unsigned short bf16_t;
typedef short bf16x8 __attribute__((ext_vector_type(8)));
typedef float f32x4 __attribute__((ext_vector_type(4)));
typedef unsigned u32x4 __attribute__((ext_vector_type(4)));
constexpr int BM = 256, BK = 64, HALF = 128, HTB = HALF * BK * 2  , STAGE_BYTES = 8 * HTB, NXCD = 8, WGM = 8;

__host__ __device__ __forceinline__ int lds_byte(int r, int c) { const int st = (r >> 4) * 2 + (c >> 5), rr = r & 15, cc = c & 31, ob = rr * 64 + cc * 2; return st * 1024 + (ob ^ (((ob >> 9) & 1) << 5)); }
__host__ __device__ __forceinline__ void stage_rc(int b, int& R, int& C) { const int st = b / 1024, sb = b % 1024, swz = sb ^ (((sb >> 9) & 1) << 5); R = (st >> 1) * 16 + swz / 64; C = (st & 1) * 32 + (swz % 64) / 2; }
__host__ __device__ __forceinline__ int perm32(int rho) { const int n = rho >> 4, i = rho & 15; return 8 * (i >> 2) + 4 * n + (i & 3); }

struct Unit { int pm, pn; };
struct Gemm { const bf16_t* A; const bf16_t* Bt; int M, N, K; const bf16_t* A2; int lda, kmid; };

struct StaticOrder {
    int nM, nN, nwg, G, c;
    __host__ __device__ void init(int M, int N, int G_, int c_) { nM = M / BM; nN = N / BM; nwg = nM * nN; G = G_; c = c_; }
    __host__ __device__ bool next(int i, Unit& u) const {
        const long L = (long)i * G + c; if (L >= nwg) return false;
        int wgid = (int)L; { const int q = nwg / NXCD, r = nwg % NXCD, xcd = wgid % NXCD, off = wgid / NXCD; wgid = (xcd < r ? xcd * (q + 1) : r * (q + 1) + (xcd - r) * q) + off; }
        const int nig = WGM * nN, gid = wgid / nig, fm = gid * WGM, gsz = (nM - fm) < WGM ? (nM - fm) : WGM;
        u.pm = fm + ((wgid % nig) % gsz); u.pn = (wgid % nig) / gsz; return true;
    }
    __device__ __forceinline__ void a_ready(const Unit&) const {}
    __device__ __forceinline__ void done(const Unit&) const {}
};

__device__ __forceinline__ unsigned cvt_pk_bf16(float lo, float hi) { unsigned r; asm volatile("v_cvt_pk_bf16_f32 %0, %1, %2" : "=v"(r) : "v"(lo), "v"(hi)); return r; }

__device__ __forceinline__ f32x4 vexp2(f32x4 t) { f32x4 r; r[0] = __builtin_amdgcn_exp2f(t[0]); r[1] = __builtin_amdgcn_exp2f(t[1]); r[2] = __builtin_amdgcn_exp2f(t[2]); r[3] = __builtin_amdgcn_exp2f(t[3]); return r; }
__device__ __forceinline__ f32x4 vrcp(f32x4 t) { f32x4 r; r[0] = __builtin_amdgcn_rcpf(t[0]); r[1] = __builtin_amdgcn_rcpf(t[1]); r[2] = __builtin_amdgcn_rcpf(t[2]); r[3] = __builtin_amdgcn_rcpf(t[3]); return r; }
__device__ __forceinline__ f32x4 vlog2(f32x4 t) { f32x4 r; r[0] = __builtin_amdgcn_logf(t[0]); r[1] = __builtin_amdgcn_logf(t[1]); r[2] = __builtin_amdgcn_logf(t[2]); r[3] = __builtin_amdgcn_logf(t[3]); return r; }
__device__ __forceinline__ f32x4 vsig(f32x4 v) { return vrcp(vexp2(v * -1.4426950408889634f) + 1.f); }
struct EpiProj {
    static constexpr bool PERM = true, AFTER_DRAIN = false; static constexpr size_t MTR = 33280;
    bf16_t *QH, *KH, *VH, *OG, *QA, *KV, *GA, *GB; float* GH; const float* lbv;
    __device__ __forceinline__ void operator()(const f32x4 (&acc)[2][2][4][2], const Unit& u, int wr, int wc, int fr, int fq) const {
        const int pn = u.pn; int mode, ld, cb; bf16_t* dst; float sc = 1.f; bool hm = false;
        if (pn < 2)        { mode = 1; dst = QH; ld = 512;  cb = pn * 256; sc = 0.08838834764831845f; hm = true; }
        else if (pn < 4)   { mode = 3; dst = KH; ld = 512;  cb = (pn - 2) * 256; hm = true; }
        else if (pn < 6)   { mode = 0; dst = VH; ld = 512;  cb = (pn - 4) * 256; hm = true; }
        else if (pn < 8)   { mode = 1; dst = OG; ld = 512;  cb = (pn - 6) * 256; hm = true; }
        else if (pn < 10)  { mode = 0; dst = QA; ld = 512;  cb = (pn - 8) * 256; }
        else if (pn == 10) { mode = 0; dst = KV; ld = 256;  cb = 0; }
        else               { mode = 4; dst = GA; ld = 1024; cb = (pn - 11) * 128; }
        const int row0 = u.pm * BM + wr * 64 + fr, col0 = cb + wc * 32 + 8 * fq;
        if (mode == 4) {
#pragma unroll
            for (int ai = 0; ai < 2; ++ai)
#pragma unroll
                for (int m = 0; m < 4; ++m) {
                    const size_t off = (size_t)(row0 + ai * HALF + m * 16) * 1024 + col0;
                    const f32x4 A0 = vexp2(acc[ai][0][m][0] * -1.4426950408889634f) + 1.f, A1 = vexp2(acc[ai][0][m][1] * -1.4426950408889634f) + 1.f;
                    const f32x4 B0 = vexp2(acc[ai][1][m][0] * -1.4426950408889634f) + 1.f, B1 = vexp2(acc[ai][1][m][1] * -1.4426950408889634f) + 1.f;
                    const f32x4 s0 = vrcp(B0), s1 = vrcp(B1), r0 = B0 * vrcp(A0), r1 = B1 * vrcp(A1);
                    u32x4 w; w.x = pk2(r0[0], r0[1]); w.y = pk2(r0[2], r0[3]); w.z = pk2(r1[0], r1[1]); w.w = pk2(r1[2], r1[3]);
                    *(u32x4*)(GA + off) = w;
                    w.x = pk2(s0[0], s0[1]); w.y = pk2(s0[2], s0[3]); w.z = pk2(s1[0], s1[1]); w.w = pk2(s1[2], s1[3]);
                    *(u32x4*)(GB + off) = w;
                }
            return;
        }
#pragma unroll
        for (int bj = 0; bj < 2; ++bj) {
            const int col = col0 + bj * HALF;
            f32x4 l0 = {0.f, 0.f, 0.f, 0.f}, l1 = l0;
            if (mode == 3) { l0 = *(const f32x4*)(lbv + col); l1 = *(const f32x4*)(lbv + col + 4); }
#pragma unroll
            for (int ai = 0; ai < 2; ++ai)
#pragma unroll
                for (int m = 0; m < 4; ++m) {
                    const size_t row = (size_t)(row0 + ai * HALF + m * 16);
                    f32x4 v0 = acc[ai][bj][m][0], v1 = acc[ai][bj][m][1];
                    if (mode == 1) {
                        v0 = (v0 * sc) * vsig(v0); v1 = (v1 * sc) * vsig(v1);
                    } else if (mode == 3) {
                        const f32x4 f0 = l0 + (1.f - l0) * vsig(v0), f1 = l1 + (1.f - l1) * vsig(v1);
                        const f32x4 g0 = vlog2(f0) * 0.6931471805599453f, g1 = vlog2(f1) * 0.6931471805599453f;
                        v0 = 1.f - f0; v1 = 1.f - f1;
                        float* gp = GH + ((size_t)(col >> 7) * MTR + row) * 128 + (col & 127); *(f32x4*)gp = g0; *(f32x4*)(gp + 4) = g1;
                    }
                    u32x4 w; w.x = pk2(v0[0], v0[1]); w.y = pk2(v0[2], v0[3]); w.z = pk2(v1[0], v1[1]); w.w = pk2(v1[2], v1[3]);
                    *(u32x4*)(dst + (hm ? ((size_t)(col >> 7) * MTR + row) * 128 + (col & 127) : row * ld + col)) = w;
                }
        }
    }
};
template <bool ADD> struct EpiGate {
    static constexpr bool PERM = true, AFTER_DRAIN = false;
    const bf16_t* gate; const bf16_t* T; bf16_t* O;
    __device__ __forceinline__ void operator()(const f32x4 (&acc)[2][2][4][2], const Unit& u, int wr, int wc, int fr, int fq) const {
        const int row0 = u.pm * BM + wr * 64 + fr, col0 = u.pn * BM + wc * 32 + 8 * fq;
#pragma unroll
        for (int ai = 0; ai < 2; ++ai)
#pragma unroll
            for (int m = 0; m < 4; ++m)
#pragma unroll
                for (int bj = 0; bj < 2; ++bj) {
                    const size_t off = (size_t)(row0 + ai * HALF + m * 16) * 1024 + col0 + bj * HALF;
                    const u32x4 gw = *(const u32x4*)(gate + off);
                    f32x4 v0 = acc[ai][bj][m][0], v1 = acc[ai][bj][m][1];
                    v0[0] *= bflo(gw.x); v0[1] *= bfhi(gw.x); v0[2] *= bflo(gw.y); v0[3] *= bfhi(gw.y);
                    v1[0] *= bflo(gw.z); v1[1] *= bfhi(gw.z); v1[2] *= bflo(gw.w); v1[3] *= bfhi(gw.w);
                    if (ADD) { const u32x4 tw = *(const u32x4*)(T + off);
                        v0[0] += bflo(tw.x); v0[1] += bfhi(tw.x); v0[2] += bflo(tw.y); v0[3] += bfhi(tw.y);
                        v1[0] += bflo(tw.z); v1[1] += bfhi(tw.z); v1[2] += bflo(tw.w); v1[3] += bfhi(tw.w); }
                    u32x4 w; w.x = pk2(v0[0], v0[1]); w.y = pk2(v0[2], v0[3]); w.z = pk2(v1[0], v1[1]); w.w = pk2(v1[2], v1[3]);
                    *(u32x4*)(O + off) = w;
                }
    }
};
struct EpiMerge {
    static constexpr bool PERM = true, AFTER_DRAIN = false;
    const bf16_t* GA; const bf16_t* GB; bf16_t* O;
    __device__ __forceinline__ void mid(f32x4 (&acc)[2][2][4][2], const Unit& u, int wr, int wc, int fr, int fq) const {
        int lane_ = (int)(threadIdx.x & 63); asm volatile("" : "+v"(lane_));
        const int row0 = u.pm * BM + wr * 64 + (lane_ & 15), col0 = u.pn * BM + wc * 32 + 8 * (lane_ >> 4);
#pragma unroll
        for (int ai = 0; ai < 2; ++ai)
#pragma unroll
            for (int m = 0; m < 4; ++m)
#pragma unroll
                for (int bj = 0; bj < 2; ++bj) {
                    const u32x4 a = *(const u32x4*)(GA + (size_t)(row0 + ai * HALF + m * 16) * 1024 + col0 + bj * HALF);
                    acc[ai][bj][m][0] = acc[ai][bj][m][0] * (f32x4){bflo(a.x), bfhi(a.x), bflo(a.y), bfhi(a.y)};
                    acc[ai][bj][m][1] = acc[ai][bj][m][1] * (f32x4){bflo(a.z), bfhi(a.z), bflo(a.w), bfhi(a.w)};
                    if (m == 3 && bj == 1) __builtin_amdgcn_sched_barrier(0);
                }
    }
    __device__ __forceinline__ void operator()(const f32x4 (&acc)[2][2][4][2], const Unit& u, int wr, int wc, int fr, int fq) const {
        const int row0 = u.pm * BM + wr * 64 + fr, col0 = u.pn * BM + wc * 32 + 8 * fq;
#pragma unroll
        for (int ai = 0; ai < 2; ++ai)
#pragma unroll
            for (int m = 0; m < 4; ++m)
#pragma unroll
                for (int bj = 0; bj < 2; ++bj) {
                    const size_t off = (size_t)(row0 + ai * HALF + m * 16) * 1024 + col0 + bj * HALF;
                    const u32x4 gw = *(const u32x4*)(GB + off);
                    const f32x4 v0 = acc[ai][bj][m][0], v1 = acc[ai][bj][m][1];
                    u32x4 w; w.x = pk2(v0[0] * bflo(gw.x), v0[1] * bfhi(gw.x)); w.y = pk2(v0[2] * bflo(gw.y), v0[3] * bfhi(gw.y));
                    w.z = pk2(v1[0] * bflo(gw.z), v1[1] * bfhi(gw.z)); w.w = pk2(v1[2] * bflo(gw.w), v1[3] * bfhi(gw.w));
                    *(u32x4*)(O + off) = w;
                }
    }
};
struct EpiRes1 {
    static constexpr bool PERM = true, AFTER_DRAIN = false;
    const float* xp; bf16_t* X1B; float* sumsq;
    __device__ __forceinline__ void operator()(const f32x4 (&acc)[2][2][4][2], const Unit& u, int wr, int wc, int fr, int fq) const {
        const int row0 = u.pm * BM + wr * 64 + fr, col0 = u.pn * BM + wc * 32 + 8 * fq;
#pragma unroll
        for (int ai = 0; ai < 2; ++ai)
#pragma unroll
            for (int m = 0; m < 4; ++m) {
                const int row = row0 + ai * HALF + m * 16; float ss = 0.f;
#pragma unroll
                for (int bj = 0; bj < 2; ++bj) {
                    const size_t off = (size_t)row * 1024 + col0 + bj * HALF;
                    const f32x4 v0 = acc[ai][bj][m][0] + *(const f32x4*)(xp + off), v1 = acc[ai][bj][m][1] + *(const f32x4*)(xp + off + 4);
                    ss += (v0[0] * v0[0] + v0[1] * v0[1]) + (v0[2] * v0[2] + v0[3] * v0[3]) + (v1[0] * v1[0] + v1[1] * v1[1]) + (v1[2] * v1[2] + v1[3] * v1[3]);
                    u32x4 w; w.x = pk2(v0[0], v0[1]); w.y = pk2(v0[2], v0[3]); w.z = pk2(v1[0], v1[1]); w.w = pk2(v1[2], v1[3]);
                    *(u32x4*)(X1B + off) = w;
                }
                ss += __shfl_xor(ss, 16); ss += __shfl_xor(ss, 32);
                if (fq == 0) atomicAdd(sumsq + row, ss);
            }
    }
};
struct EpiFfn {
    static constexpr bool PERM = true, AFTER_DRAIN = false;
    const float* sumsq; bf16_t* ACT;
    __device__ __forceinline__ void operator()(const f32x4 (&acc)[2][2][4][2], const Unit& u, int wr, int wc, int fr, int fq) const {
        const int row0 = u.pm * BM + wr * 64 + fr, col0 = u.pn * HALF + wc * 32 + 8 * fq;
        float sq[2][4];
#pragma unroll
        for (int ai = 0; ai < 2; ++ai)
#pragma unroll
            for (int m = 0; m < 4; ++m) sq[ai][m] = sumsq[row0 + ai * HALF + m * 16];
#pragma unroll
        for (int ai = 0; ai < 2; ++ai)
#pragma unroll
            for (int m = 0; m < 4; ++m) {
                const int row = row0 + ai * HALF + m * 16;
                const float r = __builtin_amdgcn_rsqf(sq[ai][m] * (1.f / 1024.f) + 1e-6f);
                const float nrl = r * -1.4426950408889634f, r2 = r * r;
                f32x4 o[2];
#pragma unroll
                for (int n = 0; n < 2; ++n) {
                    const f32x4 g = acc[ai][0][m][n], uu = acc[ai][1][m][n];
                    const f32x4 t = g * nrl;
                    f32x4 ex; ex[0] = __builtin_amdgcn_exp2f(t[0]); ex[1] = __builtin_amdgcn_exp2f(t[1]); ex[2] = __builtin_amdgcn_exp2f(t[2]); ex[3] = __builtin_amdgcn_exp2f(t[3]);
                    const f32x4 d = ex + 1.f;
                    f32x4 s; s[0] = __builtin_amdgcn_rcpf(d[0]); s[1] = __builtin_amdgcn_rcpf(d[1]); s[2] = __builtin_amdgcn_rcpf(d[2]); s[3] = __builtin_amdgcn_rcpf(d[3]);
                    o[n] = (g * uu) * (s * r2);
                }
                u32x4 w; w.x = pk2(o[0][0], o[0][1]); w.y = pk2(o[0][2], o[0][3]); w.z = pk2(o[1][0], o[1][1]); w.w = pk2(o[1][2], o[1][3]);
                *(u32x4*)(ACT + (size_t)row * 2816 + col0) = w;
            }
    }
};
struct EpiRes2 {
    static constexpr bool PERM = true, AFTER_DRAIN = false;
    const bf16_t* X1B; float* out;
    __device__ __forceinline__ void operator()(const f32x4 (&acc)[2][2][4][2], const Unit& u, int wr, int wc, int fr, int fq) const {
        const int row0 = u.pm * BM + wr * 64 + fr, col0 = u.pn * BM + wc * 32 + 8 * fq;
#pragma unroll
        for (int ai = 0; ai < 2; ++ai)
#pragma unroll
            for (int m = 0; m < 4; ++m)
#pragma unroll
                for (int bj = 0; bj < 2; ++bj) {
                    const size_t off = (size_t)(row0 + ai * HALF + m * 16) * 1024 + col0 + bj * HALF;
                    const u32x4 xw = *(const u32x4*)(X1B + off);
                    const f32x4 v0 = acc[ai][bj][m][0] + (f32x4){bflo(xw.x), bfhi(xw.x), bflo(xw.y), bfhi(xw.y)}, v1 = acc[ai][bj][m][1] + (f32x4){bflo(xw.z), bfhi(xw.z), bflo(xw.w), bfhi(xw.w)};
                    *(f32x4*)(out + off) = v0; *(f32x4*)(out + off + 4) = v1;
                }
    }
};
template <class Epi, class Sched, bool ALIGN_EPI = false, bool SP2 = false, bool MID = false>
__device__ __forceinline__ void gemm_phase(PG8_LAS unsigned char* lds, const Gemm g, const Sched& S, const Epi& E) {
    const int tid = threadIdx.x, wid = __builtin_amdgcn_readfirstlane(tid >> 6), lane = tid & 63, wr = wid >> 2, wc = wid & 3, fr = lane & 15, fq = lane >> 4;
    const int K = g.K, nt = K / BK;
    const int lda = g.lda ? g.lda : K, kmid = g.kmid ? g.kmid : nt;
    unsigned voffA[2], voffB[2];
#pragma unroll
    for (int i = 0; i < 2; ++i) { int R, C; stage_rc(tid * 16 + i * 8192, R, C); const int Rb = Epi::PERM ? ((R & ~31) + perm32(R & 31)) : R;
        voffA[i] = (unsigned)(R * lda + C) * 2u; voffB[i] = (unsigned)(Rb * K + C) * 2u; }
    const size_t kstep = (size_t)(BK * 2);
    const size_t hstepA = (size_t)HALF * lda * 2, hstepB = (size_t)HALF * K * 2;
    const size_t tstepA = 2 * hstepA, tstepB = 2 * hstepB;
    const long dA2 = g.A2 ? ((const char*)g.A2 - (const char*)g.A) - (long)kmid * (long)kstep : 0l;
    const unsigned ldsw = (unsigned)wid * 1024u;
    const int aoff = lds_byte(wr * 64 + fr, fq * 8), boff = lds_byte(wc * 32 + fr, fq * 8);
#define PG8_SA(b, h) (((b) * 2 + (h)) * HTB)
#define PG8_SB(b, h) ((4 + (b) * 2 + (h)) * HTB)
#define PG8_STAGE(bufoff, gbase, voff) do { _Pragma("unroll") for (int _i = 0; _i < 2; ++_i) \
        __builtin_amdgcn_global_load_lds((const unsigned*)((const char*)(gbase) + (voff)[_i]), (PG8_LAS unsigned*)(lds + (bufoff) + ldsw + _i * 8192), 16, 0, 0); } while (0)
#define PG8_LDA(dst, b, h) do { _Pragma("unroll") for (int m = 0; m < 4; ++m) _Pragma("unroll") for (int k = 0; k < 2; ++k) dst[m][k] = *(const PG8_LAS bf16x8*)(lds + PG8_SA(b, h) + aoff + m * 2048 + k * 1024); } while (0)
#define PG8_LDB(dst, b, h) do { _Pragma("unroll") for (int n = 0; n < 2; ++n) _Pragma("unroll") for (int k = 0; k < 2; ++k) dst[n][k] = *(const PG8_LAS bf16x8*)(lds + PG8_SB(b, h) + boff + n * 2048 + k * 1024); } while (0)
#define PG8_MMA(ai, bj, At, Bt) do { __builtin_amdgcn_s_setprio(1); _Pragma("unroll") for (int m = 0; m < 4; ++m) _Pragma("unroll") for (int n = 0; n < 2; ++n) _Pragma("unroll") for (int k = 0; k < 2; ++k) \
        acc[ai][bj][m][n] = __builtin_amdgcn_mfma_f32_16x16x32_bf16(Bt[n][k], At[m][k], acc[ai][bj][m][n], 0, 0, 0); __builtin_amdgcn_s_setprio(0); } while (0)
#define PG8_WAIT_V(n) asm volatile("s_waitcnt vmcnt(" #n ")" ::: "memory")
#define PG8_WAIT_L(n) asm volatile("s_waitcnt lgkmcnt(" #n ")" ::: "memory")
#define PG8_BAR __builtin_amdgcn_s_barrier()
#define PG8_SCHED __builtin_amdgcn_sched_barrier(0)
    Unit cur, nxt; int ui = 0;
    if (!S.next(0, cur)) return;
    f32x4 acc[2][2][4][2];
#pragma unroll
    for (int a = 0; a < 2; ++a)
#pragma unroll
        for (int b = 0; b < 2; ++b)
#pragma unroll
            for (int m = 0; m < 4; ++m)
#pragma unroll
                for (int n = 0; n < 2; ++n) acc[a][b][m][n] = (f32x4){0.f, 0.f, 0.f, 0.f};
    bf16x8 At[4][2], B0[2][2], B1[2][2];
    const char* cA = (const char*)g.A + (size_t)cur.pm * tstepA; const char* cB = (const char*)g.Bt + (size_t)cur.pn * tstepB;
    S.a_ready(cur);
    if constexpr (SP2) {
        PG8_STAGE(PG8_SB(0, 0), cB, voffB); PG8_STAGE(PG8_SB(0, 1), cB + hstepB, voffB); PG8_STAGE(PG8_SA(0, 0), cA, voffA); PG8_STAGE(PG8_SA(0, 1), cA + hstepA, voffA);
        if (wr == 1) PG8_BAR;
        PG8_WAIT_V(2); PG8_BAR;
        PG8_STAGE(PG8_SB(1, 0), cB + kstep, voffB); PG8_STAGE(PG8_SA(1, 0), cA + kstep, voffA); PG8_STAGE(PG8_SB(1, 1), cB + hstepB + kstep, voffB);
        PG8_WAIT_V(6); PG8_BAR;
    } else {
        PG8_STAGE(PG8_SB(0, 0), cB, voffB); PG8_STAGE(PG8_SA(0, 0), cA, voffA); PG8_STAGE(PG8_SB(0, 1), cB + hstepB, voffB); PG8_STAGE(PG8_SA(0, 1), cA + hstepA, voffA);
        if (wr == 1) PG8_BAR;
        PG8_WAIT_V(4); PG8_BAR;
        PG8_STAGE(PG8_SB(1, 0), cB + kstep, voffB); PG8_STAGE(PG8_SA(1, 0), cA + kstep, voffA); PG8_STAGE(PG8_SB(1, 1), cB + hstepB + kstep, voffB);
        PG8_WAIT_V(6); PG8_BAR;
    }
    for (;;) {
        const bool has_next = S.next(ui + 1, nxt);
        const char* nA = has_next ? (const char*)g.A + (size_t)nxt.pm * tstepA : cA; const char* nB = has_next ? (const char*)g.Bt + (size_t)nxt.pn * tstepB : cB;
        for (int t = 0; t < nt; t += 2) {
            const bool last = (t == nt - 2);
            const char* a1 = cA + ((t + 1 < kmid) ? 0l : dA2) + (size_t)(t + 1) * kstep;
            const char* a2 = last ? nA : cA + ((t + 2 < kmid) ? 0l : dA2) + (size_t)(t + 2) * kstep; const char* b2 = last ? nB : cB + (size_t)(t + 2) * kstep;
            if constexpr (MID) { if (t == kmid) E.mid(acc, cur, wr, wc, fr, fq); }
            const char* a3 = a2 + kstep; const char* b3 = b2 + kstep;
            if (last && has_next) S.a_ready(nxt);
            if constexpr (SP2) {
            PG8_LDB(B0, 0, 0); PG8_LDB(B1, 0, 1); PG8_SCHED; PG8_LDA(At, 0, 0); PG8_STAGE(PG8_SA(1, 1), a1 + hstepA, voffA);
            PG8_WAIT_V(8); PG8_WAIT_L(0); PG8_BAR; PG8_MMA(0, 0, At, B0); PG8_MMA(0, 1, At, B1); PG8_BAR; PG8_SCHED;
            PG8_LDA(At, 0, 1); PG8_STAGE(PG8_SB(0, 0), b2, voffB); PG8_STAGE(PG8_SB(0, 1), b2 + hstepB, voffB); PG8_STAGE(PG8_SA(0, 0), a2, voffA);
            PG8_WAIT_V(8); PG8_WAIT_L(0); PG8_BAR; PG8_MMA(1, 0, At, B0); PG8_MMA(1, 1, At, B1); PG8_BAR; PG8_SCHED;
            PG8_LDB(B0, 1, 0); PG8_LDB(B1, 1, 1); PG8_SCHED; PG8_LDA(At, 1, 0); PG8_STAGE(PG8_SA(0, 1), a2 + hstepA, voffA);
            PG8_WAIT_V(8); PG8_WAIT_L(0); PG8_BAR; PG8_MMA(0, 0, At, B0); PG8_MMA(0, 1, At, B1); PG8_BAR; PG8_SCHED;
            PG8_LDA(At, 1, 1); PG8_STAGE(PG8_SB(1, 0), b3, voffB); PG8_STAGE(PG8_SB(1, 1), b3 + hstepB, voffB); PG8_STAGE(PG8_SA(1, 0), a3, voffA);
            PG8_WAIT_V(8); PG8_WAIT_L(0); PG8_BAR; PG8_MMA(1, 0, At, B0); PG8_MMA(1, 1, At, B1); PG8_BAR; PG8_SCHED;
            } else {
            PG8_LDB(B0, 0, 0); PG8_SCHED; PG8_LDA(At, 0, 0); PG8_STAGE(PG8_SA(1, 1), a1 + hstepA, voffA);
            PG8_WAIT_L(8); PG8_BAR; PG8_WAIT_L(0); PG8_MMA(0, 0, At, B0); PG8_BAR; PG8_SCHED;
            PG8_LDB(B1, 0, 1); PG8_STAGE(PG8_SB(0, 0), b2, voffB);
            PG8_BAR; PG8_WAIT_L(0); PG8_MMA(0, 1, At, B1); PG8_BAR;
            PG8_LDA(At, 0, 1); PG8_STAGE(PG8_SA(0, 0), a2, voffA);
            PG8_BAR; PG8_WAIT_L(0); PG8_MMA(1, 0, At, B0); PG8_BAR; PG8_SCHED;
            PG8_STAGE(PG8_SB(0, 1), b2 + hstepB, voffB);
            PG8_WAIT_V(6); PG8_BAR; PG8_MMA(1, 1, At, B1); PG8_BAR;
            PG8_LDB(B0, 1, 0); PG8_SCHED; PG8_LDA(At, 1, 0); PG8_STAGE(PG8_SA(0, 1), a2 + hstepA, voffA);
            PG8_WAIT_L(8); PG8_BAR; PG8_WAIT_L(0); PG8_MMA(0, 0, At, B0); PG8_BAR; PG8_SCHED;
            PG8_LDB(B1, 1, 1); PG8_STAGE(PG8_SB(1, 0), b3, voffB);
            PG8_BAR; PG8_WAIT_L(0); PG8_MMA(0, 1, At, B1); PG8_BAR;
            PG8_LDA(At, 1, 1); PG8_STAGE(PG8_SA(1, 0), a3, voffA);
            PG8_BAR; PG8_WAIT_L(0); PG8_MMA(1, 0, At, B0); PG8_BAR; PG8_SCHED;
            PG8_STAGE(PG8_SB(1, 1), b3 + hstepB, voffB);
            PG8_WAIT_V(6); PG8_BAR; PG8_MMA(1, 1, At, B1); PG8_BAR;
            }
        }
        if constexpr (ALIGN_EPI) { if (wr == 0) PG8_BAR; }
        if constexpr (!Epi::AFTER_DRAIN) { E(acc, cur, wr, wc, fr, fq); S.done(cur); }
        if (!has_next) break;
#pragma unroll
        for (int a = 0; a < 2; ++a)
#pragma unroll
            for (int b = 0; b < 2; ++b)
#pragma unroll
                for (int m = 0; m < 4; ++m)
#pragma unroll
                    for (int n = 0; n < 2; ++n) acc[a][b][m][n] = (f32x4){0.f, 0.f, 0.f, 0.f};
        cur = nxt; cA = nA; cB = nB; ++ui;
        if constexpr (ALIGN_EPI) { if (wr == 1) PG8_BAR; }
    }
    PG8_WAIT_V(0);
    if constexpr (!ALIGN_EPI) { if (wr == 0) PG8_BAR; }
    PG8_BAR;
    if constexpr (Epi::AFTER_DRAIN) { E.fused(acc, cur, wr, wc, fr, fq, lds, wid, lane); S.done(cur); }
#undef PG8_SA
#undef PG8_SB
#undef PG8_STAGE
#undef PG8_LDA
#undef PG8_LDB
#undef PG8_MMA
#undef PG8_WAIT_V
#undef PG8_WAIT_L
#undef PG8_BAR
#undef PG8_SCHED
}
}

struct Args {
    const float *x_prompt, *x_sample, *state_hgrn, *cache_k, *cache_v, *norm1_w, *w_in, *lb_logits, *hgrn_norm_w, *q_norm_w, *k_norm_w, *sinks,
                *w_o_hgrn, *w_o_attn, *w_out, *norm2_w, *w_ffn_gate, *w_ffn_up, *w_ffn_down;
    float* out; unsigned char* ws; int ph_lo, ph_hi;
};

__device__ __forceinline__ float wave_sum(float v) {
#pragma unroll
    for (int o = 1; o < 64; o <<= 1) v += __shfl_xor(v, o);
    return v;
}

__device__ __forceinline__ void p0_transpose_item(const float* __restrict__ W, int ldw, int K, bf16* WT, int k0, int n0, int drow0, const float* __restrict__ ks, LAS float* scr, int lane, int kofs = 0) {
    float wv[32];
#pragma unroll
    for (int i = 0; i < 32; ++i) wv[i] = W[(size_t)(k0 + 2 * i + (lane >> 5)) * ldw + n0 + (lane & 31)];
#pragma unroll
    for (int i = 0; i < 32; ++i) { const int kk = 2 * i + (lane >> 5); const float s = ks ? ks[k0 + kk] : 1.f; scr[kk * 33 + (lane & 31)] = wv[i] * s; }
    asm volatile("s_waitcnt lgkmcnt(0)" ::: "memory");
    const int c = lane & 7;
#pragma unroll
    for (int j = 0; j < 4; ++j) { const int n = (lane >> 3) + 8 * j; const LAS float* s = scr + (8 * c) * 33 + n;
        u32x4 o; o.x = pk2(s[0 * 33], s[1 * 33]); o.y = pk2(s[2 * 33], s[3 * 33]); o.z = pk2(s[4 * 33], s[5 * 33]); o.w = pk2(s[6 * 33], s[7 * 33]);
        *(u32x4*)(WT + (size_t)(drow0 + n) * K + kofs + k0 + 8 * c) = o; }
    asm volatile("s_waitcnt lgkmcnt(0)" ::: "memory");
}

constexpr int P0_I1 = 16 * 152, P0_NITEMS = 16 * 152 + 2 * 8 * 32 + 16 * 32 + 2 * 16 * 88 + 44 * 32;
__device__ __forceinline__ void p0_weights(const Args& a, unsigned char* lds, int it_lo, int it_hi, int widx, int nwork) {
    const int tid = threadIdx.x, lane = tid & 63, wave = tid >> 6;
    LAS float* scr = (LAS float*)(LAS void*)(lds + wave * 16384);
    unsigned char* ws = a.ws;
    constexpr int I1 = 16 * 152, I2 = 8 * 32, I4 = 16 * 32, I5 = 16 * 88;
    for (int it = it_lo + widx; it < it_hi; it += nwork) {
        int r = it;
        if (r < I1) { const int n0 = 32 * (r % 152);
            const int dr = n0 < 2816 ? n0 : (n0 < 3840 ? 2816 + ((n0 - 2816) >> 7) * 256 + ((n0 - 2816) & 127) : 2816 + ((n0 - 3840) >> 7) * 256 + 128 + ((n0 - 3840) & 127));
            p0_transpose_item(a.w_in, PW, 1024, (bf16*)(ws + WS_W1T), 64 * (r / 152), n0, dr, a.norm1_w, scr, lane); continue; } r -= I1;
        if (r < I2) { p0_transpose_item(a.w_o_hgrn, 1024, 1024, (bf16*)(ws + WS_WOH), 64 * (r / 32), 32 * (r % 32), 32 * (r % 32), nullptr, scr, lane, 0); continue; } r -= I2;
        if (r < I2) { p0_transpose_item(a.w_o_attn, 1024, 1024, (bf16*)(ws + WS_WOH), 64 * (r / 32), 32 * (r % 32), 32 * (r % 32), nullptr, scr, lane, 512); continue; } r -= I2;
        if (r < I4) { p0_transpose_item(a.w_out, 1024, 1024, (bf16*)(ws + WS_WOUT), 64 * (r / 32), 32 * (r % 32), 32 * (r % 32), nullptr, scr, lane); continue; } r -= I4;
        if (r < I5) { const int n0 = 32 * (r % 88); p0_transpose_item(a.w_ffn_gate, DFF, 1024, (bf16*)(ws + WS_WGU), 64 * (r / 88), n0, (n0 >> 7) * 256 + (n0 & 127), a.norm2_w, scr, lane); continue; } r -= I5;
        if (r < I5) { const int n0 = 32 * (r % 88); p0_transpose_item(a.w_ffn_up, DFF, 1024, (bf16*)(ws + WS_WGU), 64 * (r / 88), n0, (n0 >> 7) * 256 + 128 + (n0 & 127), a.norm2_w, scr, lane); continue; } r -= I5;
        p0_transpose_item(a.w_ffn_down, 1024, DFF, (bf16*)(ws + WS_WD), 64 * (r / 32), 32 * (r % 32), 32 * (r % 32), nullptr, scr, lane);
    }
}
__device__ __forceinline__ void p0_prologue(const Args& a, unsigned char* lds, int w_hi) {
    const int tid = threadIdx.x, lane = tid & 63, wave = tid >> 6;
    const int gw = blockIdx.x * 8 + wave, NGW = gridDim.x * 8;
    unsigned char* ws = a.ws;
    p0_weights(a, lds, 0, w_hi, gw, NGW);
    bf16* XB = (bf16*)(ws + WS_R0);
    for (int m = gw; m < MT; m += 2 * NGW) {
        const int m1 = m + NGW; const bool has1 = m1 < MT;
        const float* xrow0 = (m < MP) ? a.x_prompt + (size_t)m * 1024 : a.x_sample + (size_t)(m - MP) * 1024;
        const float* xrow1 = !has1 ? xrow0 : (m1 < MP) ? a.x_prompt + (size_t)m1 * 1024 : a.x_sample + (size_t)(m1 - MP) * 1024;
        const f32x4* xr0 = (const f32x4*)xrow0 + lane; const f32x4* xr1 = (const f32x4*)xrow1 + lane;
        f32x4 v[4], u[4]; float s0 = 0.f, s1 = 0.f;
#pragma unroll
        for (int j = 0; j < 4; ++j) { v[j] = xr0[64 * j]; u[j] = xr1[64 * j]; }
#pragma unroll
        for (int j = 0; j < 4; ++j) { s0 += (v[j][0] * v[j][0] + v[j][1] * v[j][1]) + (v[j][2] * v[j][2] + v[j][3] * v[j][3]); s1 += (u[j][0] * u[j][0] + u[j][1] * u[j][1]) + (u[j][2] * u[j][2] + u[j][3] * u[j][3]); }
        const float r0 = __builtin_amdgcn_rsqf(wave_sum(s0) * (1.f / 1024.f) + EPS), r1 = __builtin_amdgcn_rsqf(wave_sum(s1) * (1.f / 1024.f) + EPS);
        u32x2* o0 = (u32x2*)(XB + (size_t)m * 1024) + lane; u32x2* o1 = (u32x2*)(XB + (size_t)m1 * 1024) + lane;
#pragma unroll
        for (int j = 0; j < 4; ++j) { u32x2 w; w.x = pk2(v[j][0] * r0, v[j][1] * r0); w.y = pk2(v[j][2] * r0, v[j][3] * r0); o0[64 * j] = w; }
        if (has1) {
#pragma unroll
            for (int j = 0; j < 4; ++j) { u32x2 w; w.x = pk2(u[j][0] * r1, u[j][1] * r1); w.y = pk2(u[j][2] * r1, u[j][3] * r1); o1[64 * j] = w; }
        }
    }
    float* sumsq = (float*)(ws + WS_SUMSQ);
    for (int i = blockIdx.x * NTHREADS + tid; i < MT; i += gridDim.x * NTHREADS) sumsq[i] = 0.f;
    if (blockIdx.x == 0) { float* lbv = (float*)(ws + WS_LBV); lbv[tid] = sigm(a.lb_logits[tid] - a.lb_logits[512 + tid]); }
}

__device__ __forceinline__ void hgrn_local_phase(const Args& a, unsigned char* lds) {
    const int tid = threadIdx.x, lane = tid & 63, wid = tid >> 6, G = gridDim.x;
    float* cumS = (float*)lds; float* segT = (float*)(lds + 32768); bf16* KdS = (bf16*)(lds + 34816); bf16* VS = (bf16*)(lds + 52224);
    unsigned char* ws = a.ws;
    constexpr int N_LOC = 512 * 4;
    f32x4 gr[4]; u32x4 vr[2];
    int it = blockIdx.x;
#define HL_LOAD(IT) do { const size_t r0_ = (size_t)((IT) >> 2) * 64; const int h_ = (IT) & 3; \
        const size_t ho_ = ((size_t)h_ * MT + r0_) * 128; const float* G_ = (const float*)(ws + WS_R3) + ho_; const bf16* V_ = (const bf16*)(ws + WS_R4) + ho_; \
        _Pragma("unroll") for (int i = 0; i < 4; ++i) { const int idx = tid + 512 * i; gr[i] = *(const f32x4*)(G_ + 4 * idx); } \
        _Pragma("unroll") for (int i = 0; i < 2; ++i) { const int idx = tid + 512 * i; vr[i] = *(const u32x4*)(V_ + 8 * idx); } } while (0)
    if (it < N_LOC) HL_LOAD(it);
    for (; it < N_LOC; it += G) {
        const int cidx = it >> 2, h = it & 3;
        const size_t r0 = (size_t)cidx * 64;
        float* Gp = (float*)(ws + WS_R3) + ((size_t)h * MT + r0) * 128;
#pragma unroll
        for (int i = 0; i < 4; ++i) { const int idx = tid + 512 * i, j = idx >> 5, k4 = (idx & 31) * 4; *(f32x4*)(cumS + j * 128 + k4) = gr[i]; }
        __syncthreads();
        {
            const int k = tid & 127, seg = tid >> 7; float v[16]; float run = 0.f;
#pragma unroll
            for (int i = 0; i < 16; ++i) { run += cumS[(seg * 16 + i) * 128 + k]; v[i] = run; }
            segT[seg * 128 + k] = run;
            __syncthreads();
            float off = 0.f;
#pragma unroll
            for (int s = 0; s < 3; ++s) off += (s < seg) ? segT[s * 128 + k] : 0.f;
#pragma unroll
            for (int i = 0; i < 16; ++i) cumS[(seg * 16 + i) * 128 + k] = v[i] + off;
        }
        __syncthreads();
#pragma unroll
        for (int i = 0; i < 4; ++i) { const int idx = tid + 512 * i; *(f32x4*)(Gp + 4 * idx) = *(const f32x4*)(cumS + 4 * idx); }
        if (tid < 128) ((float*)(ws + WS_DT))[(size_t)(cidx * 4 + h) * 128 + tid] = __expf(cumS[63 * 128 + tid]);
#pragma unroll
        for (int i = 0; i < 2; ++i) {
            const int idx = tid + 512 * i, j = idx >> 4, k8 = (idx & 15) * 8;
            const f32x4 c0 = *(const f32x4*)(cumS + j * 128 + k8), c1 = *(const f32x4*)(cumS + j * 128 + k8 + 4);
            const f32x4 z4 = {0.f, 0.f, 0.f, 0.f};
            const f32x4 p0 = j ? *(const f32x4*)(cumS + (j - 1) * 128 + k8) : z4, p1 = j ? *(const f32x4*)(cumS + (j - 1) * 128 + k8 + 4) : z4;
            const f32x4 l0 = *(const f32x4*)(cumS + 63 * 128 + k8), l1 = *(const f32x4*)(cumS + 63 * 128 + k8 + 4);
            float kk[8];
#pragma unroll
            for (int x = 0; x < 4; ++x) { kk[x] = 1.f - __expf(c0[x] - p0[x]); kk[4 + x] = 1.f - __expf(c1[x] - p1[x]); }
            u32x4 w;
            w.x = pk2(kk[0] * __expf(l0[0] - c0[0]), kk[1] * __expf(l0[1] - c0[1]));
            w.y = pk2(kk[2] * __expf(l0[2] - c0[2]), kk[3] * __expf(l0[3] - c0[3]));
            w.z = pk2(kk[4] * __expf(l1[0] - c1[0]), kk[5] * __expf(l1[1] - c1[1]));
            w.w = pk2(kk[6] * __expf(l1[2] - c1[2]), kk[7] * __expf(l1[3] - c1[3]));
            *(u32x4*)(KdS + j * 136 + k8) = w;
            *(u32x4*)(VS + j * 136 + k8) = vr[i];
        }
        __syncthreads();
        if (it + G < N_LOC) HL_LOAD(it + G);
        {
            const int i16 = lane & 15, g = lane >> 4, q = i16 >> 2, p = i16 & 3;
            bf16x8 af[2];
#pragma unroll
            for (int jc = 0; jc < 2; ++jc) af[jc] = cat8(tr_read(KdS + (32 * jc + 8 * g + q) * 136 + 16 * wid + 4 * p), tr_read(KdS + (32 * jc + 8 * g + 4 + q) * 136 + 16 * wid + 4 * p));
            bf16* SLT = (bf16*)(ws + WS_R0) + (size_t)(cidx * 4 + h) * 16384;
#pragma unroll
            for (int nt = 0; nt < 8; ++nt) {
                f32x4 acc = {0.f, 0.f, 0.f, 0.f};
#pragma unroll
                for (int jc = 0; jc < 2; ++jc) {
                    const bf16x8 bfr = cat8(tr_read(VS + (32 * jc + 8 * g + q) * 136 + 16 * nt + 4 * p), tr_read(VS + (32 * jc + 8 * g + 4 + q) * 136 + 16 * nt + 4 * p));
                    acc = MFMA16(af[jc], bfr, acc);
                }
                u32x2 w; w.x = pk2(acc[0], acc[1]); w.y = pk2(acc[2], acc[3]);
                *(u32x2*)(SLT + (size_t)(16 * nt + i16) * 128 + 16 * wid + 4 * g) = w;
            }
        }
        __syncthreads();
    }
#undef HL_LOAD
}

__device__ __forceinline__ void attn_prompt_item(const Args& a, int b, int qb, int kvh, unsigned char* lds) {
    const int tid = threadIdx.x, lane = tid & 63, wid = __builtin_amdgcn_readfirstlane(tid >> 6);
    bf16* KS = (bf16*)lds; bf16* VS = (bf16*)(lds + 36864);
    unsigned char* ws = a.ws;
    const bf16* QA = (const bf16*)(ws + WS_R6); const bf16* KV = (const bf16*)(ws + WS_R7); bf16* YB = (bf16*)(ws + WS_R10);
    {
        const int key = tid >> 1, half = tid & 1;
        u32x4 kw[4], vw[4];
        const bool zero = (qb == 0 && key < 128);
        const size_t row = (size_t)b * SEQ + (size_t)(qb - 1) * 128 + key;
#pragma unroll
        for (int c = 0; c < 4; ++c) {
            if (zero) { kw[c] = (u32x4){0u, 0u, 0u, 0u}; vw[c] = kw[c]; }
            else { kw[c] = *(const u32x4*)(KV + row * 256 + kvh * 64 + half * 32 + 8 * c); vw[c] = *(const u32x4*)(KV + row * 256 + 128 + kvh * 64 + half * 32 + 8 * c); }
        }
        float ss = 0.f;
#pragma unroll
        for (int c = 0; c < 4; ++c) { const float e0 = bflo(kw[c].x), e1 = bfhi(kw[c].x), e2 = bflo(kw[c].y), e3 = bfhi(kw[c].y), e4 = bflo(kw[c].z), e5 = bfhi(kw[c].z), e6 = bflo(kw[c].w), e7 = bfhi(kw[c].w);
            ss += (e0 * e0 + e1 * e1) + (e2 * e2 + e3 * e3) + (e4 * e4 + e5 * e5) + (e6 * e6 + e7 * e7); }
        ss += __shfl_xor(ss, 1);
        const float rstd = __builtin_amdgcn_rsqf(ss * (1.f / 64.f) + EPS);
        const bool wr_cache = (qb == SEQ / 128 - 1) && key >= 128;
        float* ck = a.out + O_KP + ((size_t)(b * 128 + (key - 128)) * 2 + kvh) * 64 + half * 32;
        float* cv = a.out + O_VP + ((size_t)(b * 128 + (key - 128)) * 2 + kvh) * 64 + half * 32;
#pragma unroll
        for (int c = 0; c < 4; ++c) {
            const f32x4 w0 = *(const f32x4*)(a.k_norm_w + half * 32 + 8 * c), w1 = *(const f32x4*)(a.k_norm_w + half * 32 + 8 * c + 4);
            f32x4 n0, n1;
            n0[0] = bflo(kw[c].x) * rstd * w0[0]; n0[1] = bfhi(kw[c].x) * rstd * w0[1]; n0[2] = bflo(kw[c].y) * rstd * w0[2]; n0[3] = bfhi(kw[c].y) * rstd * w0[3];
            n1[0] = bflo(kw[c].z) * rstd * w1[0]; n1[1] = bfhi(kw[c].z) * rstd * w1[1]; n1[2] = bflo(kw[c].w) * rstd * w1[2]; n1[3] = bfhi(kw[c].w) * rstd * w1[3];
            u32x4 w; w.x = pk2(n0[0], n0[1]); w.y = pk2(n0[2], n0[3]); w.z = pk2(n1[0], n1[1]); w.w = pk2(n1[2], n1[3]);
            *(u32x4*)(KS + key * 72 + half * 32 + 8 * c) = w;
            *(u32x4*)(VS + key * 72 + half * 32 + 8 * c) = vw[c];
            if (wr_cache) {
                *(f32x4*)(ck + 8 * c) = n0; *(f32x4*)(ck + 8 * c + 4) = n1;
                *(f32x4*)(cv + 8 * c) = (f32x4){bflo(vw[c].x), bfhi(vw[c].x), bflo(vw[c].y), bfhi(vw[c].y)};
                *(f32x4*)(cv + 8 * c + 4) = (f32x4){bflo(vw[c].z), bfhi(vw[c].z), bflo(vw[c].w), bfhi(vw[c].w)};
            }
        }
    }
    __syncthreads();
    const int i16 = lane & 15, g = lane >> 4, q = i16 >> 2, p = i16 & 3;
    const int qt = wid, t0 = qt > 0 ? qt - 1 : 0;
    const size_t row = (size_t)b * SEQ + (size_t)qb * 128 + 16 * qt + i16;
    f32x4 dl2[10];
    {
        const int qz = (qb == 0) ? -1 : 0, band0 = 16 * t0 + 4 * g, dist0 = 128 + 16 * qt + i16 - band0;
#pragma unroll
        for (int t = 0; t < 10; ++t)
#pragma unroll
            for (int r = 0; r < 4; ++r) {
                const int band = band0 + 16 * t + r, dist = dist0 - 16 * t - r;
                const int msk = ((dist | (127 - dist)) >> 31) | (((band - 128) >> 31) & qz);
                dl2[t][r] = msk ? 1e30f : (float)dist * 1.4426950408889634f;
            }
    }
    u32x4 qnx[2];
    qnx[0] = *(const u32x4*)(QA + row * 512 + kvh * 256 + 8 * g); qnx[1] = *(const u32x4*)(QA + row * 512 + kvh * 256 + 32 + 8 * g);
#pragma unroll 1
    for (int g4 = 0; g4 < 4; ++g4) {
        asm volatile("" ::: "memory");
        const int hq = kvh * 4 + g4;
        bf16x8 bq[2];
        {
            u32x4 qw[2]; float ss = 0.f;
            qw[0] = qnx[0]; qw[1] = qnx[1];
            if (g4 < 3) { qnx[0] = *(const u32x4*)(QA + row * 512 + (hq + 1) * 64 + 8 * g); qnx[1] = *(const u32x4*)(QA + row * 512 + (hq + 1) * 64 + 32 + 8 * g); }
#pragma unroll
            for (int c = 0; c < 2; ++c) {
                const float e0 = bflo(qw[c].x), e1 = bfhi(qw[c].x), e2 = bflo(qw[c].y), e3 = bfhi(qw[c].y), e4 = bflo(qw[c].z), e5 = bfhi(qw[c].z), e6 = bflo(qw[c].w), e7 = bfhi(qw[c].w);
                ss += (e0 * e0 + e1 * e1) + (e2 * e2 + e3 * e3) + (e4 * e4 + e5 * e5) + (e6 * e6 + e7 * e7); }
            ss += __shfl_xor(ss, 16); ss += __shfl_xor(ss, 32);
            const float rstd = __builtin_amdgcn_rsqf(ss * (1.f / 64.f) + EPS);
#pragma unroll
            for (int c = 0; c < 2; ++c) {
                const f32x4 w0 = *(const f32x4*)(a.q_norm_w + 32 * c + 8 * g), w1 = *(const f32x4*)(a.q_norm_w + 32 * c + 8 * g + 4);
                u32x4 w;
                w.x = pk2(bflo(qw[c].x) * rstd * w0[0], bfhi(qw[c].x) * rstd * w0[1]); w.y = pk2(bflo(qw[c].y) * rstd * w0[2], bfhi(qw[c].y) * rstd * w0[3]);
                w.z = pk2(bflo(qw[c].z) * rstd * w1[0], bfhi(qw[c].z) * rstd * w1[1]); w.w = pk2(bflo(qw[c].w) * rstd * w1[2], bfhi(qw[c].w) * rstd * w1[3]);
                bq[c] = __builtin_bit_cast(bf16x8, w);
            }
        }
        const float nslope = -exp2f(-(float)(hq + 1)), sink2 = a.sinks[hq] * 1.4426950408889634f;
        f32x4 sc[10]; float mx = -3.0e38f;
#pragma unroll
        for (int t = 0; t < 10; ++t) {
            f32x4 s = {0.f, 0.f, 0.f, 0.f};
#pragma unroll
            for (int c = 0; c < 2; ++c) s = MFMA16(*(const bf16x8*)(KS + (16 * (t0 + t) + i16) * 72 + 32 * c + 8 * g), bq[c], s);
            s = s * (0.125f * 1.4426950408889634f) + dl2[t] * nslope;
            mx = fmaxf(mx, fmaxf(fmaxf(s[0], s[1]), fmaxf(s[2], s[3])));
            sc[t] = s;
        }
        mx = fmaxf(mx, __shfl_xor(mx, 16)); mx = fmaxf(mx, __shfl_xor(mx, 32)); mx = fmaxf(mx, sink2);
        f32x4 sum4 = {0.f, 0.f, 0.f, 0.f};
#pragma unroll
        for (int t = 0; t < 10; ++t) {
            const f32x4 d = sc[t] - mx; f32x4 ev;
            ev[0] = __builtin_amdgcn_exp2f(d[0]); ev[1] = __builtin_amdgcn_exp2f(d[1]); ev[2] = __builtin_amdgcn_exp2f(d[2]); ev[3] = __builtin_amdgcn_exp2f(d[3]);
            sc[t] = ev; sum4 += ev;
        }
        float sum = (sum4[0] + sum4[1]) + (sum4[2] + sum4[3]);
        sum += __shfl_xor(sum, 16); sum += __shfl_xor(sum, 32);
        const float inv = 1.f / (sum + __builtin_amdgcn_exp2f(sink2 - mx));
        bf16x8 pb[5];
#pragma unroll
        for (int ch = 0; ch < 5; ++ch) pb[ch] = pk8(sc[2 * ch], sc[2 * ch + 1]);
#pragma unroll
        for (int dt = 0; dt < 4; ++dt) {
            f32x4 acc = {0.f, 0.f, 0.f, 0.f};
#pragma unroll
            for (int ch = 0; ch < 5; ++ch) {
                const bf16x8 av = cat8(tr_read(VS + (16 * (t0 + 2 * ch) + 4 * g + q) * 72 + 16 * dt + 4 * p), tr_read(VS + (16 * (t0 + 2 * ch + 1) + 4 * g + q) * 72 + 16 * dt + 4 * p));
                acc = MFMA16(av, pb[ch], acc);
            }
            u32x2 w; w.x = pk2(acc[0] * inv, acc[1] * inv); w.y = pk2(acc[2] * inv, acc[3] * inv);
            *(u32x2*)(YB + row * 512 + hq * 64 + 16 * dt + 4 * g) = w;
        }
    }
    __syncthreads();
}

__device__ __forceinline__ void attn_sample_item(const Args& a, int b, unsigned char* lds) {
    const int tid = threadIdx.x;
    float* qn = (float*)lds; float* knew = (float*)(lds + 8192); float* vnew = (float*)(lds + 10240); float* sc = (float*)(lds + 12288); float* invs = (float*)(lds + 29696); float* cb = (float*)(lds + 32768);
    unsigned char* ws = a.ws;
    const bf16* QA = (const bf16*)(ws + WS_R6); const bf16* KV = (const bf16*)(ws + WS_R7); bf16* YB = (bf16*)(ws + WS_R10);
    const size_t rb = (size_t)MP + (size_t)b * 4;
    const float* ck = a.cache_k + (size_t)b * 16384; const float* cv = a.cache_v + (size_t)b * 16384;
    f32x4 kreg[8];
#pragma unroll
    for (int i = 0; i < 8; ++i) kreg[i] = *(const f32x4*)(ck + 4 * (tid + 512 * i));
    {
        const int pair = tid >> 4, d4 = (tid & 15) * 4, hq = pair >> 2, t = pair & 3;
        const u32x2 w = *(const u32x2*)(QA + (rb + t) * 512 + hq * 64 + d4);
        const float e0 = bflo(w.x), e1 = bfhi(w.x), e2 = bflo(w.y), e3 = bfhi(w.y);
        float ss = (e0 * e0 + e1 * e1) + (e2 * e2 + e3 * e3);
        ss += __shfl_xor(ss, 1); ss += __shfl_xor(ss, 2); ss += __shfl_xor(ss, 4); ss += __shfl_xor(ss, 8);
        const float rstd = __builtin_amdgcn_rsqf(ss * (1.f / 64.f) + EPS);
        const f32x4 nw = *(const f32x4*)(a.q_norm_w + d4);
        *(f32x4*)(qn + pair * 64 + d4) = (f32x4){e0 * rstd * nw[0], e1 * rstd * nw[1], e2 * rstd * nw[2], e3 * rstd * nw[3]};
    }
    if (tid < 128) {
        const int t = tid >> 5, kvh = (tid >> 4) & 1, d4 = (tid & 15) * 4;
        const u32x2 w = *(const u32x2*)(KV + (rb + t) * 256 + kvh * 64 + d4);
        const float e0 = bflo(w.x), e1 = bfhi(w.x), e2 = bflo(w.y), e3 = bfhi(w.y);
        float ss = (e0 * e0 + e1 * e1) + (e2 * e2 + e3 * e3);
        ss += __shfl_xor(ss, 1); ss += __shfl_xor(ss, 2); ss += __shfl_xor(ss, 4); ss += __shfl_xor(ss, 8);
        const float rstd = __builtin_amdgcn_rsqf(ss * (1.f / 64.f) + EPS);
        const f32x4 nw = *(const f32x4*)(a.k_norm_w + d4);
        *(f32x4*)(knew + t * 128 + kvh * 64 + d4) = (f32x4){e0 * rstd * nw[0], e1 * rstd * nw[1], e2 * rstd * nw[2], e3 * rstd * nw[3]};
        const u32x2 v = *(const u32x2*)(KV + (rb + t) * 256 + 128 + kvh * 64 + d4);
        *(f32x4*)(vnew + t * 128 + kvh * 64 + d4) = (f32x4){bflo(v.x), bfhi(v.x), bflo(v.y), bfhi(v.y)};
    }
    {
        float* ok = a.out + O_KS + (size_t)b * 16384;
#pragma unroll
        for (int i = 0; i < 8; ++i) { const int f = 4 * (tid + 512 * i); *(f32x4*)(cb + f) = kreg[i];
            if (f >= 512) *(f32x4*)(ok + f - 512) = kreg[i]; }
    }
    __syncthreads();
    if (tid < 128) { const int f = 4 * tid;
        *(f32x4*)(a.out + O_KS + (size_t)b * 16384 + 124 * 128 + f) = *(const f32x4*)(knew + f); *(f32x4*)(a.out + O_VS + (size_t)b * 16384 + 124 * 128 + f) = *(const f32x4*)(vnew + f); }
    for (int idx = tid; idx < 132 * 32; idx += 512) {
        const int key = idx >> 5, pair = idx & 31, hq = pair >> 2, t = pair & 3, kvh = hq >> 2;
        const float* qp = qn + pair * 64; float dot = 0.f;
        const float* kp = key < 128 ? cb + (key * 2 + kvh) * 64 : knew + (key - 128) * 128 + kvh * 64;
#pragma unroll
        for (int d = 0; d < 64; d += 4) { const f32x4 kk = *(const f32x4*)(kp + d), qq = *(const f32x4*)(qp + d); dot += (kk[0] * qq[0] + kk[1] * qq[1]) + (kk[2] * qq[2] + kk[3] * qq[3]); }
        const int dist = key < 128 ? t + 128 - key : t - (key - 128);
        const bool valid = dist >= 0 && dist < 128;
        sc[pair * 136 + key] = valid ? dot * 0.125f - exp2f(-(float)(hq + 1)) * (float)dist : -1e30f;
    }
    __syncthreads();
    f32x4 vreg[8];
#pragma unroll
    for (int i = 0; i < 8; ++i) vreg[i] = *(const f32x4*)(cv + 4 * (tid + 512 * i));
    {
        const int pair = tid >> 4, l16 = tid & 15, hq = pair >> 2; const float sink = a.sinks[hq];
        float mx = -3.0e38f;
        for (int key = l16; key < 132; key += 16) mx = fmaxf(mx, sc[pair * 136 + key]);
        mx = fmaxf(mx, __shfl_xor(mx, 1)); mx = fmaxf(mx, __shfl_xor(mx, 2)); mx = fmaxf(mx, __shfl_xor(mx, 4)); mx = fmaxf(mx, __shfl_xor(mx, 8));
        mx = fmaxf(mx, sink);
        float sum = 0.f;
        for (int key = l16; key < 132; key += 16) { const float e = __expf(sc[pair * 136 + key] - mx); sc[pair * 136 + key] = e; sum += e; }
        sum += __shfl_xor(sum, 1); sum += __shfl_xor(sum, 2); sum += __shfl_xor(sum, 4); sum += __shfl_xor(sum, 8);
        if (l16 == 0) invs[pair] = 1.f / (sum + __expf(sink - mx));
    }
    { float* ov = a.out + O_VS + (size_t)b * 16384;
#pragma unroll
      for (int i = 0; i < 8; ++i) { const int f = 4 * (tid + 512 * i); *(f32x4*)(cb + f) = vreg[i]; if (f >= 512) *(f32x4*)(ov + f - 512) = vreg[i]; } }
    __syncthreads();
    {
        const int pair = tid >> 4, d4 = (tid & 15) * 4, hq = pair >> 2, t = pair & 3, kvh = hq >> 2;
        f32x4 acc = {0.f, 0.f, 0.f, 0.f};
#pragma unroll 8
        for (int key = 0; key < 128; ++key) { const float pv = sc[pair * 136 + key]; acc += pv * *(const f32x4*)(cb + (key * 2 + kvh) * 64 + d4); }
#pragma unroll
        for (int key = 0; key < 4; ++key) { const float pv = sc[pair * 136 + 128 + key]; acc += pv * *(const f32x4*)(vnew + key * 128 + kvh * 64 + d4); }
        const float inv = invs[pair];
        u32x2 w; w.x = pk2(acc[0] * inv, acc[1] * inv); w.y = pk2(acc[2] * inv, acc[3] * inv);
        *(u32x2*)(YB + (rb + t) * 512 + hq * 64 + d4) = w;
    }
    __syncthreads();
}

__device__ __forceinline__ void hgrn_scan(const Args& a, int sb, int ns, unsigned char* lds) {
    unsigned char* ws = a.ws;
    bf16* SLT = (bf16*)(ws + WS_R0); const float* DT = (const float*)(ws + WS_DT);
    float* dts = (float*)lds;
    for (int e0 = sb * NTHREADS; e0 < 4 * 4 * 128 * 16; e0 += ns * NTHREADS) {
        const int e = e0 + threadIdx.x;
        const int k8 = (e & 15) * 8, v = (e >> 4) & 127, h = (e0 >> 11) & 3, b = e0 >> 13;
        __syncthreads();
#pragma unroll
        for (int i = 0; i < 8; ++i) { const int idx = threadIdx.x + 512 * i, c = idx >> 5, k4 = (idx & 31) * 4; *(f32x4*)(dts + c * 128 + k4) = *(const f32x4*)(DT + (size_t)((b * 128 + c) * 4 + h) * 128 + k4); }
        __syncthreads();
        float st[8];
#pragma unroll
        for (int j = 0; j < 8; ++j) st[j] = 0.f;
        for (int c0 = 0; c0 < 128; c0 += 16) {
            u32x4 loc[16];
#pragma unroll
            for (int i = 0; i < 16; ++i) { const size_t ci = (size_t)((b * 128 + c0 + i) * 4 + h); loc[i] = *(const u32x4*)(SLT + (ci * 128 + v) * 128 + k8); }
#pragma unroll
            for (int i = 0; i < 16; ++i) { const size_t ci = (size_t)((b * 128 + c0 + i) * 4 + h);
                const f32x4 d0 = *(const f32x4*)(dts + (c0 + i) * 128 + k8), d1 = *(const f32x4*)(dts + (c0 + i) * 128 + k8 + 4);
                u32x4 w; w.x = pk2(st[0], st[1]); w.y = pk2(st[2], st[3]); w.z = pk2(st[4], st[5]); w.w = pk2(st[6], st[7]);
                *(u32x4*)(SLT + (ci * 128 + v) * 128 + k8) = w;
                st[0] = d0[0] * st[0] + bflo(loc[i].x); st[1] = d0[1] * st[1] + bfhi(loc[i].x); st[2] = d0[2] * st[2] + bflo(loc[i].y); st[3] = d0[3] * st[3] + bfhi(loc[i].y);
                st[4] = d1[0] * st[4] + bflo(loc[i].z); st[5] = d1[1] * st[5] + bfhi(loc[i].z); st[6] = d1[2] * st[6] + bflo(loc[i].w); st[7] = d1[3] * st[7] + bfhi(loc[i].w); }
        }
        float* o = a.out + O_SP + ((size_t)(b * 4 + h) * 128 + k8) * 128 + v;
#pragma unroll
        for (int j = 0; j < 8; ++j) o[j * 128] = st[j];
    }
}

__device__ __forceinline__ void hgrn_out_phase(const Args& a, unsigned char* lds) {
    const int tid = threadIdx.x, lane = tid & 63, wid = tid >> 6, G = gridDim.x;
    bf16* QdS = (bf16*)lds; bf16* KxS = (bf16*)(lds + 17408); bf16* VS = (bf16*)(lds + 34816); bf16* SS = (bf16*)(lds + 52224); float* red = (float*)(lds + 87040);
    unsigned char* ws = a.ws;
    constexpr int N_OUT = 512 * 4;
    f32x4 c0r[2], c1r[2]; u32x4 qr[2], kr[2], vr[2], sr[4];
#define HO_LOAD(IT) do { const size_t r0_ = (size_t)((IT) >> 2) * 64; const int h_ = (IT) & 3; \
        const size_t ho_ = ((size_t)h_ * MT + r0_) * 128; const float* CU_ = (const float*)(ws + WS_R3) + ho_; const bf16* Q_ = (const bf16*)(ws + WS_R1) + ho_; \
        const bf16* K_ = (const bf16*)(ws + WS_R2) + ho_; const bf16* V_ = (const bf16*)(ws + WS_R4) + ho_; const bf16* S_ = (const bf16*)(ws + WS_R0) + (size_t)(IT) * 16384; \
        _Pragma("unroll") for (int i = 0; i < 2; ++i) { const int idx = tid + 512 * i; \
            c0r[i] = *(const f32x4*)(CU_ + 8 * idx); c1r[i] = *(const f32x4*)(CU_ + 8 * idx + 4); \
            qr[i] = *(const u32x4*)(Q_ + 8 * idx); kr[i] = *(const u32x4*)(K_ + 8 * idx); vr[i] = *(const u32x4*)(V_ + 8 * idx); } \
        _Pragma("unroll") for (int i = 0; i < 4; ++i) { const int idx = tid + 512 * i, v = idx >> 4, c8 = (idx & 15) * 8; sr[i] = *(const u32x4*)(S_ + (size_t)v * 128 + c8); } } while (0)
    int it = blockIdx.x;
    if (it < N_OUT) HO_LOAD(it);
    for (; it < N_OUT; it += G) {
        const int cidx = it >> 2, h = it & 3;
        const size_t r0 = (size_t)cidx * 64;
        const bf16* OG = (const bf16*)(ws + WS_R5) + ((size_t)h * MT + r0) * 128;
        bf16* YA = (bf16*)(ws + WS_R6) + r0 * 512 + h * 128;
#pragma unroll
        for (int i = 0; i < 2; ++i) {
            const int idx = tid + 512 * i, j = idx >> 4, k8 = (idx & 15) * 8;
            const f32x4 c0 = c0r[i], c1 = c1r[i]; const u32x4 qw = qr[i], kw = kr[i];
            float e[8], ei[8];
#pragma unroll
            for (int x = 0; x < 4; ++x) { e[x] = __expf(c0[x]); e[4 + x] = __expf(c1[x]); ei[x] = __expf(-c0[x]); ei[4 + x] = __expf(-c1[x]); }
            u32x4 w;
            w.x = pk2(bflo(qw.x) * e[0], bfhi(qw.x) * e[1]); w.y = pk2(bflo(qw.y) * e[2], bfhi(qw.y) * e[3]); w.z = pk2(bflo(qw.z) * e[4], bfhi(qw.z) * e[5]); w.w = pk2(bflo(qw.w) * e[6], bfhi(qw.w) * e[7]);
            *(u32x4*)(QdS + j * 136 + k8) = w;
            w.x = pk2(bflo(kw.x) * ei[0], bfhi(kw.x) * ei[1]); w.y = pk2(bflo(kw.y) * ei[2], bfhi(kw.y) * ei[3]); w.z = pk2(bflo(kw.z) * ei[4], bfhi(kw.z) * ei[5]); w.w = pk2(bflo(kw.w) * ei[6], bfhi(kw.w) * ei[7]);
            *(u32x4*)(KxS + j * 136 + k8) = w;
            *(u32x4*)(VS + j * 136 + k8) = vr[i];
        }
#pragma unroll
        for (int i = 0; i < 4; ++i) { const int idx = tid + 512 * i, v = idx >> 4, c8 = (idx & 15) * 8; *(u32x4*)(SS + v * 136 + c8) = sr[i]; }
        __syncthreads();
        if (it + G < N_OUT) HO_LOAD(it + G);
        const int i16 = lane & 15, g = lane >> 4, q = i16 >> 2, p = i16 & 3, tt = wid & 3, vh = wid >> 2;
        u32x2 ogr[4];
#pragma unroll
        for (int vt = 0; vt < 4; ++vt) ogr[vt] = *(const u32x2*)(OG + (size_t)(16 * tt + i16) * 128 + vh * 64 + 16 * vt + 4 * g);
        bf16x8 bq[4];
#pragma unroll
        for (int kc = 0; kc < 4; ++kc) bq[kc] = *(const bf16x8*)(QdS + (16 * tt + i16) * 136 + 32 * kc + 8 * g);
        f32x4 sc[4];
#pragma unroll
        for (int jt = 0; jt < 4; ++jt) {
            f32x4 sv = {0.f, 0.f, 0.f, 0.f};
            if (jt <= tt) {
#pragma unroll
                for (int kc = 0; kc < 4; ++kc) sv = MFMA16(*(const bf16x8*)(KxS + (16 * jt + i16) * 136 + 32 * kc + 8 * g), bq[kc], sv);
                if (jt == tt) {
#pragma unroll
                    for (int r = 0; r < 4; ++r) sv[r] = (4 * g + r > i16) ? 0.f : sv[r];
                }
            }
            sc[jt] = sv;
        }
        bf16x8 pb[2];
        pb[0] = pk8(sc[0], sc[1]); pb[1] = pk8(sc[2], sc[3]);
        f32x4 acc[4]; float ss = 0.f;
#pragma unroll
        for (int vt = 0; vt < 4; ++vt) {
            const int v0 = vh * 64 + 16 * vt;
            f32x4 c = {0.f, 0.f, 0.f, 0.f};
#pragma unroll
            for (int kc = 0; kc < 4; ++kc) c = MFMA16(*(const bf16x8*)(SS + (v0 + i16) * 136 + 32 * kc + 8 * g), bq[kc], c);
#pragma unroll
            for (int jc = 0; jc < 2; ++jc) {
                const bf16x8 av = cat8(tr_read(VS + (32 * jc + 4 * g + q) * 136 + v0 + 4 * p), tr_read(VS + (32 * jc + 16 + 4 * g + q) * 136 + v0 + 4 * p));
                c = MFMA16(av, pb[jc], c);
            }
            acc[vt] = c; ss += (c[0] * c[0] + c[1] * c[1]) + (c[2] * c[2] + c[3] * c[3]);
        }
        ss += __shfl_xor(ss, 16); ss += __shfl_xor(ss, 32);
        if (g == 0) red[vh * 64 + 16 * tt + i16] = ss;
        __syncthreads();
        const float rstd = __builtin_amdgcn_rsqf((red[16 * tt + i16] + red[64 + 16 * tt + i16]) * (1.f / 128.f) + EPS);
#pragma unroll
        for (int vt = 0; vt < 4; ++vt) {
            const int col = vh * 64 + 16 * vt + 4 * g; const size_t t = (size_t)(16 * tt + i16);
            const u32x2 ow = ogr[vt]; const f32x4 nw = *(const f32x4*)(a.hgrn_norm_w + h * 128 + col);
            u32x2 w; w.x = pk2(acc[vt][0] * rstd * nw[0] * bflo(ow.x), acc[vt][1] * rstd * nw[1] * bfhi(ow.x)); w.y = pk2(acc[vt][2] * rstd * nw[2] * bflo(ow.y), acc[vt][3] * rstd * nw[3] * bfhi(ow.y));
            *(u32x2*)(YA + t * 512 + col) = w;
        }
        __syncthreads();
    }
#undef HO_LOAD
}

__device__ __forceinline__ void hgrn_sample_item(const Args& a, int b, int h, unsigned char* lds) {
    const int tid = threadIdx.x, lane = tid & 63, wid = tid >> 6;
    float* part = (float*)lds;
    float* wsum = (float*)(lds + 32768);
    unsigned char* ws = a.ws;
    const int v4 = (tid & 31) * 4, kg = tid >> 5;
    const float* S0 = a.state_hgrn + ((size_t)(b * 4 + h) * 128 + 8 * kg) * 128 + v4;
    float* S1 = a.out + O_SS + ((size_t)(b * 4 + h) * 128 + 8 * kg) * 128 + v4;
    f32x4 S[8];
#pragma unroll
    for (int e = 0; e < 8; ++e) S[e] = *(const f32x4*)(S0 + e * 128);
    const size_t rb = (size_t)MP + (size_t)b * 4;
#pragma unroll
    for (int t = 0; t < 4; ++t) {
        const size_t off = ((size_t)h * MT + rb + t) * 128;
        const f32x4 g0 = *(const f32x4*)((const float*)(ws + WS_R3) + off + 8 * kg), g1 = *(const f32x4*)((const float*)(ws + WS_R3) + off + 8 * kg + 4);
        const u32x4 kw = *(const u32x4*)((const bf16*)(ws + WS_R2) + off + 8 * kg), qw = *(const u32x4*)((const bf16*)(ws + WS_R1) + off + 8 * kg);
        const u32x2 vw = *(const u32x2*)((const bf16*)(ws + WS_R4) + off + v4);
        const f32x4 vv = {bflo(vw.x), bfhi(vw.x), bflo(vw.y), bfhi(vw.y)};
        const float f[8] = {__expf(g0[0]), __expf(g0[1]), __expf(g0[2]), __expf(g0[3]), __expf(g1[0]), __expf(g1[1]), __expf(g1[2]), __expf(g1[3])};
        const float kk[8] = {bflo(kw.x), bfhi(kw.x), bflo(kw.y), bfhi(kw.y), bflo(kw.z), bfhi(kw.z), bflo(kw.w), bfhi(kw.w)};
        const float qq[8] = {bflo(qw.x), bfhi(qw.x), bflo(qw.y), bfhi(qw.y), bflo(qw.z), bfhi(qw.z), bflo(qw.w), bfhi(qw.w)};
        f32x4 po = {0.f, 0.f, 0.f, 0.f};
#pragma unroll
        for (int e = 0; e < 8; ++e) { S[e] = f[e] * S[e] + kk[e] * vv; po += qq[e] * S[e]; }
        *(f32x4*)(part + (t * 16 + kg) * 128 + v4) = po;
    }
#pragma unroll
    for (int e = 0; e < 8; ++e) *(f32x4*)(S1 + e * 128) = S[e];
    __syncthreads();
    const int t = tid >> 7, v = tid & 127;
    float o = 0.f;
#pragma unroll
    for (int k = 0; k < 16; ++k) o += part[(t * 16 + k) * 128 + v];
    const float s2 = wave_sum(o * o);
    if (lane == 0) wsum[wid] = s2;
    __syncthreads();
    const float rstd = __builtin_amdgcn_rsqf((wsum[2 * t] + wsum[2 * t + 1]) * (1.f / 128.f) + EPS);
    const float y = o * rstd * a.hgrn_norm_w[h * 128 + v] * bf2f(((const bf16*)(ws + WS_R5))[((size_t)h * MT + rb + t) * 128 + v]);
    ((bf16*)(ws + WS_YAS))[((size_t)b * 4 + t) * 512 + h * 128 + v] = (bf16)(pk2(y, 0.f) & 0xffffu);
    __syncthreads();
}


template <int K, int LDW = K> __device__ __forceinline__ f32x4 mini_gemm(const bf16* __restrict__ X, const bf16* __restrict__ W, unsigned char* lds, f32x4 acc) {
    const int tid = threadIdx.x, lane = tid & 63, wid = tid >> 6, i16 = lane & 15, g = lane >> 4, rw = wid & 1, cw = wid >> 1;
    const int sr = tid >> 5, sc = (tid & 31) * 8;
    constexpr int NT = K / 256, P = 264, XB_ = 32 * P * 2, BUF = (32 + 64) * P * 2;
    static_assert(K % 256 == 0, "mini_gemm: K must be a multiple of 256");
    const bf16* xp = X + (size_t)sr * K + sc; const bf16* wp = W + (size_t)sr * LDW + sc;
    u32x4 xr[2], wv[4];
#pragma unroll
    for (int i = 0; i < 2; ++i) xr[i] = *(const u32x4*)(xp + (size_t)(16 * i) * K);
#pragma unroll
    for (int i = 0; i < 4; ++i) wv[i] = *(const u32x4*)(wp + (size_t)(16 * i) * LDW);
    __syncthreads();
#pragma unroll 1
    for (int kt = 0; kt < NT; ++kt) {
        unsigned char* b = lds + (kt & 1) * BUF;
#pragma unroll
        for (int i = 0; i < 2; ++i) *(u32x4*)(b + ((sr + 16 * i) * P + sc) * 2) = xr[i];
#pragma unroll
        for (int i = 0; i < 4; ++i) *(u32x4*)(b + XB_ + ((sr + 16 * i) * P + sc) * 2) = wv[i];
        __syncthreads();
        if (kt + 1 < NT) {
#pragma unroll
            for (int i = 0; i < 2; ++i) xr[i] = *(const u32x4*)(xp + (size_t)(16 * i) * K + 256 * (kt + 1));
#pragma unroll
            for (int i = 0; i < 4; ++i) wv[i] = *(const u32x4*)(wp + (size_t)(16 * i) * LDW + 256 * (kt + 1));
        }
        const bf16* xs = (const bf16*)b + (16 * rw + i16) * P + 8 * g; const bf16* wsm = (const bf16*)(b + XB_) + (16 * cw + i16) * P + 8 * g;
#pragma unroll
        for (int kc = 0; kc < 8; ++kc) acc = MFMA16(*(const bf16x8*)(wsm + 32 * kc), *(const bf16x8*)(xs + 32 * kc), acc);
    }
    return acc;
}
#define SAMPLE_TILE_VARS const int lane = threadIdx.x & 63, wid = threadIdx.x >> 6, i16 = lane & 15, g = lane >> 4; \
    const int row0 = MP + 32 * (tile & 15), colb = 64 * (tile >> 4), row = row0 + 16 * (wid & 1) + i16, col0 = colb + 16 * (wid >> 1); const size_t off = (size_t)row * 1024 + col0 + 4 * g
__device__ __forceinline__ void p5_sample(const Args& a, unsigned char* lds) {
    unsigned char* ws = a.ws;
    for (int tile = blockIdx.x; tile < 256; tile += gridDim.x) {
        SAMPLE_TILE_VARS;
        const f32x4 z = {0.f, 0.f, 0.f, 0.f};
        const f32x4 pa = mini_gemm<512, 1024>((const bf16*)(ws + WS_YAS) + (size_t)(row0 - MP) * 512, (const bf16*)(ws + WS_WOH) + (size_t)colb * 1024, lds, z);
        const f32x4 pb = mini_gemm<512, 1024>((const bf16*)(ws + WS_R10) + (size_t)row0 * 512, (const bf16*)(ws + WS_WOH) + (size_t)colb * 1024 + 512, lds, z);
        const u32x2 ga = *(const u32x2*)((const bf16*)(ws + WS_R8) + off), gb = *(const u32x2*)((const bf16*)(ws + WS_R9) + off);
        u32x2 w; w.x = pk2(bflo(gb.x) * (bflo(ga.x) * pa[0] + pb[0]), bfhi(gb.x) * (bfhi(ga.x) * pa[1] + pb[1])); w.y = pk2(bflo(gb.y) * (bflo(ga.y) * pa[2] + pb[2]), bfhi(gb.y) * (bfhi(ga.y) * pa[3] + pb[3]));
        *(u32x2*)((bf16*)(ws + WS_R3) + off) = w;
    }
    __syncthreads();
}
__device__ __forceinline__ void p6_sample(const Args& a, unsigned char* lds) {
    unsigned char* ws = a.ws;
    for (int tile = blockIdx.x; tile < 256; tile += gridDim.x) {
        SAMPLE_TILE_VARS;
        const f32x4 z = {0.f, 0.f, 0.f, 0.f};
        const f32x4 p = mini_gemm<1024>((const bf16*)(ws + WS_R3) + (size_t)row0 * 1024, (const bf16*)(ws + WS_WOUT) + (size_t)colb * 1024, lds, z);
        const f32x4 v = p + *(const f32x4*)(a.x_sample + off - (size_t)MP * 1024);
        u32x2 w; w.x = pk2(v[0], v[1]); w.y = pk2(v[2], v[3]);
        *(u32x2*)((bf16*)(ws + WS_R8) + off) = w;
        float ss = (v[0] * v[0] + v[1] * v[1]) + (v[2] * v[2] + v[3] * v[3]);
        ss += __shfl_xor(ss, 16); ss += __shfl_xor(ss, 32);
        if (g == 0) atomicAdd((float*)(ws + WS_SUMSQ) + row, ss);
    }
    __syncthreads();
}
__device__ __forceinline__ void p8_sample(const Args& a, unsigned char* lds) {
    unsigned char* ws = a.ws;
    for (int tile = blockIdx.x; tile < 256; tile += gridDim.x) {
        SAMPLE_TILE_VARS;
        const f32x4 z = {0.f, 0.f, 0.f, 0.f};
        const f32x4 p = mini_gemm<DFF>((const bf16*)(ws + WS_R0) + (size_t)row0 * DFF, (const bf16*)(ws + WS_WD) + (size_t)colb * DFF, lds, z);
        const u32x2 xw = *(const u32x2*)((const bf16*)(ws + WS_R8) + off);
        *(f32x4*)(a.out + O_Y + off) = (f32x4){p[0] + bflo(xw.x), p[1] + bfhi(xw.x), p[2] + bflo(xw.y), p[3] + bfhi(xw.y)};
    }
    __syncthreads();
}
#define XB_TMO      128
#define XB_XCNT(j)  (256  + 64 * (j))
#define XB_XSUB(j)  (1280 + 64 * (j))
#define XB_XGEN(j)  (2304 + 64 * (j))
#define XB_TOP      3328
#define XB_TOPGEN   3392
#define XCD_BAR_WORDS 3456
#define XB_SPIN_CAP (1u << 18)

__device__ __forceinline__ unsigned xb_ld(unsigned* p)              { return __hip_atomic_load(p, __ATOMIC_RELAXED, __HIP_MEMORY_SCOPE_AGENT); }
__device__ __forceinline__ unsigned xb_add(unsigned* p, unsigned v) { return __hip_atomic_fetch_add(p, v, __ATOMIC_RELAXED, __HIP_MEMORY_SCOPE_AGENT); }
__device__ __forceinline__ unsigned xb_xcc_id() { return (unsigned)__builtin_amdgcn_s_getreg((3 << 11) | 20) & 0xFu; }
#define XB_SPIN(cond, bar) do { unsigned _sp = 0; while (cond) { __builtin_amdgcn_s_sleep(1); \
    if ((++_sp & 255u) == 0u) { if (xb_ld(&(bar)[XB_TMO])) break; if (_sp > XB_SPIN_CAP) { atomicAdd(&(bar)[XB_TMO], 1u); break; } } } } while (0)

struct XcdBarrier {
    unsigned* bar; unsigned x;
    volatile LAS unsigned* st;
};

__device__ __forceinline__ XcdBarrier xcd_barrier_post(unsigned* bar, volatile LAS unsigned* st) {
    XcdBarrier b; b.bar = bar; b.x = xb_xcc_id(); b.st = st;
    if (threadIdx.x == 0) (void)xb_add(&bar[XB_XCNT(b.x)], 1u);
    return b;
}
__device__ __forceinline__ void xcd_barrier_complete(unsigned* bar, unsigned x, unsigned& nloc, unsigned& nx) {
    const unsigned G = gridDim.x * gridDim.y * gridDim.z;
    unsigned sum, cnt, mine, sp = 0u;
    for (;;) {
        sum = 0u; cnt = 0u; mine = 0u;
#pragma unroll
        for (unsigned j = 0; j < 16; ++j) { const unsigned c = xb_ld(&bar[XB_XCNT(j)]); sum += c; cnt += (c > 0u) ? 1u : 0u; mine = (j == x) ? c : mine; }
        if (sum == G) break;
        __builtin_amdgcn_s_sleep(1);
        if ((++sp & 255u) == 0u) { if (xb_ld(&bar[XB_TMO])) break; if (sp > XB_SPIN_CAP) { atomicAdd(&bar[XB_TMO], 1u); break; } }
    }
    nloc = mine > 0u ? mine : 1u; nx = cnt > 0u ? cnt : 1u;
}

__device__ __forceinline__ void xcd_barrier(const XcdBarrier& b) {
    asm volatile("s_waitcnt vmcnt(0)" ::: "memory");
    __syncthreads();
    if (threadIdx.x == 0) {
        unsigned* bar = b.bar;
        __builtin_amdgcn_s_waitcnt(0);
        unsigned nloc = b.st[0], nx = b.st[1];
        if (nloc == 0u) { xcd_barrier_complete(bar, b.x, nloc, nx); b.st[0] = nloc; b.st[1] = nx; }
        const unsigned old = xb_add(&bar[XB_XSUB(b.x)], 1u);
        const unsigned gen = old / nloc;
        if (old + 1u == (gen + 1u) * nloc) {
            __builtin_amdgcn_fence(__ATOMIC_RELEASE, "agent");
            asm volatile("s_waitcnt vmcnt(0)" ::: "memory");
            const unsigned og = xb_add(&bar[XB_TOP], 1u);
            const unsigned tg = og / nx;
            if (og + 1u == (tg + 1u) * nx) xb_add(&bar[XB_TOPGEN], 1u);
            else XB_SPIN(xb_ld(&bar[XB_TOPGEN]) == tg, bar);
            __builtin_amdgcn_fence(__ATOMIC_ACQUIRE, "agent");
            xb_add(&bar[XB_XGEN(b.x)], 1u);
            asm volatile("s_waitcnt vmcnt(0)" ::: "memory");
        } else {
            XB_SPIN(xb_ld(&bar[XB_XGEN(b.x)]) == gen, bar);
            __builtin_amdgcn_fence(__ATOMIC_ACQUIRE, "agent");
            asm volatile("s_waitcnt vmcnt(0)" ::: "memory");
        }
    }
    __syncthreads();
}


#ifndef PG_ALIGN_BIG
#define PG_ALIGN_BIG true
#endif
#ifndef PG_ALIGN_N1K
#define PG_ALIGN_N1K true
#endif
__global__ void __launch_bounds__(NTHREADS, 2) mk_fwd(Args a) {
    extern __shared__ __attribute__((aligned(16))) unsigned char lds[];
    cg::grid_group grid = cg::this_grid();
    const int lo = a.ph_lo, hi = a.ph_hi, G = gridDim.x, bid = blockIdx.x;
    unsigned char* ws = a.ws;
    LAS unsigned char* ring = (LAS unsigned char*)(LAS void*)lds;
#ifdef PH_MASK
#define IN(k) (((PH_MASK) >> (k)) & 1)
#else
#define IN(k) (lo <= (k) && (k) < hi)
#endif
#ifdef TPROBE_A
#define STAMP(k) do { if (bid == 0 && threadIdx.x == 0) ((volatile unsigned long long*)(lds + 131072 + 64))[k] = __builtin_amdgcn_s_memrealtime(); } while (0)
#else
#define STAMP(k) do { } while (0)
#endif
    if (threadIdx.x < 2) ((volatile LAS unsigned*)(LAS void*)(lds + LDS_BYTES))[threadIdx.x] = 0u;
    __syncthreads();
    XcdBarrier xbar = xcd_barrier_post((unsigned*)(ws + WS_BAR), (volatile LAS unsigned*)(LAS void*)(lds + LDS_BYTES));
#define SEAM(k) do { if (IN(k) && IN((k) + 1)) { if (hi > 1000) grid.sync(); else xcd_barrier(xbar); } STAMP((k) + 1); } while (0)
    STAMP(0);

    constexpr int P1_NWG = (MT / 256) * (PW / 256);
    const int p1_rem = P1_NWG % G;
    if (IN(0)) { p0_prologue(a, lds, (p1_rem != 0 && IN(1)) ? P0_I1 : P0_NITEMS); }
    SEAM(0);
    if (IN(1)) {
        pg8::Gemm g{(const bf16*)(ws + WS_R0), (const bf16*)(ws + WS_W1T), MT, PW, 1024}; pg8::StaticOrder S; S.init(MT, PW, G, bid);
        pg8::EpiProj E{(bf16*)(ws + WS_R1), (bf16*)(ws + WS_R2), (bf16*)(ws + WS_R4), (bf16*)(ws + WS_R5), (bf16*)(ws + WS_R6), (bf16*)(ws + WS_R7), (bf16*)(ws + WS_R8), (bf16*)(ws + WS_R9),
                       (float*)(ws + WS_R3), (const float*)(ws + WS_LBV)};
        pg8::gemm_phase<pg8::EpiProj, pg8::StaticOrder, PG_ALIGN_BIG, true>(ring, g, S, E);
        if (p1_rem != 0 && IN(0) && bid >= p1_rem) p0_weights(a, lds, P0_I1, P0_NITEMS, (bid - p1_rem) * 8 + (int)(threadIdx.x >> 6), (G - p1_rem) * 8);
    }
    SEAM(1);
    if (IN(2)) { hgrn_local_phase(a, lds); }
    SEAM(2);
    if (IN(3)) {
        constexpr int N_ATT = 4 * 64 * 2, N_SAT = DEC_B;
        const int ns = (G >= 128) ? 64 : 0;
        if (G == 256) {
            if (bid < ns) {
                hgrn_scan(a, bid, ns, lds); STAMP(10);
                __syncthreads();
                { const int r = 448 + bid; attn_prompt_item(a, r >> 7, (r >> 1) & 63, r & 1, lds); }
                for (int r = 320 + 3 * bid; r < 320 + 3 * bid + 3; ++r) hgrn_sample_item(a, r >> 2, r & 3, lds);
            } else {
                const int j = bid - ns;
                if (j < 128) { attn_sample_item(a, j, lds);
                    for (int r = 2 * j; r < 2 * j + 2; ++r) attn_prompt_item(a, r >> 7, (r >> 1) & 63, r & 1, lds);
                    for (int r = 2 * j; r < 2 * j + 2; ++r) hgrn_sample_item(a, r >> 2, r & 3, lds); }
                else { for (int r = 256 + 3 * (j - 128); r < 256 + 3 * (j - 128) + 3; ++r) attn_prompt_item(a, r >> 7, (r >> 1) & 63, r & 1, lds);
                    { const int r = 256 + (j - 128); hgrn_sample_item(a, r >> 2, r & 3, lds); } }
            }
        } else {
            if (ns == 0) hgrn_scan(a, bid, G, lds); else if (bid < ns) hgrn_scan(a, bid, ns, lds);
            __syncthreads();
            if (bid >= ns) {
                for (int it = bid - ns; it < N_ATT + N_SAT; it += G - ns) {
                    if (it < N_ATT) attn_prompt_item(a, it >> 7, (it >> 1) & 63, it & 1, lds);
                    else attn_sample_item(a, it - N_ATT, lds);
                }
                for (int r = bid - ns; r < DEC_B * 4; r += G - ns) hgrn_sample_item(a, r >> 2, r & 3, lds);
            }
        }
    }
    SEAM(3);
    if (IN(4)) {
        hgrn_out_phase(a, lds);
    }
    SEAM(4);
    if (IN(5)) {
        p5_sample(a, lds);
        pg8::StaticOrder S; S.init(MP, 1024, G, bid);
        pg8::Gemm g{(const bf16*)(ws + WS_R6), (const bf16*)(ws + WS_WOH), MP, 1024, 1024, (const bf16*)(ws + WS_R10), 512, 8};
        pg8::EpiMerge E{(const bf16*)(ws + WS_R8), (const bf16*)(ws + WS_R9), (bf16*)(ws + WS_R3)};
        pg8::gemm_phase<pg8::EpiMerge, pg8::StaticOrder, PG_ALIGN_N1K, true, true>(ring, g, S, E);
    }
    SEAM(5);
    if (IN(6)) {
        p6_sample(a, lds);
        pg8::Gemm g{(const bf16*)(ws + WS_R3), (const bf16*)(ws + WS_WOUT), MP, 1024, 1024}; pg8::StaticOrder S; S.init(MP, 1024, G, bid);
        pg8::EpiRes1 E{a.x_prompt, (bf16*)(ws + WS_R8), (float*)(ws + WS_SUMSQ)};
        pg8::gemm_phase<pg8::EpiRes1, pg8::StaticOrder, PG_ALIGN_N1K, true>(ring, g, S, E);
    }
    SEAM(6);
    if (IN(7)) {
        pg8::Gemm g{(const bf16*)(ws + WS_R8), (const bf16*)(ws + WS_WGU), MT, 2 * DFF, 1024}; pg8::StaticOrder S; S.init(MT, 2 * DFF, G, bid);
        pg8::EpiFfn E{(const float*)(ws + WS_SUMSQ), (bf16*)(ws + WS_R0)};
        pg8::gemm_phase<pg8::EpiFfn, pg8::StaticOrder, PG_ALIGN_BIG, true>(ring, g, S, E);
    }
    SEAM(7);
    if (IN(8)) {
        p8_sample(a, lds);
        pg8::Gemm g{(const bf16*)(ws + WS_R0), (const bf16*)(ws + WS_WD), MP, 1024, DFF}; pg8::StaticOrder S; S.init(MP, 1024, G, bid);
        pg8::EpiRes2 E{(const bf16*)(ws + WS_R8), a.out + O_Y};
        pg8::gemm_phase<pg8::EpiRes2, pg8::StaticOrder, PG_ALIGN_N1K, true>(ring, g, S, E);
    }
#ifdef TPROBE_A
    {
        grid.sync(); STAMP(9);
        unsigned long long* pw = (unsigned long long*)(ws + WS_MISC + 2048);
        if (bid == 0 && threadIdx.x == 0) { volatile unsigned long long* t = (volatile unsigned long long*)(lds + 131072 + 64);
            pw[0] = (TPROBE_A >= 0) ? t[TPROBE_A + 1] - t[TPROBE_A] : 0ull; pw[1] = (TPROBE_B == 10) ? t[10] - t[3] : t[TPROBE_B + 1] - t[TPROBE_B]; __threadfence(); }
        grid.sync();
        const unsigned long long dA = __hip_atomic_load(pw, __ATOMIC_RELAXED, __HIP_MEMORY_SCOPE_AGENT), dB = __hip_atomic_load(pw + 1, __ATOMIC_RELAXED, __HIP_MEMORY_SCOPE_AGENT);
        const float eps = sqrtf(2e-5f + (float)dB * 0.01f * (float)(TPROBE_KB));
        f32x4* cvs = (f32x4*)(a.out + O_VS);
        for (int i = bid * NTHREADS + threadIdx.x; i < 128 * 128 * 128 / 4; i += G * NTHREADS) cvs[i] = cvs[i] * (1.f + eps);
        const unsigned long long t0 = __builtin_amdgcn_s_memrealtime();
        while (__builtin_amdgcn_s_memrealtime() - t0 < 4ull * dA) __builtin_amdgcn_s_sleep(8);
    }
#endif
#undef IN
#undef SEAM
}

__global__ void dump_ws(const unsigned short* w, float* o, size_t n, size_t tot) {
    for (size_t i = blockIdx.x * (size_t)blockDim.x + threadIdx.x; i < n; i += (size_t)gridDim.x * blockDim.x) { unsigned s = 0; for (size_t j = i; j < tot; j += n) s += w[j]; o[i] = (float)s; }
}
constexpr int N_PHASES = 9;
extern "C" void kernel_launch(void* const* d_in, const int* in_sizes, int n_in, void* d_out, int out_size, void* d_ws, size_t ws_size, hipStream_t stream) {
    static int grid = 0;
    if (grid == 0) {
        if (n_in != 19 || (size_t)out_size != O_END || ws_size < WS_END) { fprintf(stderr, "kernel_launch: unexpected shapes: n_in %d out %d ws %zu (need %zu)\n", n_in, out_size, ws_size, (size_t)WS_END); grid = -1; return; }
        int dev = 0, cus = 0, per_cu = 0;
        if (hipGetDevice(&dev) != hipSuccess || hipDeviceGetAttribute(&cus, hipDeviceAttributeMultiprocessorCount, dev) != hipSuccess) { grid = -1; return; }
        if (hipFuncSetAttribute((const void*)mk_fwd, hipFuncAttributeMaxDynamicSharedMemorySize, LDS_TOTAL) != hipSuccess) { fprintf(stderr, "kernel_launch: hipFuncSetAttribute failed\n"); grid = -1; return; }
        if (hipOccupancyMaxActiveBlocksPerMultiprocessor(&per_cu, (const void*)mk_fwd, NTHREADS, LDS_TOTAL) != hipSuccess || per_cu < 1) { fprintf(stderr, "kernel_launch: occupancy query says %d\n", per_cu); (void)hipGetLastError(); grid = -1; return; }
        grid = cus;
    }
    if (grid < 0) return;
    Args a{};
    const float** ap = (const float**)&a;
    for (int i = 0; i < 19; ++i) ap[i] = (const float*)d_in[i];
    a.out = (float*)d_out; a.ws = (unsigned char*)d_ws;
#if MK_N_LAUNCHES == 1
    if (hipMemsetAsync((char*)d_ws + WS_BAR, 0, XCD_BAR_WORDS * 4, stream) != hipSuccess) { fprintf(stderr, "kernel_launch: memset of the barrier words failed\n"); return; }
    a.ph_lo = 0; a.ph_hi = N_PHASES;
    void* args[] = {&a};
    hipError_t e = hipLaunchCooperativeKernel((const void*)mk_fwd, dim3(grid), dim3(NTHREADS), args, LDS_TOTAL, stream);
    if (e != hipSuccess) fprintf(stderr, "kernel_launch: cooperative launch failed: %s (grid %d)\n", hipGetErrorString(e), grid);
#else
#ifndef PROBE_K
#define PROBE_K 8
#endif
    for (int ph = 0; ph <= PROBE_K; ++ph) {
        a.ph_lo = ph; a.ph_hi = ph + 1;
        hipLaunchKernelGGL(mk_fwd, dim3(grid), dim3(NTHREADS), LDS_TOTAL, stream, a);
    }
#if PROBE_K < 8
    hipLaunchKernelGGL(dump_ws, dim3(2048), dim3(256), 0, stream, (const unsigned short*)d_ws, (float*)d_out, (size_t)out_size, (size_t)(WS_END / 2));
#endif
#endif
}
```

```cpp
#include <hip/hip_runtime.h>
#include <hip/hip_cooperative_groups.h>
#include <cstdio>
#include <cstdint>
namespace cg = cooperative_groups;

#ifndef MK_N_LAUNCHES
#define MK_N_LAUNCHES 1
#endif

constexpr int DM = 1024, SEQ = 8192, NBATCH = 4, MP = NBATCH * SEQ, DEC_B = 128, DEC_T = 4, MS = DEC_B * DEC_T, MT = MP + MS;
constexpr int PW = 4864, DFF = 2816;
constexpr float EPS = 1e-6f;

constexpr size_t UB = (size_t)MT * 512 * 2;
constexpr size_t WS_W1T = 0;
constexpr size_t WS_WOH = WS_W1T + (size_t)PW * DM * 2;
constexpr size_t WS_WOA = WS_WOH + (size_t)1024 * 512 * 2;
constexpr size_t WS_WOUT = WS_WOA + (size_t)1024 * 512 * 2;
constexpr size_t WS_WGU = WS_WOUT + (size_t)1024 * 1024 * 2;
constexpr size_t WS_WD = WS_WGU + (size_t)2 * DFF * DM * 2;
constexpr size_t WS_MISC = WS_WD + (size_t)DM * DFF * 2;
constexpr size_t WS_LBV = WS_MISC;
constexpr size_t WS_SUMSQ = WS_MISC + 4096;
constexpr size_t WS_DT = WS_MISC + 512 * 1024;
constexpr size_t WS_BAR = WS_MISC + 1536 * 1024;
constexpr size_t WS_R0 = (size_t)32 << 20;
constexpr size_t WS_R1 = WS_R0 + 2 * UB;
constexpr size_t WS_R2 = WS_R1 + UB;
constexpr size_t WS_R3 = WS_R2 + UB;
constexpr size_t WS_R4 = WS_R3 + 2 * UB;
constexpr size_t WS_R5 = WS_R4 + UB;
constexpr size_t WS_R6 = WS_R5 + UB;
constexpr size_t WS_R7 = WS_R6 + UB;
constexpr size_t WS_R8 = WS_R7 + UB / 2;
constexpr size_t WS_R9 = WS_R8 + 2 * UB;
constexpr size_t WS_R10 = WS_R9 + 2 * UB;
constexpr size_t WS_YAS = WS_R10 + UB;
constexpr size_t WS_END = WS_YAS + (size_t)MS * 512 * 2;
static_assert(WS_MISC == ((size_t)30 << 20) && WS_END <= ((size_t)512 << 20), "d_ws map");
static_assert((size_t)MT * DFF * 2 <= 6 * UB, "ACT fits R0..R3");

constexpr size_t O_Y = 0;
constexpr size_t O_SP = (size_t)MT * DM;
constexpr size_t O_KP = O_SP + (size_t)4 * 4 * 128 * 128;
constexpr size_t O_VP = O_KP + (size_t)4 * 128 * 128;
constexpr size_t O_SS = O_VP + (size_t)4 * 128 * 128;
constexpr size_t O_KS = O_SS + (size_t)128 * 4 * 128 * 128;
constexpr size_t O_VS = O_KS + (size_t)128 * 128 * 128;
constexpr size_t O_END = O_VS + (size_t)128 * 128 * 128;

constexpr int LDS_BYTES = 131072;
constexpr int LDS_TOTAL = LDS_BYTES + 256;
constexpr int NTHREADS = 512;

#define LAS __attribute__((address_space(3)))
typedef unsigned short bf16;
typedef float f32x4 __attribute__((ext_vector_type(4)));
typedef float f32x2 __attribute__((ext_vector_type(2)));
typedef unsigned u32x4 __attribute__((ext_vector_type(4)));
typedef unsigned u32x2 __attribute__((ext_vector_type(2)));
typedef short bf16x8 __attribute__((ext_vector_type(8)));
typedef short s16x4 __attribute__((ext_vector_type(4)));

__device__ __forceinline__ float bf2f(unsigned short u) { return __uint_as_float((unsigned)u << 16); }
__device__ __forceinline__ float bflo(unsigned w) { return __uint_as_float(w << 16); }
__device__ __forceinline__ float bfhi(unsigned w) { return __uint_as_float(w & 0xffff0000u); }
typedef __bf16 bf16x2_t __attribute__((ext_vector_type(2)));
__device__ __forceinline__ unsigned pk2(float lo, float hi) { f32x2 v = {lo, hi}; bf16x2_t b = __builtin_convertvector(v, bf16x2_t); return __builtin_bit_cast(unsigned, b); }
__device__ __forceinline__ float sigm(float x) { return __builtin_amdgcn_rcpf(1.f + __expf(-x)); }
__device__ __forceinline__ s16x4 tr_read(const bf16* p) {
    return __builtin_bit_cast(s16x4, __builtin_amdgcn_ds_read_tr16_b64_v4i16((LAS s16x4*)(LAS void*)p));
}
__device__ __forceinline__ bf16x8 cat8(s16x4 a, s16x4 b) { return (bf16x8){a[0], a[1], a[2], a[3], b[0], b[1], b[2], b[3]}; }
__device__ __forceinline__ bf16x8 pk8(f32x4 a, f32x4 b) { u32x4 w; w.x = pk2(a[0], a[1]); w.y = pk2(a[2], a[3]); w.z = pk2(b[0], b[1]); w.w = pk2(b[2], b[3]); return __builtin_bit_cast(bf16x8, w); }
#define MFMA16(a, b, c) __builtin_amdgcn_mfma_f32_16x16x32_bf16((a), (b), (c), 0, 0, 0)

namespace pg8 {
#define PG8_LAS __attribute__((address_space(3)))
typedef unsigned short bf16_t;
typedef short bf16x8 __attribute__((ext_vector_type(8)));
typedef float f32x4 __attribute__((ext_vector_type(4)));
typedef unsigned u32x4 __attribute__((ext_vector_type(4)));
constexpr int BM = 256, BK = 64, HALF = 128, HTB = HALF * BK * 2  , STAGE_BYTES = 8 * HTB, NXCD = 8, WGM = 8;

__host__ __device__ __forceinline__ int lds_byte(int r, int c) { const int st = (r >> 4) * 2 + (c >> 5), rr = r & 15, cc = c & 31, ob = rr * 64 + cc * 2; return st * 1024 + (ob ^ (((ob >> 9) & 1) << 5)); }
__host__ __device__ __forceinline__ void stage_rc(int b, int& R, int& C) { const int st = b / 1024, sb = b % 1024, swz = sb ^ (((sb >> 9) & 1) << 5); R = (st >> 1) * 16 + swz / 64; C = (st & 1) * 32 + (swz % 64) / 2; }
__host__ __device__ __forceinline__ int perm32(int rho) { const int n = rho >> 4, i = rho & 15; return 8 * (i >> 2) + 4 * n + (i & 3); }

struct Unit { int pm, pn; };
struct Gemm { const bf16_t* A; const bf16_t* Bt; int M, N, K; const bf16_t* A2; int lda, kmid; };

struct StaticOrder {
    int nM, nN, nwg, G, c;
    __host__ __device__ void init(int M, int N, int G_, int c_) { nM = M / BM; nN = N / BM; nwg = nM * nN; G = G_; c = c_; }
    __host__ __device__ bool next(int i, Unit& u) const {
        const long L = (long)i * G + c; if (L >= nwg) return false;
        int wgid = (int)L; { const int q = nwg / NXCD, r = nwg % NXCD, xcd = wgid % NXCD, off = wgid / NXCD; wgid = (xcd < r ? xcd * (q + 1) : r * (q + 1) + (xcd - r) * q) + off; }
        const int nig = WGM * nN, gid = wgid / nig, fm = gid * WGM, gsz = (nM - fm) < WGM ? (nM - fm) : WGM;
        u.pm = fm + ((wgid % nig) % gsz); u.pn = (wgid % nig) / gsz; return true;
    }
    __device__ __forceinline__ void a_ready(const Unit&) const {}
    __device__ __forceinline__ void done(const Unit&) const {}
};

__device__ __forceinline__ unsigned cvt_pk_bf16(float lo, float hi) { unsigned r; asm volatile("v_cvt_pk_bf16_f32 %0, %1, %2" : "=v"(r) : "v"(lo), "v"(hi)); return r; }

__device__ __forceinline__ f32x4 vexp2(f32x4 t) { f32x4 r; r[0] = __builtin_amdgcn_exp2f(t[0]); r[1] = __builtin_amdgcn_exp2f(t[1]); r[2] = __builtin_amdgcn_exp2f(t[2]); r[3] = __builtin_amdgcn_exp2f(t[3]); return r; }
__device__ __forceinline__ f32x4 vrcp(f32x4 t) { f32x4 r; r[0] = __builtin_amdgcn_rcpf(t[0]); r[1] = __builtin_amdgcn_rcpf(t[1]); r[2] = __builtin_amdgcn_rcpf(t[2]); r[3] = __builtin_amdgcn_rcpf(t[3]); return r; }
__device__ __forceinline__ f32x4 vlog2(f32x4 t) { f32x4 r; r[0] = __builtin_amdgcn_logf(t[0]); r[1] = __builtin_amdgcn_logf(t[1]); r[2] = __builtin_amdgcn_logf(t[2]); r[3] = __builtin_amdgcn_logf(t[3]); return r; }
__device__ __forceinline__ f32x4 vsig(f32x4 v) { return vrcp(vexp2(v * -1.4426950408889634f) + 1.f); }
struct EpiProj {
    static constexpr bool PERM = true, AFTER_DRAIN = false; static constexpr size_t MTR = 33280;
    bf16_t *QH, *KH, *VH, *OG, *QA, *KV, *GA, *GB; float* GH; const float* lbv;
    __device__ __forceinline__ void operator()(const f32x4 (&acc)[2][2][4][2], const Unit& u, int wr, int wc, int fr, int fq) const {
        const int pn = u.pn; int mode, ld, cb; bf16_t* dst; float sc = 1.f; bool hm = false;
        if (pn < 2)        { mode = 1; dst = QH; ld = 512;  cb = pn * 256; sc = 0.08838834764831845f; hm = true; }
        else if (pn < 4)   { mode = 3; dst = KH; ld = 512;  cb = (pn - 2) * 256; hm = true; }
        else if (pn < 6)   { mode = 0; dst = VH; ld = 512;  cb = (pn - 4) * 256; hm = true; }
        else if (pn < 8)   { mode = 1; dst = OG; ld = 512;  cb = (pn - 6) * 256; hm = true; }
        else if (pn < 10)  { mode = 0; dst = QA; ld = 512;  cb = (pn - 8) * 256; }
        else if (pn == 10) { mode = 0; dst = KV; ld = 256;  cb = 0; }
        else               { mode = 4; dst = GA; ld = 1024; cb = (pn - 11) * 128; }
        const int row0 = u.pm * BM + wr * 64 + fr, col0 = cb + wc * 32 + 8 * fq;
        if (mode == 4) {
#pragma unroll
            for (int ai = 0; ai < 2; ++ai)
#pragma unroll
                for (int m = 0; m < 4; ++m) {
                    const size_t off = (size_t)(row0 + ai * HALF + m * 16) * 1024 + col0;
                    const f32x4 A0 = vexp2(acc[ai][0][m][0] * -1.4426950408889634f) + 1.f, A1 = vexp2(acc[ai][0][m][1] * -1.4426950408889634f) + 1.f;
                    const f32x4 B0 = vexp2(acc[ai][1][m][0] * -1.4426950408889634f) + 1.f, B1 = vexp2(acc[ai][1][m][1] * -1.4426950408889634f) + 1.f;
                    const f32x4 s0 = vrcp(B0), s1 = vrcp(B1), r0 = B0 * vrcp(A0), r1 = B1 * vrcp(A1);
                    u32x4 w; w.x = pk2(r0[0], r0[1]); w.y = pk2(r0[2], r0[3]); w.z = pk2(r1[0], r1[1]); w.w = pk2(r1[2], r1[3]);
                    *(u32x4*)(GA + off) = w;
                    w.x = pk2(s0[0], s0[1]); w.y = pk2(s0[2], s0[3]); w.z = pk2(s1[0], s1[1]); w.w = pk2(s1[2], s1[3]);
                    *(u32x4*)(GB + off) = w;
                }
            return;
        }
#pragma unroll
        for (int bj = 0; bj < 2; ++bj) {
            const int col = col0 + bj * HALF;
            f32x4 l0 = {0.f, 0.f, 0.f, 0.f}, l1 = l0;
            if (mode == 3) { l0 = *(const f32x4*)(lbv + col); l1 = *(const f32x4*)(lbv + col + 4); }
#pragma unroll
            for (int ai = 0; ai < 2; ++ai)
#pragma unroll
                for (int m = 0; m < 4; ++m) {
                    const size_t row = (size_t)(row0 + ai * HALF + m * 16);
                    f32x4 v0 = acc[ai][bj][m][0], v1 = acc[ai][bj][m][1];
                    if (mode == 1) {
                        v0 = (v0 * sc) * vsig(v0); v1 = (v1 * sc) * vsig(v1);
                    } else if (mode == 3) {
                        const f32x4 f0 = l0 + (1.f - l0) * vsig(v0), f1 = l1 + (1.f - l1) * vsig(v1);
                        const f32x4 g0 = vlog2(f0) * 0.6931471805599453f, g1 = vlog2(f1) * 0.6931471805599453f;
                        v0 = 1.f - f0; v1 = 1.f - f1;
                        float* gp = GH + ((size_t)(col >> 7) * MTR + row) * 128 + (col & 127); *(f32x4*)gp = g0; *(f32x4*)(gp + 4) = g1;
                    }
                    u32x4 w; w.x = pk2(v0[0], v0[1]); w.y = pk2(v0[2], v0[3]); w.z = pk2(v1[0], v1[1]); w.w = pk2(v1[2], v1[3]);
                    *(u32x4*)(dst + (hm ? ((size_t)(col >> 7) * MTR + row) * 128 + (col & 127) : row * ld + col)) = w;
                }
        }
    }
};
template <bool ADD> struct EpiGate {
    static constexpr bool PERM = true, AFTER_DRAIN = false;
    const bf16_t* gate; const bf16_t* T; bf16_t* O;
    __device__ __forceinline__ void operator()(const f32x4 (&acc)[2][2][4][2], const Unit& u, int wr, int wc, int fr, int fq) const {
        const int row0 = u.pm * BM + wr * 64 + fr, col0 = u.pn * BM + wc * 32 + 8 * fq;
#pragma unroll
        for (int ai = 0; ai < 2; ++ai)
#pragma unroll
            for (int m = 0; m < 4; ++m)
#pragma unroll
                for (int bj = 0; bj < 2; ++bj) {
                    const size_t off = (size_t)(row0 + ai * HALF + m * 16) * 1024 + col0 + bj * HALF;
                    const u32x4 gw = *(const u32x4*)(gate + off);
                    f32x4 v0 = acc[ai][bj][m][0], v1 = acc[ai][bj][m][1];
                    v0[0] *= bflo(gw.x); v0[1] *= bfhi(gw.x); v0[2] *= bflo(gw.y); v0[3] *= bfhi(gw.y);
                    v1[0] *= bflo(gw.z); v1[1] *= bfhi(gw.z); v1[2] *= bflo(gw.w); v1[3] *= bfhi(gw.w);
                    if (ADD) { const u32x4 tw = *(const u32x4*)(T + off);
                        v0[0] += bflo(tw.x); v0[1] += bfhi(tw.x); v0[2] += bflo(tw.y); v0[3] += bfhi(tw.y);
                        v1[0] += bflo(tw.z); v1[1] += bfhi(tw.z); v1[2] += bflo(tw.w); v1[3] += bfhi(tw.w); }
                    u32x4 w; w.x = pk2(v0[0], v0[1]); w.y = pk2(v0[2], v0[3]); w.z = pk2(v1[0], v1[1]); w.w = pk2(v1[2], v1[3]);
                    *(u32x4*)(O + off) = w;
                }
    }
};
struct EpiMerge {
    static constexpr bool PERM = true, AFTER_DRAIN = false;
    const bf16_t* GA; const bf16_t* GB; bf16_t* O;
    __device__ __forceinline__ void mid(f32x4 (&acc)[2][2][4][2], const Unit& u, int wr, int wc, int fr, int fq) const {
        int lane_ = (int)(threadIdx.x & 63); asm volatile("" : "+v"(lane_));
        const int row0 = u.pm * BM + wr * 64 + (lane_ & 15), col0 = u.pn * BM + wc * 32 + 8 * (lane_ >> 4);
#pragma unroll
        for (int ai = 0; ai < 2; ++ai)
#pragma unroll
            for (int m = 0; m < 4; ++m)
#pragma unroll
                for (int bj = 0; bj < 2; ++bj) {
                    const u32x4 a = *(const u32x4*)(GA + (size_t)(row0 + ai * HALF + m * 16) * 1024 + col0 + bj * HALF);
                    acc[ai][bj][m][0] = acc[ai][bj][m][0] * (f32x4){bflo(a.x), bfhi(a.x), bflo(a.y), bfhi(a.y)};
                    acc[ai][bj][m][1] = acc[ai][bj][m][1] * (f32x4){bflo(a.z), bfhi(a.z), bflo(a.w), bfhi(a.w)};
                    if (m == 3 && bj == 1) __builtin_amdgcn_sched_barrier(0);
                }
    }
    __device__ __forceinline__ void operator()(const f32x4 (&acc)[2][2][4][2], const Unit& u, int wr, int wc, int fr, int fq) const {
        const int row0 = u.pm * BM + wr * 64 + fr, col0 = u.pn * BM + wc * 32 + 8 * fq;
#pragma unroll
        for (int ai = 0; ai < 2; ++ai)
#pragma unroll
            for (int m = 0; m < 4; ++m)
#pragma unroll
                for (int bj = 0; bj < 2; ++bj) {
                    const size_t off = (size_t)(row0 + ai * HALF + m * 16) * 1024 + col0 + bj * HALF;
                    const u32x4 gw = *(const u32x4*)(GB + off);
                    const f32x4 v0 = acc[ai][bj][m][0], v1 = acc[ai][bj][m][1];
                    u32x4 w; w.x = pk2(v0[0] * bflo(gw.x), v0[1] * bfhi(gw.x)); w.y = pk2(v0[2] * bflo(gw.y), v0[3] * bfhi(gw.y));
                    w.z = pk2(v1[0] * bflo(gw.z), v1[1] * bfhi(gw.z)); w.w = pk2(v1[2] * bflo(gw.w), v1[3] * bfhi(gw.w));
                    *(u32x4*)(O + off) = w;
                }
    }
};
struct EpiRes1 {
    static constexpr bool PERM = true, AFTER_DRAIN = false;
    const float* xp; bf16_t* X1B; float* sumsq;
    __device__ __forceinline__ void operator()(const f32x4 (&acc)[2][2][4][2], const Unit& u, int wr, int wc, int fr, int fq) const {
        const int row0 = u.pm * BM + wr * 64 + fr, col0 = u.pn * BM + wc * 32 + 8 * fq;
#pragma unroll
        for (int ai = 0; ai < 2; ++ai)
#pragma unroll
            for (int m = 0; m < 4; ++m) {
                const int row = row0 + ai * HALF + m * 16; float ss = 0.f;
#pragma unroll
                for (int bj = 0; bj < 2; ++bj) {
                    const size_t off = (size_t)row * 1024 + col0 + bj * HALF;
                    const f32x4 v0 = acc[ai][bj][m][0] + *(const f32x4*)(xp + off), v1 = acc[ai][bj][m][1] + *(const f32x4*)(xp + off + 4);
                    ss += (v0[0] * v0[0] + v0[1] * v0[1]) + (v0[2] * v0[2] + v0[3] * v0[3]) + (v1[0] * v1[0] + v1[1] * v1[1]) + (v1[2] * v1[2] + v1[3] * v1[3]);
                    u32x4 w; w.x = pk2(v0[0], v0[1]); w.y = pk2(v0[2], v0[3]); w.z = pk2(v1[0], v1[1]); w.w = pk2(v1[2], v1[3]);
                    *(u32x4*)(X1B + off) = w;
                }
                ss += __shfl_xor(ss, 16); ss += __shfl_xor(ss, 32);
                if (fq == 0) atomicAdd(sumsq + row, ss);
            }
    }
};
struct EpiFfn {
    static constexpr bool PERM = true, AFTER_DRAIN = false;
    const float* sumsq; bf16_t* ACT;
    __device__ __forceinline__ void operator()(const f32x4 (&acc)[2][2][4][2], const Unit& u, int wr, int wc, int fr, int fq) const {
        const int row0 = u.pm * BM + wr * 64 + fr, col0 = u.pn * HALF + wc * 32 + 8 * fq;
        float sq[2][4];
#pragma unroll
        for (int ai = 0; ai < 2; ++ai)
#pragma unroll
            for (int m = 0; m < 4; ++m) sq[ai][m] = sumsq[row0 + ai * HALF + m * 16];
#pragma unroll
        for (int ai = 0; ai < 2; ++ai)
#pragma unroll
            for (int m = 0; m < 4; ++m) {
                const int row = row0 + ai * HALF + m * 16;
                const float r = __builtin_amdgcn_rsqf(sq[ai][m] * (1.f / 1024.f) + 1e-6f);
                const float nrl = r * -1.4426950408889634f, r2 = r * r;
                f32x4 o[2];
#pragma unroll
                for (int n = 0; n < 2; ++n) {
                    const f32x4 g = acc[ai][0][m][n], uu = acc[ai][1][m][n];
                    const f32x4 t = g * nrl;
                    f32x4 ex; ex[0] = __builtin_amdgcn_exp2f(t[0]); ex[1] = __builtin_amdgcn_exp2f(t[1]); ex[2] = __builtin_amdgcn_exp2f(t[2]); ex[3] = __builtin_amdgcn_exp2f(t[3]);
                    const f32x4 d = ex + 1.f;
                    f32x4 s; s[0] = __builtin_amdgcn_rcpf(d[0]); s[1] = __builtin_amdgcn_rcpf(d[1]); s[2] = __builtin_amdgcn_rcpf(d[2]); s[3] = __builtin_amdgcn_rcpf(d[3]);
                    o[n] = (g * uu) * (s * r2);
                }
                u32x4 w; w.x = pk2(o[0][0], o[0][1]); w.y = pk2(o[0][2], o[0][3]); w.z = pk2(o[1][0], o[1][1]); w.w = pk2(o[1][2], o[1][3]);
                *(u32x4*)(ACT + (size_t)row * 2816 + col0) = w;
            }
    }
};
struct EpiRes2 {
    static constexpr bool PERM = true, AFTER_DRAIN = false;
    const bf16_t* X1B; float* out;
    __device__ __forceinline__ void operator()(const f32x4 (&acc)[2][2][4][2], const Unit& u, int wr, int wc, int fr, int fq) const {
        const int row0 = u.pm * BM + wr * 64 + fr, col0 = u.pn * BM + wc * 32 + 8 * fq;
#pragma unroll
        for (int ai = 0; ai < 2; ++ai)
#pragma unroll
            for (int m = 0; m < 4; ++m)
#pragma unroll
                for (int bj = 0; bj < 2; ++bj) {
                    const size_t off = (size_t)(row0 + ai * HALF + m * 16) * 1024 + col0 + bj * HALF;
                    const u32x4 xw = *(const u32x4*)(X1B + off);
                    const f32x4 v0 = acc[ai][bj][m][0] + (f32x4){bflo(xw.x), bfhi(xw.x), bflo(xw.y), bfhi(xw.y)}, v1 = acc[ai][bj][m][1] + (f32x4){bflo(xw.z), bfhi(xw.z), bflo(xw.w), bfhi(xw.w)};
                    *(f32x4*)(out + off) = v0; *(f32x4*)(out + off + 4) = v1;
                }
    }
};
template <class Epi, class Sched, bool ALIGN_EPI = false, bool SP2 = false, bool MID = false>
__device__ __forceinline__ void gemm_phase(PG8_LAS unsigned char* lds, const Gemm g, const Sched& S, const Epi& E) {
    const int tid = threadIdx.x, wid = __builtin_amdgcn_readfirstlane(tid >> 6), lane = tid & 63, wr = wid >> 2, wc = wid & 3, fr = lane & 15, fq = lane >> 4;
    const int K = g.K, nt = K / BK;
    const int lda = g.lda ? g.lda : K, kmid = g.kmid ? g.kmid : nt;
    unsigned voffA[2], voffB[2];
#pragma unroll
    for (int i = 0; i < 2; ++i) { int R, C; stage_rc(tid * 16 + i * 8192, R, C); const int Rb = Epi::PERM ? ((R & ~31) + perm32(R & 31)) : R;
        voffA[i] = (unsigned)(R * lda + C) * 2u; voffB[i] = (unsigned)(Rb * K + C) * 2u; }
    const size_t kstep = (size_t)(BK * 2);
    const size_t hstepA = (size_t)HALF * lda * 2, hstepB = (size_t)HALF * K * 2;
    const size_t tstepA = 2 * hstepA, tstepB = 2 * hstepB;
    const long dA2 = g.A2 ? ((const char*)g.A2 - (const char*)g.A) - (long)kmid * (long)kstep : 0l;
    const unsigned ldsw = (unsigned)wid * 1024u;
    const int aoff = lds_byte(wr * 64 + fr, fq * 8), boff = lds_byte(wc * 32 + fr, fq * 8);
#define PG8_SA(b, h) (((b) * 2 + (h)) * HTB)
#define PG8_SB(b, h) ((4 + (b) * 2 + (h)) * HTB)
#define PG8_STAGE(bufoff, gbase, voff) do { _Pragma("unroll") for (int _i = 0; _i < 2; ++_i) \
        __builtin_amdgcn_global_load_lds((const unsigned*)((const char*)(gbase) + (voff)[_i]), (PG8_LAS unsigned*)(lds + (bufoff) + ldsw + _i * 8192), 16, 0, 0); } while (0)
#define PG8_LDA(dst, b, h) do { _Pragma("unroll") for (int m = 0; m < 4; ++m) _Pragma("unroll") for (int k = 0; k < 2; ++k) dst[m][k] = *(const PG8_LAS bf16x8*)(lds + PG8_SA(b, h) + aoff + m * 2048 + k * 1024); } while (0)
#define PG8_LDB(dst, b, h) do { _Pragma("unroll") for (int n = 0; n < 2; ++n) _Pragma("unroll") for (int k = 0; k < 2; ++k) dst[n][k] = *(const PG8_LAS bf16x8*)(lds + PG8_SB(b, h) + boff + n * 2048 + k * 1024); } while (0)
#define PG8_MMA(ai, bj, At, Bt) do { __builtin_amdgcn_s_setprio(1); _Pragma("unroll") for (int m = 0; m < 4; ++m) _Pragma("unroll") for (int n = 0; n < 2; ++n) _Pragma("unroll") for (int k = 0; k < 2; ++k) \
        acc[ai][bj][m][n] = __builtin_amdgcn_mfma_f32_16x16x32_bf16(Bt[n][k], At[m][k], acc[ai][bj][m][n], 0, 0, 0); __builtin_amdgcn_s_setprio(0); } while (0)
#define PG8_WAIT_V(n) asm volatile("s_waitcnt vmcnt(" #n ")" ::: "memory")
#define PG8_WAIT_L(n) asm volatile("s_waitcnt lgkmcnt(" #n ")" ::: "memory")
#define PG8_BAR __builtin_amdgcn_s_barrier()
#define PG8_SCHED __builtin_amdgcn_sched_barrier(0)
    Unit cur, nxt; int ui = 0;
    if (!S.next(0, cur)) return;
    f32x4 acc[2][2][4][2];
#pragma unroll
    for (int a = 0; a < 2; ++a)
#pragma unroll
        for (int b = 0; b < 2; ++b)
#pragma unroll
            for (int m = 0; m < 4; ++m)
#pragma unroll
                for (int n = 0; n < 2; ++n) acc[a][b][m][n] = (f32x4){0.f, 0.f, 0.f, 0.f};
    bf16x8 At[4][2], B0[2][2], B1[2][2];
    const char* cA = (const char*)g.A + (size_t)cur.pm * tstepA; const char* cB = (const char*)g.Bt + (size_t)cur.pn * tstepB;
    S.a_ready(cur);
    if constexpr (SP2) {
        PG8_STAGE(PG8_SB(0, 0), cB, voffB); PG8_STAGE(PG8_SB(0, 1), cB + hstepB, voffB); PG8_STAGE(PG8_SA(0, 0), cA, voffA); PG8_STAGE(PG8_SA(0, 1), cA + hstepA, voffA);
        if (wr == 1) PG8_BAR;
        PG8_WAIT_V(2); PG8_BAR;
        PG8_STAGE(PG8_SB(1, 0), cB + kstep, voffB); PG8_STAGE(PG8_SA(1, 0), cA + kstep, voffA); PG8_STAGE(PG8_SB(1, 1), cB + hstepB + kstep, voffB);
        PG8_WAIT_V(6); PG8_BAR;
    } else {
        PG8_STAGE(PG8_SB(0, 0), cB, voffB); PG8_STAGE(PG8_SA(0, 0), cA, voffA); PG8_STAGE(PG8_SB(0, 1), cB + hstepB, voffB); PG8_STAGE(PG8_SA(0, 1), cA + hstepA, voffA);
        if (wr == 1) PG8_BAR;
        PG8_WAIT_V(4); PG8_BAR;
        PG8_STAGE(PG8_SB(1, 0), cB + kstep, voffB); PG8_STAGE(PG8_SA(1, 0), cA + kstep, voffA); PG8_STAGE(PG8_SB(1, 1), cB + hstepB + kstep, voffB);
        PG8_WAIT_V(6); PG8_BAR;
    }
    for (;;) {
        const bool has_next = S.next(ui + 1, nxt);
        const char* nA = has_next ? (const char*)g.A + (size_t)nxt.pm * tstepA : cA; const char* nB = has_next ? (const char*)g.Bt + (size_t)nxt.pn * tstepB : cB;
        for (int t = 0; t < nt; t += 2) {
            const bool last = (t == nt - 2);
            const char* a1 = cA + ((t + 1 < kmid) ? 0l : dA2) + (size_t)(t + 1) * kstep;
            const char* a2 = last ? nA : cA + ((t + 2 < kmid) ? 0l : dA2) + (size_t)(t + 2) * kstep; const char* b2 = last ? nB : cB + (size_t)(t + 2) * kstep;
            if constexpr (MID) { if (t == kmid) E.mid(acc, cur, wr, wc, fr, fq); }
            const char* a3 = a2 + kstep; const char* b3 = b2 + kstep;
            if (last && has_next) S.a_ready(nxt);
            if constexpr (SP2) {
            PG8_LDB(B0, 0, 0); PG8_LDB(B1, 0, 1); PG8_SCHED; PG8_LDA(At, 0, 0); PG8_STAGE(PG8_SA(1, 1), a1 + hstepA, voffA);
            PG8_WAIT_V(8); PG8_WAIT_L(0); PG8_BAR; PG8_MMA(0, 0, At, B0); PG8_MMA(0, 1, At, B1); PG8_BAR; PG8_SCHED;
            PG8_LDA(At, 0, 1); PG8_STAGE(PG8_SB(0, 0), b2, voffB); PG8_STAGE(PG8_SB(0, 1), b2 + hstepB, voffB); PG8_STAGE(PG8_SA(0, 0), a2, voffA);
            PG8_WAIT_V(8); PG8_WAIT_L(0); PG8_BAR; PG8_MMA(1, 0, At, B0); PG8_MMA(1, 1, At, B1); PG8_BAR; PG8_SCHED;
            PG8_LDB(B0, 1, 0); PG8_LDB(B1, 1, 1); PG8_SCHED; PG8_LDA(At, 1, 0); PG8_STAGE(PG8_SA(0, 1), a2 + hstepA, voffA);
            PG8_WAIT_V(8); PG8_WAIT_L(0); PG8_BAR; PG8_MMA(0, 0, At, B0); PG8_MMA(0, 1, At, B1); PG8_BAR; PG8_SCHED;
            PG8_LDA(At, 1, 1); PG8_STAGE(PG8_SB(1, 0), b3, voffB); PG8_STAGE(PG8_SB(1, 1), b3 + hstepB, voffB); PG8_STAGE(PG8_SA(1, 0), a3, voffA);
            PG8_WAIT_V(8); PG8_WAIT_L(0); PG8_BAR; PG8_MMA(1, 0, At, B0); PG8_MMA(1, 1, At, B1); PG8_BAR; PG8_SCHED;
            } else {
            PG8_LDB(B0, 0, 0); PG8_SCHED; PG8_LDA(At, 0, 0); PG8_STAGE(PG8_SA(1, 1), a1 + hstepA, voffA);
            PG8_WAIT_L(8); PG8_BAR; PG8_WAIT_L(0); PG8_MMA(0, 0, At, B0); PG8_BAR; PG8_SCHED;
            PG8_LDB(B1, 0, 1); PG8_STAGE(PG8_SB(0, 0), b2, voffB);
            PG8_BAR; PG8_WAIT_L(0); PG8_MMA(0, 1, At, B1); PG8_BAR;
            PG8_LDA(At, 0, 1); PG8_STAGE(PG8_SA(0, 0), a2, voffA);
            PG8_BAR; PG8_WAIT_L(0); PG8_MMA(1, 0, At, B0); PG8_BAR; PG8_SCHED;
            PG8_STAGE(PG8_SB(0, 1), b2 + hstepB, voffB);
            PG8_WAIT_V(6); PG8_BAR; PG8_MMA(1, 1, At, B1); PG8_BAR;
            PG8_LDB(B0, 1, 0); PG8_SCHED; PG8_LDA(At, 1, 0); PG8_STAGE(PG8_SA(0, 1), a2 + hstepA, voffA);
            PG8_WAIT_L(8); PG8_BAR; PG8_WAIT_L(0); PG8_MMA(0, 0, At, B0); PG8_BAR; PG8_SCHED;
            PG8_LDB(B1, 1, 1); PG8_STAGE(PG8_SB(1, 0), b3, voffB);
            PG8_BAR; PG8_WAIT_L(0); PG8_MMA(0, 1, At, B1); PG8_BAR;
            PG8_LDA(At, 1, 1); PG8_STAGE(PG8_SA(1, 0), a3, voffA);
            PG8_BAR; PG8_WAIT_L(0); PG8_MMA(1, 0, At, B0); PG8_BAR; PG8_SCHED;
            PG8_STAGE(PG8_SB(1, 1), b3 + hstepB, voffB);
            PG8_WAIT_V(6); PG8_BAR; PG8_MMA(1, 1, At, B1); PG8_BAR;
            }
        }
        if constexpr (ALIGN_EPI) { if (wr == 0) PG8_BAR; }
        if constexpr (!Epi::AFTER_DRAIN) { E(acc, cur, wr, wc, fr, fq); S.done(cur); }
        if (!has_next) break;
#pragma unroll
        for (int a = 0; a < 2; ++a)
#pragma unroll
            for (int b = 0; b < 2; ++b)
#pragma unroll
                for (int m = 0; m < 4; ++m)
#pragma unroll
                    for (int n = 0; n < 2; ++n) acc[a][b][m][n] = (f32x4){0.f, 0.f, 0.f, 0.f};
        cur = nxt; cA = nA; cB = nB; ++ui;
        if constexpr (ALIGN_EPI) { if (wr == 1) PG8_BAR; }
    }
    PG8_WAIT_V(0);
    if constexpr (!ALIGN_EPI) { if (wr == 0) PG8_BAR; }
    PG8_BAR;
    if constexpr (Epi::AFTER_DRAIN) { E.fused(acc, cur, wr, wc, fr, fq, lds, wid, lane); S.done(cur); }
#undef PG8_SA
#undef PG8_SB
#undef PG8_STAGE
#undef PG8_LDA
#undef PG8_LDB
#undef PG8_MMA
#undef PG8_WAIT_V
#undef PG8_WAIT_L
#undef PG8_BAR
#undef PG8_SCHED
}
}

struct Args {
    const float *x_prompt, *x_sample, *state_hgrn, *cache_k, *cache_v, *norm1_w, *w_in, *lb_logits, *hgrn_norm_w, *q_norm_w, *k_norm_w, *sinks,
                *w_o_hgrn, *w_o_attn, *w_out, *norm2_w, *w_ffn_gate, *w_ffn_up, *w_ffn_down;
    float* out; unsigned char* ws; int ph_lo, ph_hi;
};

__device__ __forceinline__ float wave_sum(float v) {
#pragma unroll
    for (int o = 1; o < 64; o <<= 1) v += __shfl_xor(v, o);
    return v;
}

__device__ __forceinline__ void p0_transpose_item(const float* __restrict__ W, int ldw, int K, bf16* WT, int k0, int n0, int drow0, const float* __restrict__ ks, LAS float* scr, int lane, int kofs = 0) {
    float wv[32];
#pragma unroll
    for (int i = 0; i < 32; ++i) wv[i] = W[(size_t)(k0 + 2 * i + (lane >> 5)) * ldw + n0 + (lane & 31)];
#pragma unroll
    for (int i = 0; i < 32; ++i) { const int kk = 2 * i + (lane >> 5); const float s = ks ? ks[k0 + kk] : 1.f; scr[kk * 33 + (lane & 31)] = wv[i] * s; }
    asm volatile("s_waitcnt lgkmcnt(0)" ::: "memory");
    const int c = lane & 7;
#pragma unroll
    for (int j = 0; j < 4; ++j) { const int n = (lane >> 3) + 8 * j; const LAS float* s = scr + (8 * c) * 33 + n;
        u32x4 o; o.x = pk2(s[0 * 33], s[1 * 33]); o.y = pk2(s[2 * 33], s[3 * 33]); o.z = pk2(s[4 * 33], s[5 * 33]); o.w = pk2(s[6 * 33], s[7 * 33]);
        *(u32x4*)(WT + (size_t)(drow0 + n) * K + kofs + k0 + 8 * c) = o; }
    asm volatile("s_waitcnt lgkmcnt(0)" ::: "memory");
}

constexpr int P0_I1 = 16 * 152, P0_NITEMS = 16 * 152 + 2 * 8 * 32 + 16 * 32 + 2 * 16 * 88 + 44 * 32;
__device__ __forceinline__ void p0_weights(const Args& a, unsigned char* lds, int it_lo, int it_hi, int widx, int nwork) {
    const int tid = threadIdx.x, lane = tid & 63, wave = tid >> 6;
    LAS float* scr = (LAS float*)(LAS void*)(lds + wave * 16384);
    unsigned char* ws = a.ws;
    constexpr int I1 = 16 * 152, I2 = 8 * 32, I4 = 16 * 32, I5 = 16 * 88;
    for (int it = it_lo + widx; it < it_hi; it += nwork) {
        int r = it;
        if (r < I1) { const int n0 = 32 * (r % 152);
            const int dr = n0 < 2816 ? n0 : (n0 < 3840 ? 2816 + ((n0 - 2816) >> 7) * 256 + ((n0 - 2816) & 127) : 2816 + ((n0 - 3840) >> 7) * 256 + 128 + ((n0 - 3840) & 127));
            p0_transpose_item(a.w_in, PW, 1024, (bf16*)(ws + WS_W1T), 64 * (r / 152), n0, dr, a.norm1_w, scr, lane); continue; } r -= I1;
        if (r < I2) { p0_transpose_item(a.w_o_hgrn, 1024, 1024, (bf16*)(ws + WS_WOH), 64 * (r / 32), 32 * (r % 32), 32 * (r % 32), nullptr, scr, lane, 0); continue; } r -= I2;
        if (r < I2) { p0_transpose_item(a.w_o_attn, 1024, 1024, (bf16*)(ws + WS_WOH), 64 * (r / 32), 32 * (r % 32), 32 * (r % 32), nullptr, scr, lane, 512); continue; } r -= I2;
        if (r < I4) { p0_transpose_item(a.w_out, 1024, 1024, (bf16*)(ws + WS_WOUT), 64 * (r / 32), 32 * (r % 32), 32 * (r % 32), nullptr, scr, lane); continue; } r -= I4;
        if (r < I5) { const int n0 = 32 * (r % 88); p0_transpose_item(a.w_ffn_gate, DFF, 1024, (bf16*)(ws + WS_WGU), 64 * (r / 88), n0, (n0 >> 7) * 256 + (n0 & 127), a.norm2_w, scr, lane); continue; } r -= I5;
        if (r < I5) { const int n0 = 32 * (r % 88); p0_transpose_item(a.w_ffn_up, DFF, 1024, (bf16*)(ws + WS_WGU), 64 * (r / 88), n0, (n0 >> 7) * 256 + 128 + (n0 & 127), a.norm2_w, scr, lane); continue; } r -= I5;
        p0_transpose_item(a.w_ffn_down, 1024, DFF, (bf16*)(ws + WS_WD), 64 * (r / 32), 32 * (r % 32), 32 * (r % 32), nullptr, scr, lane);
    }
}
__device__ __forceinline__ void p0_prologue(const Args& a, unsigned char* lds, int w_hi) {
    const int tid = threadIdx.x, lane = tid & 63, wave = tid >> 6;
    const int gw = blockIdx.x * 8 + wave, NGW = gridDim.x * 8;
    unsigned char* ws = a.ws;
    p0_weights(a, lds, 0, w_hi, gw, NGW);
    bf16* XB = (bf16*)(ws + WS_R0);
    for (int m = gw; m < MT; m += 2 * NGW) {
        const int m1 = m + NGW; const bool has1 = m1 < MT;
        const float* xrow0 = (m < MP) ? a.x_prompt + (size_t)m * 1024 : a.x_sample + (size_t)(m - MP) * 1024;
        const float* xrow1 = !has1 ? xrow0 : (m1 < MP) ? a.x_prompt + (size_t)m1 * 1024 : a.x_sample + (size_t)(m1 - MP) * 1024;
        const f32x4* xr0 = (const f32x4*)xrow0 + lane; const f32x4* xr1 = (const f32x4*)xrow1 + lane;
        f32x4 v[4], u[4]; float s0 = 0.f, s1 = 0.f;
#pragma unroll
        for (int j = 0; j < 4; ++j) { v[j] = xr0[64 * j]; u[j] = xr1[64 * j]; }
#pragma unroll
        for (int j = 0; j < 4; ++j) { s0 += (v[j][0] * v[j][0] + v[j][1] * v[j][1]) + (v[j][2] * v[j][2] + v[j][3] * v[j][3]); s1 += (u[j][0] * u[j][0] + u[j][1] * u[j][1]) + (u[j][2] * u[j][2] + u[j][3] * u[j][3]); }
        const float r0 = __builtin_amdgcn_rsqf(wave_sum(s0) * (1.f / 1024.f) + EPS), r1 = __builtin_amdgcn_rsqf(wave_sum(s1) * (1.f / 1024.f) + EPS);
        u32x2* o0 = (u32x2*)(XB + (size_t)m * 1024) + lane; u32x2* o1 = (u32x2*)(XB + (size_t)m1 * 1024) + lane;
#pragma unroll
        for (int j = 0; j < 4; ++j) { u32x2 w; w.x = pk2(v[j][0] * r0, v[j][1] * r0); w.y = pk2(v[j][2] * r0, v[j][3] * r0); o0[64 * j] = w; }
        if (has1) {
#pragma unroll
            for (int j = 0; j < 4; ++j) { u32x2 w; w.x = pk2(u[j][0] * r1, u[j][1] * r1); w.y = pk2(u[j][2] * r1, u[j][3] * r1); o1[64 * j] = w; }
        }
    }
    float* sumsq = (float*)(ws + WS_SUMSQ);
    for (int i = blockIdx.x * NTHREADS + tid; i < MT; i += gridDim.x * NTHREADS) sumsq[i] = 0.f;
    if (blockIdx.x == 0) { float* lbv = (float*)(ws + WS_LBV); lbv[tid] = sigm(a.lb_logits[tid] - a.lb_logits[512 + tid]); }
}

__device__ __forceinline__ void hgrn_local_phase(const Args& a, unsigned char* lds) {
    const int tid = threadIdx.x, lane = tid & 63, wid = tid >> 6, G = gridDim.x;
    float* cumS = (float*)lds; float* segT = (float*)(lds + 32768); bf16* KdS = (bf16*)(lds + 34816); bf16* VS = (bf16*)(lds + 52224);
    unsigned char* ws = a.ws;
    constexpr int N_LOC = 512 * 4;
    f32x4 gr[4]; u32x4 vr[2];
    int it = blockIdx.x;
#define HL_LOAD(IT) do { const size_t r0_ = (size_t)((IT) >> 2) * 64; const int h_ = (IT) & 3; \
        const size_t ho_ = ((size_t)h_ * MT + r0_) * 128; const float* G_ = (const float*)(ws + WS_R3) + ho_; const bf16* V_ = (const bf16*)(ws + WS_R4) + ho_; \
        _Pragma("unroll") for (int i = 0; i < 4; ++i) { const int idx = tid + 512 * i; gr[i] = *(const f32x4*)(G_ + 4 * idx); } \
        _Pragma("unroll") for (int i = 0; i < 2; ++i) { const int idx = tid + 512 * i; vr[i] = *(const u32x4*)(V_ + 8 * idx); } } while (0)
    if (it < N_LOC) HL_LOAD(it);
    for (; it < N_LOC; it += G) {
        const int cidx = it >> 2, h = it & 3;
        const size_t r0 = (size_t)cidx * 64;
        float* Gp = (float*)(ws + WS_R3) + ((size_t)h * MT + r0) * 128;
#pragma unroll
        for (int i = 0; i < 4; ++i) { const int idx = tid + 512 * i, j = idx >> 5, k4 = (idx & 31) * 4; *(f32x4*)(cumS + j * 128 + k4) = gr[i]; }
        __syncthreads();
        {
            const int k = tid & 127, seg = tid >> 7; float v[16]; float run = 0.f;
#pragma unroll
            for (int i = 0; i < 16; ++i) { run += cumS[(seg * 16 + i) * 128 + k]; v[i] = run; }
            segT[seg * 128 + k] = run;
            __syncthreads();
            float off = 0.f;
#pragma unroll
            for (int s = 0; s < 3; ++s) off += (s < seg) ? segT[s * 128 + k] : 0.f;
#pragma unroll
            for (int i = 0; i < 16; ++i) cumS[(seg * 16 + i) * 128 + k] = v[i] + off;
        }
        __syncthreads();
#pragma unroll
        for (int i = 0; i < 2; ++i) { const int idx = tid + 512 * i;
            const f32x4 ca = *(const f32x4*)(cumS + 8 * idx), cb = *(const f32x4*)(cumS + 8 * idx + 4);
            u32x4 w; w.x = pk2(__expf(ca[0]), __expf(ca[1])); w.y = pk2(__expf(ca[2]), __expf(ca[3])); w.z = pk2(__expf(cb[0]), __expf(cb[1])); w.w = pk2(__expf(cb[2]), __expf(cb[3]));
            *(u32x4*)((bf16*)Gp + 8 * idx) = w; }
        if (tid < 128) ((float*)(ws + WS_DT))[(size_t)(cidx * 4 + h) * 128 + tid] = __expf(cumS[63 * 128 + tid]);
#pragma unroll
        for (int i = 0; i < 2; ++i) {
            const int idx = tid + 512 * i, j = idx >> 4, k8 = (idx & 15) * 8;
            const f32x4 c0 = *(const f32x4*)(cumS + j * 128 + k8), c1 = *(const f32x4*)(cumS + j * 128 + k8 + 4);
            const f32x4 z4 = {0.f, 0.f, 0.f, 0.f};
            const f32x4 p0 = j ? *(const f32x4*)(cumS + (j - 1) * 128 + k8) : z4, p1 = j ? *(const f32x4*)(cumS + (j - 1) * 128 + k8 + 4) : z4;
            const f32x4 l0 = *(const f32x4*)(cumS + 63 * 128 + k8), l1 = *(const f32x4*)(cumS + 63 * 128 + k8 + 4);
            float kk[8];
#pragma unroll
            for (int x = 0; x < 4; ++x) { kk[x] = 1.f - __expf(c0[x] - p0[x]); kk[4 + x] = 1.f - __expf(c1[x] - p1[x]); }
            u32x4 w;
            w.x = pk2(kk[0] * __expf(l0[0] - c0[0]), kk[1] * __expf(l0[1] - c0[1]));
            w.y = pk2(kk[2] * __expf(l0[2] - c0[2]), kk[3] * __expf(l0[3] - c0[3]));
            w.z = pk2(kk[4] * __expf(l1[0] - c1[0]), kk[5] * __expf(l1[1] - c1[1]));
            w.w = pk2(kk[6] * __expf(l1[2] - c1[2]), kk[7] * __expf(l1[3] - c1[3]));
            *(u32x4*)(KdS + j * 136 + k8) = w;
            *(u32x4*)(VS + j * 136 + k8) = vr[i];
        }
        __syncthreads();
        if (it + G < N_LOC) HL_LOAD(it + G);
        {
            const int i16 = lane & 15, g = lane >> 4, q = i16 >> 2, p = i16 & 3;
            bf16x8 af[2];
#pragma unroll
            for (int jc = 0; jc < 2; ++jc) af[jc] = cat8(tr_read(KdS + (32 * jc + 8 * g + q) * 136 + 16 * wid + 4 * p), tr_read(KdS + (32 * jc + 8 * g + 4 + q) * 136 + 16 * wid + 4 * p));
            bf16* SLT = (bf16*)(ws + WS_R0) + (size_t)(cidx * 4 + h) * 16384;
#pragma unroll
            for (int nt = 0; nt < 8; ++nt) {
                f32x4 acc = {0.f, 0.f, 0.f, 0.f};
#pragma unroll
                for (int jc = 0; jc < 2; ++jc) {
                    const bf16x8 bfr = cat8(tr_read(VS + (32 * jc + 8 * g + q) * 136 + 16 * nt + 4 * p), tr_read(VS + (32 * jc + 8 * g + 4 + q) * 136 + 16 * nt + 4 * p));
                    acc = MFMA16(af[jc], bfr, acc);
                }
                u32x2 w; w.x = pk2(acc[0], acc[1]); w.y = pk2(acc[2], acc[3]);
                *(u32x2*)(SLT + (size_t)(16 * nt + i16) * 128 + 16 * wid + 4 * g) = w;
            }
        }
        __syncthreads();
    }
#undef HL_LOAD
}

__device__ __forceinline__ void attn_prompt_item(const Args& a, int b, int qb, int kvh, unsigned char* lds) {
    const int tid = threadIdx.x, lane = tid & 63, wid = __builtin_amdgcn_readfirstlane(tid >> 6);
    bf16* KS = (bf16*)lds; bf16* VS = (bf16*)(lds + 36864);
    unsigned char* ws = a.ws;
    const bf16* QA = (const bf16*)(ws + WS_R6); const bf16* KV = (const bf16*)(ws + WS_R7); bf16* YB = (bf16*)(ws + WS_R10);
    {
        const int key = tid >> 1, half = tid & 1;
        u32x4 kw[4], vw[4];
        const bool zero = (qb == 0 && key < 128);
        const size_t row = (size_t)b * SEQ + (size_t)(qb - 1) * 128 + key;
#pragma unroll
        for (int c = 0; c < 4; ++c) {
            if (zero) { kw[c] = (u32x4){0u, 0u, 0u, 0u}; vw[c] = kw[c]; }
            else { kw[c] = *(const u32x4*)(KV + row * 256 + kvh * 64 + half * 32 + 8 * c); vw[c] = *(const u32x4*)(KV + row * 256 + 128 + kvh * 64 + half * 32 + 8 * c); }
        }
        float ss = 0.f;
#pragma unroll
        for (int c = 0; c < 4; ++c) { const float e0 = bflo(kw[c].x), e1 = bfhi(kw[c].x), e2 = bflo(kw[c].y), e3 = bfhi(kw[c].y), e4 = bflo(kw[c].z), e5 = bfhi(kw[c].z), e6 = bflo(kw[c].w), e7 = bfhi(kw[c].w);
            ss += (e0 * e0 + e1 * e1) + (e2 * e2 + e3 * e3) + (e4 * e4 + e5 * e5) + (e6 * e6 + e7 * e7); }
        ss += __shfl_xor(ss, 1);
        const float rstd = __builtin_amdgcn_rsqf(ss * (1.f / 64.f) + EPS);
        const bool wr_cache = (qb == SEQ / 128 - 1) && key >= 128;
        float* ck = a.out + O_KP + ((size_t)(b * 128 + (key - 128)) * 2 + kvh) * 64 + half * 32;
        float* cv = a.out + O_VP + ((size_t)(b * 128 + (key - 128)) * 2 + kvh) * 64 + half * 32;
#pragma unroll
        for (int c = 0; c < 4; ++c) {
            const f32x4 w0 = *(const f32x4*)(a.k_norm_w + half * 32 + 8 * c), w1 = *(const f32x4*)(a.k_norm_w + half * 32 + 8 * c + 4);
            f32x4 n0, n1;
            n0[0] = bflo(kw[c].x) * rstd * w0[0]; n0[1] = bfhi(kw[c].x) * rstd * w0[1]; n0[2] = bflo(kw[c].y) * rstd * w0[2]; n0[3] = bfhi(kw[c].y) * rstd * w0[3];
            n1[0] = bflo(kw[c].z) * rstd * w1[0]; n1[1] = bfhi(kw[c].z) * rstd * w1[1]; n1[2] = bflo(kw[c].w) * rstd * w1[2]; n1[3] = bfhi(kw[c].w) * rstd * w1[3];
            u32x4 w; w.x = pk2(n0[0], n0[1]); w.y = pk2(n0[2], n0[3]); w.z = pk2(n1[0], n1[1]); w.w = pk2(n1[2], n1[3]);
            *(u32x4*)(KS + key * 72 + half * 32 + 8 * c) = w;
            *(u32x4*)(VS + key * 72 + half * 32 + 8 * c) = vw[c];
            if (wr_cache) {
                *(f32x4*)(ck + 8 * c) = n0; *(f32x4*)(ck + 8 * c + 4) = n1;
                *(f32x4*)(cv + 8 * c) = (f32x4){bflo(vw[c].x), bfhi(vw[c].x), bflo(vw[c].y), bfhi(vw[c].y)};
                *(f32x4*)(cv + 8 * c + 4) = (f32x4){bflo(vw[c].z), bfhi(vw[c].z), bflo(vw[c].w), bfhi(vw[c].w)};
            }
        }
    }
    __syncthreads();
    const int i16 = lane & 15, g = lane >> 4, q = i16 >> 2, p = i16 & 3;
    const int qt = wid, t0 = qt > 0 ? qt - 1 : 0;
    const size_t row = (size_t)b * SEQ + (size_t)qb * 128 + 16 * qt + i16;
    f32x4 dl2[10];
    {
        const int qz = (qb == 0) ? -1 : 0, band0 = 16 * t0 + 4 * g, dist0 = 128 + 16 * qt + i16 - band0;
#pragma unroll
        for (int t = 0; t < 10; ++t)
#pragma unroll
            for (int r = 0; r < 4; ++r) {
                const int band = band0 + 16 * t + r, dist = dist0 - 16 * t - r;
                const int msk = ((dist | (127 - dist)) >> 31) | (((band - 128) >> 31) & qz);
                dl2[t][r] = msk ? 1e30f : (float)dist * 1.4426950408889634f;
            }
    }
    u32x4 qnx[2];
    qnx[0] = *(const u32x4*)(QA + row * 512 + kvh * 256 + 8 * g); qnx[1] = *(const u32x4*)(QA + row * 512 + kvh * 256 + 32 + 8 * g);
#pragma unroll 1
    for (int g4 = 0; g4 < 4; ++g4) {
        asm volatile("" ::: "memory");
        const int hq = kvh * 4 + g4;
        bf16x8 bq[2];
        {
            u32x4 qw[2]; float ss = 0.f;
            qw[0] = qnx[0]; qw[1] = qnx[1];
            if (g4 < 3) { qnx[0] = *(const u32x4*)(QA + row * 512 + (hq + 1) * 64 + 8 * g); qnx[1] = *(const u32x4*)(QA + row * 512 + (hq + 1) * 64 + 32 + 8 * g); }
#pragma unroll
            for (int c = 0; c < 2; ++c) {
                const float e0 = bflo(qw[c].x), e1 = bfhi(qw[c].x), e2 = bflo(qw[c].y), e3 = bfhi(qw[c].y), e4 = bflo(qw[c].z), e5 = bfhi(qw[c].z), e6 = bflo(qw[c].w), e7 = bfhi(qw[c].w);
                ss += (e0 * e0 + e1 * e1) + (e2 * e2 + e3 * e3) + (e4 * e4 + e5 * e5) + (e6 * e6 + e7 * e7); }
            ss += __shfl_xor(ss, 16); ss += __shfl_xor(ss, 32);
            const float rstd = __builtin_amdgcn_rsqf(ss * (1.f / 64.f) + EPS);
#pragma unroll
            for (int c = 0; c < 2; ++c) {
                const f32x4 w0 = *(const f32x4*)(a.q_norm_w + 32 * c + 8 * g), w1 = *(const f32x4*)(a.q_norm_w + 32 * c + 8 * g + 4);
                u32x4 w;
                w.x = pk2(bflo(qw[c].x) * rstd * w0[0], bfhi(qw[c].x) * rstd * w0[1]); w.y = pk2(bflo(qw[c].y) * rstd * w0[2], bfhi(qw[c].y) * rstd * w0[3]);
                w.z = pk2(bflo(qw[c].z) * rstd * w1[0], bfhi(qw[c].z) * rstd * w1[1]); w.w = pk2(bflo(qw[c].w) * rstd * w1[2], bfhi(qw[c].w) * rstd * w1[3]);
                bq[c] = __builtin_bit_cast(bf16x8, w);
            }
        }
        const float nslope = -exp2f(-(float)(hq + 1)), sink2 = a.sinks[hq] * 1.4426950408889634f;
        f32x4 sc[10]; float mx = -3.0e38f;
#pragma unroll
        for (int t = 0; t < 10; ++t) {
            f32x4 s = {0.f, 0.f, 0.f, 0.f};
#pragma unroll
            for (int c = 0; c < 2; ++c) s = MFMA16(*(const bf16x8*)(KS + (16 * (t0 + t) + i16) * 72 + 32 * c + 8 * g), bq[c], s);
            s = s * (0.125f * 1.4426950408889634f) + dl2[t] * nslope;
            mx = fmaxf(mx, fmaxf(fmaxf(s[0], s[1]), fmaxf(s[2], s[3])));
            sc[t] = s;
        }
        mx = fmaxf(mx, __shfl_xor(mx, 16)); mx = fmaxf(mx, __shfl_xor(mx, 32)); mx = fmaxf(mx, sink2);
        f32x4 sum4 = {0.f, 0.f, 0.f, 0.f};
#pragma unroll
        for (int t = 0; t < 10; ++t) {
            const f32x4 d = sc[t] - mx; f32x4 ev;
            ev[0] = __builtin_amdgcn_exp2f(d[0]); ev[1] = __builtin_amdgcn_exp2f(d[1]); ev[2] = __builtin_amdgcn_exp2f(d[2]); ev[3] = __builtin_amdgcn_exp2f(d[3]);
            sc[t] = ev; sum4 += ev;
        }
        float sum = (sum4[0] + sum4[1]) + (sum4[2] + sum4[3]);
        sum += __shfl_xor(sum, 16); sum += __shfl_xor(sum, 32);
        const float inv = 1.f / (sum + __builtin_amdgcn_exp2f(sink2 - mx));
        bf16x8 pb[5];
#pragma unroll
        for (int ch = 0; ch < 5; ++ch) pb[ch] = pk8(sc[2 * ch], sc[2 * ch + 1]);
#pragma unroll
        for (int dt = 0; dt < 4; ++dt) {
            f32x4 acc = {0.f, 0.f, 0.f, 0.f};
#pragma unroll
            for (int ch = 0; ch < 5; ++ch) {
                const bf16x8 av = cat8(tr_read(VS + (16 * (t0 + 2 * ch) + 4 * g + q) * 72 + 16 * dt + 4 * p), tr_read(VS + (16 * (t0 + 2 * ch + 1) + 4 * g + q) * 72 + 16 * dt + 4 * p));
                acc = MFMA16(av, pb[ch], acc);
            }
            u32x2 w; w.x = pk2(acc[0] * inv, acc[1] * inv); w.y = pk2(acc[2] * inv, acc[3] * inv);
            *(u32x2*)(YB + row * 512 + hq * 64 + 16 * dt + 4 * g) = w;
        }
    }
    __syncthreads();
}

__device__ __forceinline__ void attn_sample_item(const Args& a, int b, unsigned char* lds) {
    const int tid = threadIdx.x;
    float* qn = (float*)lds; float* knew = (float*)(lds + 8192); float* vnew = (float*)(lds + 10240); float* sc = (float*)(lds + 12288); float* invs = (float*)(lds + 29696); float* cb = (float*)(lds + 32768);
    unsigned char* ws = a.ws;
    const bf16* QA = (const bf16*)(ws + WS_R6); const bf16* KV = (const bf16*)(ws + WS_R7); bf16* YB = (bf16*)(ws + WS_R10);
    const size_t rb = (size_t)MP + (size_t)b * 4;
    const float* ck = a.cache_k + (size_t)b * 16384; const float* cv = a.cache_v + (size_t)b * 16384;
    f32x4 kreg[8];
#pragma unroll
    for (int i = 0; i < 8; ++i) kreg[i] = *(const f32x4*)(ck + 4 * (tid + 512 * i));
    {
        const int pair = tid >> 4, d4 = (tid & 15) * 4, hq = pair >> 2, t = pair & 3;
        const u32x2 w = *(const u32x2*)(QA + (rb + t) * 512 + hq * 64 + d4);
        const float e0 = bflo(w.x), e1 = bfhi(w.x), e2 = bflo(w.y), e3 = bfhi(w.y);
        float ss = (e0 * e0 + e1 * e1) + (e2 * e2 + e3 * e3);
        ss += __shfl_xor(ss, 1); ss += __shfl_xor(ss, 2); ss += __shfl_xor(ss, 4); ss += __shfl_xor(ss, 8);
        const float rstd = __builtin_amdgcn_rsqf(ss * (1.f / 64.f) + EPS);
        const f32x4 nw = *(const f32x4*)(a.q_norm_w + d4);
        *(f32x4*)(qn + pair * 64 + d4) = (f32x4){e0 * rstd * nw[0], e1 * rstd * nw[1], e2 * rstd * nw[2], e3 * rstd * nw[3]};
    }
    if (tid < 128) {
        const int t = tid >> 5, kvh = (tid >> 4) & 1, d4 = (tid & 15) * 4;
        const u32x2 w = *(const u32x2*)(KV + (rb + t) * 256 + kvh * 64 + d4);
        const float e0 = bflo(w.x), e1 = bfhi(w.x), e2 = bflo(w.y), e3 = bfhi(w.y);
        float ss = (e0 * e0 + e1 * e1) + (e2 * e2 + e3 * e3);
        ss += __shfl_xor(ss, 1); ss += __shfl_xor(ss, 2); ss += __shfl_xor(ss, 4); ss += __shfl_xor(ss, 8);
        const float rstd = __builtin_amdgcn_rsqf(ss * (1.f / 64.f) + EPS);
        const f32x4 nw = *(const f32x4*)(a.k_norm_w + d4);
        *(f32x4*)(knew + t * 128 + kvh * 64 + d4) = (f32x4){e0 * rstd * nw[0], e1 * rstd * nw[1], e2 * rstd * nw[2], e3 * rstd * nw[3]};
        const u32x2 v = *(const u32x2*)(KV + (rb + t) * 256 + 128 + kvh * 64 + d4);
        *(f32x4*)(vnew + t * 128 + kvh * 64 + d4) = (f32x4){bflo(v.x), bfhi(v.x), bflo(v.y), bfhi(v.y)};
    }
    {
        float* ok = a.out + O_KS + (size_t)b * 16384;
#pragma unroll
        for (int i = 0; i < 8; ++i) { const int f = 4 * (tid + 512 * i); *(f32x4*)(cb + f) = kreg[i];
            if (f >= 512) *(f32x4*)(ok + f - 512) = kreg[i]; }
    }
    __syncthreads();
    if (tid < 128) { const int f = 4 * tid;
        *(f32x4*)(a.out + O_KS + (size_t)b * 16384 + 124 * 128 + f) = *(const f32x4*)(knew + f); *(f32x4*)(a.out + O_VS + (size_t)b * 16384 + 124 * 128 + f) = *(const f32x4*)(vnew + f); }
    for (int idx = tid; idx < 132 * 32; idx += 512) {
        const int key = idx >> 5, pair = idx & 31, hq = pair >> 2, t = pair & 3, kvh = hq >> 2;
        const float* qp = qn + pair * 64; float dot = 0.f;
        const float* kp = key < 128 ? cb + (key * 2 + kvh) * 64 : knew + (key - 128) * 128 + kvh * 64;
#pragma unroll
        for (int d = 0; d < 64; d += 4) { const f32x4 kk = *(const f32x4*)(kp + d), qq = *(const f32x4*)(qp + d); dot += (kk[0] * qq[0] + kk[1] * qq[1]) + (kk[2] * qq[2] + kk[3] * qq[3]); }
        const int dist = key < 128 ? t + 128 - key : t - (key - 128);
        const bool valid = dist >= 0 && dist < 128;
        sc[pair * 136 + key] = valid ? dot * 0.125f - exp2f(-(float)(hq + 1)) * (float)dist : -1e30f;
    }
    __syncthreads();
    f32x4 vreg[8];
#pragma unroll
    for (int i = 0; i < 8; ++i) vreg[i] = *(const f32x4*)(cv + 4 * (tid + 512 * i));
    {
        const int pair = tid >> 4, l16 = tid & 15, hq = pair >> 2; const float sink = a.sinks[hq];
        float mx = -3.0e38f;
        for (int key = l16; key < 132; key += 16) mx = fmaxf(mx, sc[pair * 136 + key]);
        mx = fmaxf(mx, __shfl_xor(mx, 1)); mx = fmaxf(mx, __shfl_xor(mx, 2)); mx = fmaxf(mx, __shfl_xor(mx, 4)); mx = fmaxf(mx, __shfl_xor(mx, 8));
        mx = fmaxf(mx, sink);
        float sum = 0.f;
        for (int key = l16; key < 132; key += 16) { const float e = __expf(sc[pair * 136 + key] - mx); sc[pair * 136 + key] = e; sum += e; }
        sum += __shfl_xor(sum, 1); sum += __shfl_xor(sum, 2); sum += __shfl_xor(sum, 4); sum += __shfl_xor(sum, 8);
        if (l16 == 0) invs[pair] = 1.f / (sum + __expf(sink - mx));
    }
    { float* ov = a.out + O_VS + (size_t)b * 16384;
#pragma unroll
      for (int i = 0; i < 8; ++i) { const int f = 4 * (tid + 512 * i); *(f32x4*)(cb + f) = vreg[i]; if (f >= 512) *(f32x4*)(ov + f - 512) = vreg[i]; } }
    __syncthreads();
    {
        const int pair = tid >> 4, d4 = (tid & 15) * 4, hq = pair >> 2, t = pair & 3, kvh = hq >> 2;
        f32x4 acc = {0.f, 0.f, 0.f, 0.f};
#pragma unroll 8
        for (int key = 0; key < 128; ++key) { const float pv = sc[pair * 136 + key]; acc += pv * *(const f32x4*)(cb + (key * 2 + kvh) * 64 + d4); }
#pragma unroll
        for (int key = 0; key < 4; ++key) { const float pv = sc[pair * 136 + 128 + key]; acc += pv * *(const f32x4*)(vnew + key * 128 + kvh * 64 + d4); }
        const float inv = invs[pair];
        u32x2 w; w.x = pk2(acc[0] * inv, acc[1] * inv); w.y = pk2(acc[2] * inv, acc[3] * inv);
        *(u32x2*)(YB + (rb + t) * 512 + hq * 64 + d4) = w;
    }
    __syncthreads();
}

__device__ __forceinline__ void hgrn_scan(const Args& a, int sb, int ns, unsigned char* lds) {
    unsigned char* ws = a.ws;
    bf16* SLT = (bf16*)(ws + WS_R0); const float* DT = (const float*)(ws + WS_DT);
    float* dts = (float*)lds;
    for (int e0 = sb * NTHREADS; e0 < 4 * 4 * 128 * 16; e0 += ns * NTHREADS) {
        const int e = e0 + threadIdx.x;
        const int k8 = (e & 15) * 8, v = (e >> 4) & 127, h = (e0 >> 11) & 3, b = e0 >> 13;
        __syncthreads();
#pragma unroll
        for (int i = 0; i < 8; ++i) { const int idx = threadIdx.x + 512 * i, c = idx >> 5, k4 = (idx & 31) * 4; *(f32x4*)(dts + c * 128 + k4) = *(const f32x4*)(DT + (size_t)((b * 128 + c) * 4 + h) * 128 + k4); }
        __syncthreads();
        float st[8];
#pragma unroll
        for (int j = 0; j < 8; ++j) st[j] = 0.f;
        for (int c0 = 0; c0 < 128; c0 += 16) {
            u32x4 loc[16];
#pragma unroll
            for (int i = 0; i < 16; ++i) { const size_t ci = (size_t)((b * 128 + c0 + i) * 4 + h); loc[i] = *(const u32x4*)(SLT + (ci * 128 + v) * 128 + k8); }
#pragma unroll
            for (int i = 0; i < 16; ++i) { const size_t ci = (size_t)((b * 128 + c0 + i) * 4 + h);
                const f32x4 d0 = *(const f32x4*)(dts + (c0 + i) * 128 + k8), d1 = *(const f32x4*)(dts + (c0 + i) * 128 + k8 + 4);
                u32x4 w; w.x = pk2(st[0], st[1]); w.y = pk2(st[2], st[3]); w.z = pk2(st[4], st[5]); w.w = pk2(st[6], st[7]);
                *(u32x4*)(SLT + (ci * 128 + v) * 128 + k8) = w;
                st[0] = d0[0] * st[0] + bflo(loc[i].x); st[1] = d0[1] * st[1] + bfhi(loc[i].x); st[2] = d0[2] * st[2] + bflo(loc[i].y); st[3] = d0[3] * st[3] + bfhi(loc[i].y);
                st[4] = d1[0] * st[4] + bflo(loc[i].z); st[5] = d1[1] * st[5] + bfhi(loc[i].z); st[6] = d1[2] * st[6] + bflo(loc[i].w); st[7] = d1[3] * st[7] + bfhi(loc[i].w); }
        }
        float* o = a.out + O_SP + ((size_t)(b * 4 + h) * 128 + k8) * 128 + v;
#pragma unroll
        for (int j = 0; j < 8; ++j) o[j * 128] = st[j];
    }
}

__device__ __forceinline__ void hgrn_out_phase(const Args& a, unsigned char* lds) {
    const int tid = threadIdx.x, lane = tid & 63, wid = tid >> 6, G = gridDim.x;
    bf16* QdS = (bf16*)lds; bf16* KxS = (bf16*)(lds + 17408); bf16* VS = (bf16*)(lds + 34816); bf16* SS = (bf16*)(lds + 52224); float* red = (float*)(lds + 87040);
    unsigned char* ws = a.ws;
    constexpr int N_OUT = 512 * 4;
    u32x4 er[2], qr[2], kr[2], vr[2], sr[4];
#define HO_LOAD(IT) do { const size_t r0_ = (size_t)((IT) >> 2) * 64; const int h_ = (IT) & 3; \
        const size_t ho_ = ((size_t)h_ * MT + r0_) * 128; const float* CU_ = (const float*)(ws + WS_R3) + ho_; const bf16* Q_ = (const bf16*)(ws + WS_R1) + ho_; \
        const bf16* K_ = (const bf16*)(ws + WS_R2) + ho_; const bf16* V_ = (const bf16*)(ws + WS_R4) + ho_; const bf16* S_ = (const bf16*)(ws + WS_R0) + (size_t)(IT) * 16384; \
        _Pragma("unroll") for (int i = 0; i < 2; ++i) { const int idx = tid + 512 * i; \
            er[i] = *(const u32x4*)((const bf16*)CU_ + 8 * idx); \
            qr[i] = *(const u32x4*)(Q_ + 8 * idx); kr[i] = *(const u32x4*)(K_ + 8 * idx); vr[i] = *(const u32x4*)(V_ + 8 * idx); } \
        _Pragma("unroll") for (int i = 0; i < 4; ++i) { const int idx = tid + 512 * i, v = idx >> 4, c8 = (idx & 15) * 8; sr[i] = *(const u32x4*)(S_ + (size_t)v * 128 + c8); } } while (0)
    int it = blockIdx.x;
    if (it < N_OUT) HO_LOAD(it);
    for (; it < N_OUT; it += G) {
        const int cidx = it >> 2, h = it & 3;
        const size_t r0 = (size_t)cidx * 64;
        const bf16* OG = (const bf16*)(ws + WS_R5) + ((size_t)h * MT + r0) * 128;
        bf16* YA = (bf16*)(ws + WS_R6) + r0 * 512 + h * 128;
#pragma unroll
        for (int i = 0; i < 2; ++i) {
            const int idx = tid + 512 * i, j = idx >> 4, k8 = (idx & 15) * 8;
            const u32x4 ew = er[i], qw = qr[i], kw = kr[i];
            const float e[8] = {bflo(ew.x), bfhi(ew.x), bflo(ew.y), bfhi(ew.y), bflo(ew.z), bfhi(ew.z), bflo(ew.w), bfhi(ew.w)};
            float ei[8];
#pragma unroll
            for (int x = 0; x < 8; ++x) ei[x] = __builtin_amdgcn_rcpf(e[x]);
            u32x4 w;
            w.x = pk2(bflo(qw.x) * e[0], bfhi(qw.x) * e[1]); w.y = pk2(bflo(qw.y) * e[2], bfhi(qw.y) * e[3]); w.z = pk2(bflo(qw.z) * e[4], bfhi(qw.z) * e[5]); w.w = pk2(bflo(qw.w) * e[6], bfhi(qw.w) * e[7]);
            *(u32x4*)(QdS + j * 136 + k8) = w;
            w.x = pk2(bflo(kw.x) * ei[0], bfhi(kw.x) * ei[1]); w.y = pk2(bflo(kw.y) * ei[2], bfhi(kw.y) * ei[3]); w.z = pk2(bflo(kw.z) * ei[4], bfhi(kw.z) * ei[5]); w.w = pk2(bflo(kw.w) * ei[6], bfhi(kw.w) * ei[7]);
            *(u32x4*)(KxS + j * 136 + k8) = w;
            *(u32x4*)(VS + j * 136 + k8) = vr[i];
        }
#pragma unroll
        for (int i = 0; i < 4; ++i) { const int idx = tid + 512 * i, v = idx >> 4, c8 = (idx & 15) * 8; *(u32x4*)(SS + v * 136 + c8) = sr[i]; }
        __syncthreads();
        if (it + G < N_OUT) HO_LOAD(it + G);
        const int i16 = lane & 15, g = lane >> 4, q = i16 >> 2, p = i16 & 3, tt = wid & 3, vh = wid >> 2;
        u32x2 ogr[4];
#pragma unroll
        for (int vt = 0; vt < 4; ++vt) ogr[vt] = *(const u32x2*)(OG + (size_t)(16 * tt + i16) * 128 + vh * 64 + 16 * vt + 4 * g);
        bf16x8 bq[4];
#pragma unroll
        for (int kc = 0; kc < 4; ++kc) bq[kc] = *(const bf16x8*)(QdS + (16 * tt + i16) * 136 + 32 * kc + 8 * g);
        f32x4 sc[4];
#pragma unroll
        for (int jt = 0; jt < 4; ++jt) {
            f32x4 sv = {0.f, 0.f, 0.f, 0.f};
            if (jt <= tt) {
#pragma unroll
                for (int kc = 0; kc < 4; ++kc) sv = MFMA16(*(const bf16x8*)(KxS + (16 * jt + i16) * 136 + 32 * kc + 8 * g), bq[kc], sv);
                if (jt == tt) {
#pragma unroll
                    for (int r = 0; r < 4; ++r) sv[r] = (4 * g + r > i16) ? 0.f : sv[r];
                }
            }
            sc[jt] = sv;
        }
        bf16x8 pb[2];
        pb[0] = pk8(sc[0], sc[1]); pb[1] = pk8(sc[2], sc[3]);
        f32x4 acc[4]; float ss = 0.f;
#pragma unroll
        for (int vt = 0; vt < 4; ++vt) {
            const int v0 = vh * 64 + 16 * vt;
            f32x4 c = {0.f, 0.f, 0.f, 0.f};
#pragma unroll
            for (int kc = 0; kc < 4; ++kc) c = MFMA16(*(const bf16x8*)(SS + (v0 + i16) * 136 + 32 * kc + 8 * g), bq[kc], c);
#pragma unroll
            for (int jc = 0; jc < 2; ++jc) {
                const bf16x8 av = cat8(tr_read(VS + (32 * jc + 4 * g + q) * 136 + v0 + 4 * p), tr_read(VS + (32 * jc + 16 + 4 * g + q) * 136 + v0 + 4 * p));
                c = MFMA16(av, pb[jc], c);
            }
            acc[vt] = c; ss += (c[0] * c[0] + c[1] * c[1]) + (c[2] * c[2] + c[3] * c[3]);
        }
        ss += __shfl_xor(ss, 16); ss += __shfl_xor(ss, 32);
        if (g == 0) red[vh * 64 + 16 * tt + i16] = ss;
        __syncthreads();
        const float rstd = __builtin_amdgcn_rsqf((red[16 * tt + i16] + red[64 + 16 * tt + i16]) * (1.f / 128.f) + EPS);
#pragma unroll
        for (int vt = 0; vt < 4; ++vt) {
            const int col = vh * 64 + 16 * vt + 4 * g; const size_t t = (size_t)(16 * tt + i16);
            const u32x2 ow = ogr[vt]; const f32x4 nw = *(const f32x4*)(a.hgrn_norm_w + h * 128 + col);
            u32x2 w; w.x = pk2(acc[vt][0] * rstd * nw[0] * bflo(ow.x), acc[vt][1] * rstd * nw[1] * bfhi(ow.x)); w.y = pk2(acc[vt][2] * rstd * nw[2] * bflo(ow.y), acc[vt][3] * rstd * nw[3] * bfhi(ow.y));
            *(u32x2*)(YA + t * 512 + col) = w;
        }
        __syncthreads();
    }
#undef HO_LOAD
}

__device__ __forceinline__ void hgrn_sample_item(const Args& a, int b, int h, unsigned char* lds) {
    const int tid = threadIdx.x, lane = tid & 63, wid = tid >> 6;
    float* part = (float*)lds;
    float* wsum = (float*)(lds + 32768);
    unsigned char* ws = a.ws;
    const int v4 = (tid & 31) * 4, kg = tid >> 5;
    const float* S0 = a.state_hgrn + ((size_t)(b * 4 + h) * 128 + 8 * kg) * 128 + v4;
    float* S1 = a.out + O_SS + ((size_t)(b * 4 + h) * 128 + 8 * kg) * 128 + v4;
    f32x4 S[8];
#pragma unroll
    for (int e = 0; e < 8; ++e) S[e] = *(const f32x4*)(S0 + e * 128);
    const size_t rb = (size_t)MP + (size_t)b * 4;
#pragma unroll
    for (int t = 0; t < 4; ++t) {
        const size_t off = ((size_t)h * MT + rb + t) * 128;
        const f32x4 g0 = *(const f32x4*)((const float*)(ws + WS_R3) + off + 8 * kg), g1 = *(const f32x4*)((const float*)(ws + WS_R3) + off + 8 * kg + 4);
        const u32x4 kw = *(const u32x4*)((const bf16*)(ws + WS_R2) + off + 8 * kg), qw = *(const u32x4*)((const bf16*)(ws + WS_R1) + off + 8 * kg);
        const u32x2 vw = *(const u32x2*)((const bf16*)(ws + WS_R4) + off + v4);
        const f32x4 vv = {bflo(vw.x), bfhi(vw.x), bflo(vw.y), bfhi(vw.y)};
        const float f[8] = {__expf(g0[0]), __expf(g0[1]), __expf(g0[2]), __expf(g0[3]), __expf(g1[0]), __expf(g1[1]), __expf(g1[2]), __expf(g1[3])};
        const float kk[8] = {bflo(kw.x), bfhi(kw.x), bflo(kw.y), bfhi(kw.y), bflo(kw.z), bfhi(kw.z), bflo(kw.w), bfhi(kw.w)};
        const float qq[8] = {bflo(qw.x), bfhi(qw.x), bflo(qw.y), bfhi(qw.y), bflo(qw.z), bfhi(qw.z), bflo(qw.w), bfhi(qw.w)};
        f32x4 po = {0.f, 0.f, 0.f, 0.f};
#pragma unroll
        for (int e = 0; e < 8; ++e) { S[e] = f[e] * S[e] + kk[e] * vv; po += qq[e] * S[e]; }
        *(f32x4*)(part + (t * 16 + kg) * 128 + v4) = po;
    }
#pragma unroll
    for (int e = 0; e < 8; ++e) *(f32x4*)(S1 + e * 128) = S[e];
    __syncthreads();
    const int t = tid >> 7, v = tid & 127;
    float o = 0.f;
#pragma unroll
    for (int k = 0; k < 16; ++k) o += part[(t * 16 + k) * 128 + v];
    const float s2 = wave_sum(o * o);
    if (lane == 0) wsum[wid] = s2;
    __syncthreads();
    const float rstd = __builtin_amdgcn_rsqf((wsum[2 * t] + wsum[2 * t + 1]) * (1.f / 128.f) + EPS);
    const float y = o * rstd * a.hgrn_norm_w[h * 128 + v] * bf2f(((const bf16*)(ws + WS_R5))[((size_t)h * MT + rb + t) * 128 + v]);
    ((bf16*)(ws + WS_YAS))[((size_t)b * 4 + t) * 512 + h * 128 + v] = (bf16)(pk2(y, 0.f) & 0xffffu);
    __syncthreads();
}


template <int K, int LDW = K> __device__ __forceinline__ f32x4 mini_gemm(const bf16* __restrict__ X, const bf16* __restrict__ W, unsigned char* lds, f32x4 acc) {
    const int tid = threadIdx.x, lane = tid & 63, wid = tid >> 6, i16 = lane & 15, g = lane >> 4, rw = wid & 1, cw = wid >> 1;
    const int sr = tid >> 5, sc = (tid & 31) * 8;
    constexpr int NT = K / 256, P = 264, XB_ = 32 * P * 2, BUF = (32 + 64) * P * 2;
    static_assert(K % 256 == 0, "mini_gemm: K must be a multiple of 256");
    const bf16* xp = X + (size_t)sr * K + sc; const bf16* wp = W + (size_t)sr * LDW + sc;
    u32x4 xr[2], wv[4];
#pragma unroll
    for (int i = 0; i < 2; ++i) xr[i] = *(const u32x4*)(xp + (size_t)(16 * i) * K);
#pragma unroll
    for (int i = 0; i < 4; ++i) wv[i] = *(const u32x4*)(wp + (size_t)(16 * i) * LDW);
    __syncthreads();
#pragma unroll 1
    for (int kt = 0; kt < NT; ++kt) {
        unsigned char* b = lds + (kt & 1) * BUF;
#pragma unroll
        for (int i = 0; i < 2; ++i) *(u32x4*)(b + ((sr + 16 * i) * P + sc) * 2) = xr[i];
#pragma unroll
        for (int i = 0; i < 4; ++i) *(u32x4*)(b + XB_ + ((sr + 16 * i) * P + sc) * 2) = wv[i];
        __syncthreads();
        if (kt + 1 < NT) {
#pragma unroll
            for (int i = 0; i < 2; ++i) xr[i] = *(const u32x4*)(xp + (size_t)(16 * i) * K + 256 * (kt + 1));
#pragma unroll
            for (int i = 0; i < 4; ++i) wv[i] = *(const u32x4*)(wp + (size_t)(16 * i) * LDW + 256 * (kt + 1));
        }
        const bf16* xs = (const bf16*)b + (16 * rw + i16) * P + 8 * g; const bf16* wsm = (const bf16*)(b + XB_) + (16 * cw + i16) * P + 8 * g;
#pragma unroll
        for (int kc = 0; kc < 8; ++kc) acc = MFMA16(*(const bf16x8*)(wsm + 32 * kc), *(const bf16x8*)(xs + 32 * kc), acc);
    }
    return acc;
}
#define SAMPLE_TILE_VARS const int lane = threadIdx.x & 63, wid = threadIdx.x >> 6, i16 = lane & 15, g = lane >> 4; \
    const int row0 = MP + 32 * (tile & 15), colb = 64 * (tile >> 4), row = row0 + 16 * (wid & 1) + i16, col0 = colb + 16 * (wid >> 1); const size_t off = (size_t)row * 1024 + col0 + 4 * g
__device__ __forceinline__ void p5_sample(const Args& a, unsigned char* lds) {
    unsigned char* ws = a.ws;
    for (int tile = blockIdx.x; tile < 256; tile += gridDim.x) {
        SAMPLE_TILE_VARS;
        const f32x4 z = {0.f, 0.f, 0.f, 0.f};
        const f32x4 pa = mini_gemm<512, 1024>((const bf16*)(ws + WS_YAS) + (size_t)(row0 - MP) * 512, (const bf16*)(ws + WS_WOH) + (size_t)colb * 1024, lds, z);
        const f32x4 pb = mini_gemm<512, 1024>((const bf16*)(ws + WS_R10) + (size_t)row0 * 512, (const bf16*)(ws + WS_WOH) + (size_t)colb * 1024 + 512, lds, z);
        const u32x2 ga = *(const u32x2*)((const bf16*)(ws + WS_R8) + off), gb = *(const u32x2*)((const bf16*)(ws + WS_R9) + off);
        u32x2 w; w.x = pk2(bflo(gb.x) * (bflo(ga.x) * pa[0] + pb[0]), bfhi(gb.x) * (bfhi(ga.x) * pa[1] + pb[1])); w.y = pk2(bflo(gb.y) * (bflo(ga.y) * pa[2] + pb[2]), bfhi(gb.y) * (bfhi(ga.y) * pa[3] + pb[3]));
        *(u32x2*)((bf16*)(ws + WS_R3) + off) = w;
    }
    __syncthreads();
}
__device__ __forceinline__ void p6_sample(const Args& a, unsigned char* lds) {
    unsigned char* ws = a.ws;
    for (int tile = blockIdx.x; tile < 256; tile += gridDim.x) {
        SAMPLE_TILE_VARS;
        const f32x4 z = {0.f, 0.f, 0.f, 0.f};
        const f32x4 p = mini_gemm<1024>((const bf16*)(ws + WS_R3) + (size_t)row0 * 1024, (const bf16*)(ws + WS_WOUT) + (size_t)colb * 1024, lds, z);
        const f32x4 v = p + *(const f32x4*)(a.x_sample + off - (size_t)MP * 1024);
        u32x2 w; w.x = pk2(v[0], v[1]); w.y = pk2(v[2], v[3]);
        *(u32x2*)((bf16*)(ws + WS_R8) + off) = w;
        float ss = (v[0] * v[0] + v[1] * v[1]) + (v[2] * v[2] + v[3] * v[3]);
        ss += __shfl_xor(ss, 16); ss += __shfl_xor(ss, 32);
        if (g == 0) atomicAdd((float*)(ws + WS_SUMSQ) + row, ss);
    }
    __syncthreads();
}
__device__ __forceinline__ void p8_sample(const Args& a, unsigned char* lds) {
    unsigned char* ws = a.ws;
    for (int tile = blockIdx.x; tile < 256; tile += gridDim.x) {
        SAMPLE_TILE_VARS;
        const f32x4 z = {0.f, 0.f, 0.f, 0.f};
        const f32x4 p = mini_gemm<DFF>((const bf16*)(ws + WS_R0) + (size_t)row0 * DFF, (const bf16*)(ws + WS_WD) + (size_t)colb * DFF, lds, z);
        const u32x2 xw = *(const u32x2*)((const bf16*)(ws + WS_R8) + off);
        *(f32x4*)(a.out + O_Y + off) = (f32x4){p[0] + bflo(xw.x), p[1] + bfhi(xw.x), p[2] + bflo(xw.y), p[3] + bfhi(xw.y)};
    }
    __syncthreads();
}
#define XB_TMO      128
#define XB_XCNT(j)  (256  + 64 * (j))
#define XB_XSUB(j)  (1280 + 64 * (j))
#define XB_XGEN(j)  (2304 + 64 * (j))
#define XB_TOP      3328
#define XB_TOPGEN   3392
#define XCD_BAR_WORDS 3456
#define XB_SPIN_CAP (1u << 18)

__device__ __forceinline__ unsigned xb_ld(unsigned* p)              { return __hip_atomic_load(p, __ATOMIC_RELAXED, __HIP_MEMORY_SCOPE_AGENT); }
__device__ __forceinline__ unsigned xb_add(unsigned* p, unsigned v) { return __hip_atomic_fetch_add(p, v, __ATOMIC_RELAXED, __HIP_MEMORY_SCOPE_AGENT); }
__device__ __forceinline__ unsigned xb_xcc_id() { return (unsigned)__builtin_amdgcn_s_getreg((3 << 11) | 20) & 0xFu; }
#define XB_SPIN(cond, bar) do { unsigned _sp = 0; while (cond) { __builtin_amdgcn_s_sleep(1); \
    if ((++_sp & 255u) == 0u) { if (xb_ld(&(bar)[XB_TMO])) break; if (_sp > XB_SPIN_CAP) { atomicAdd(&(bar)[XB_TMO], 1u); break; } } } } while (0)

struct XcdBarrier {
    unsigned* bar; unsigned x;
    volatile LAS unsigned* st;
};

__device__ __forceinline__ XcdBarrier xcd_barrier_post(unsigned* bar, volatile LAS unsigned* st) {
    XcdBarrier b; b.bar = bar; b.x = xb_xcc_id(); b.st = st;
    if (threadIdx.x == 0) (void)xb_add(&bar[XB_XCNT(b.x)], 1u);
    return b;
}
__device__ __forceinline__ void xcd_barrier_complete(unsigned* bar, unsigned x, unsigned& nloc, unsigned& nx) {
    const unsigned G = gridDim.x * gridDim.y * gridDim.z;
    unsigned sum, cnt, mine, sp = 0u;
    for (;;) {
        sum = 0u; cnt = 0u; mine = 0u;
#pragma unroll
        for (unsigned j = 0; j < 16; ++j) { const unsigned c = xb_ld(&bar[XB_XCNT(j)]); sum += c; cnt += (c > 0u) ? 1u : 0u; mine = (j == x) ? c : mine; }
        if (sum == G) break;
        __builtin_amdgcn_s_sleep(1);
        if ((++sp & 255u) == 0u) { if (xb_ld(&bar[XB_TMO])) break; if (sp > XB_SPIN_CAP) { atomicAdd(&bar[XB_TMO], 1u); break; } }
    }
    nloc = mine > 0u ? mine : 1u; nx = cnt > 0u ? cnt : 1u;
}

__device__ __forceinline__ void xcd_barrier(const XcdBarrier& b) {
    asm volatile("s_waitcnt vmcnt(0)" ::: "memory");
    __syncthreads();
    if (threadIdx.x == 0) {
        unsigned* bar = b.bar;
        __builtin_amdgcn_s_waitcnt(0);
        unsigned nloc = b.st[0], nx = b.st[1];
        if (nloc == 0u) { xcd_barrier_complete(bar, b.x, nloc, nx); b.st[0] = nloc; b.st[1] = nx; }
        const unsigned old = xb_add(&bar[XB_XSUB(b.x)], 1u);
        const unsigned gen = old / nloc;
        if (old + 1u == (gen + 1u) * nloc) {
            __builtin_amdgcn_fence(__ATOMIC_RELEASE, "agent");
            asm volatile("s_waitcnt vmcnt(0)" ::: "memory");
            const unsigned og = xb_add(&bar[XB_TOP], 1u);
            const unsigned tg = og / nx;
            if (og + 1u == (tg + 1u) * nx) xb_add(&bar[XB_TOPGEN], 1u);
            else XB_SPIN(xb_ld(&bar[XB_TOPGEN]) == tg, bar);
            __builtin_amdgcn_fence(__ATOMIC_ACQUIRE, "agent");
            xb_add(&bar[XB_XGEN(b.x)], 1u);
            asm volatile("s_waitcnt vmcnt(0)" ::: "memory");
        } else {
            XB_SPIN(xb_ld(&bar[XB_XGEN(b.x)]) == gen, bar);
            __builtin_amdgcn_fence(__ATOMIC_ACQUIRE, "agent");
            asm volatile("s_waitcnt vmcnt(0)" ::: "memory");
        }
    }
    __syncthreads();
}


#ifndef PG_ALIGN_BIG
#define PG_ALIGN_BIG true
#endif
#ifndef PG_ALIGN_N1K
#define PG_ALIGN_N1K true
#endif
__global__ void __launch_bounds__(NTHREADS, 2) mk_fwd(Args a) {
    extern __shared__ __attribute__((aligned(16))) unsigned char lds[];
    cg::grid_group grid = cg::this_grid();
    const int lo = a.ph_lo, hi = a.ph_hi, G = gridDim.x, bid = blockIdx.x;
    unsigned char* ws = a.ws;
    LAS unsigned char* ring = (LAS unsigned char*)(LAS void*)lds;
#ifdef PH_MASK
#define IN(k) (((PH_MASK) >> (k)) & 1)
#else
#define IN(k) (lo <= (k) && (k) < hi)
#endif
#ifdef TPROBE_A
#define STAMP(k) do { if (bid == 0 && threadIdx.x == 0) ((volatile unsigned long long*)(lds + 131072 + 64))[k] = __builtin_amdgcn_s_memrealtime(); } while (0)
#else
#define STAMP(k) do { } while (0)
#endif
    if (threadIdx.x < 2) ((volatile LAS unsigned*)(LAS void*)(lds + LDS_BYTES))[threadIdx.x] = 0u;
    __syncthreads();
    XcdBarrier xbar = xcd_barrier_post((unsigned*)(ws + WS_BAR), (volatile LAS unsigned*)(LAS void*)(lds + LDS_BYTES));
#define SEAM(k) do { if (IN(k) && IN((k) + 1)) { if (hi > 1000) grid.sync(); else xcd_barrier(xbar); } STAMP((k) + 1); } while (0)
    STAMP(0);

    constexpr int P1_NWG = (MT / 256) * (PW / 256);
    const int p1_rem = P1_NWG % G;
    if (IN(0)) { p0_prologue(a, lds, (p1_rem != 0 && IN(1)) ? P0_I1 : P0_NITEMS); }
    SEAM(0);
    if (IN(1)) {
        pg8::Gemm g{(const bf16*)(ws + WS_R0), (const bf16*)(ws + WS_W1T), MT, PW, 1024}; pg8::StaticOrder S; S.init(MT, PW, G, bid);
        pg8::EpiProj E{(bf16*)(ws + WS_R1), (bf16*)(ws + WS_R2), (bf16*)(ws + WS_R4), (bf16*)(ws + WS_R5), (bf16*)(ws + WS_R6), (bf16*)(ws + WS_R7), (bf16*)(ws + WS_R8), (bf16*)(ws + WS_R9),
                       (float*)(ws + WS_R3), (const float*)(ws + WS_LBV)};
        pg8::gemm_phase<pg8::EpiProj, pg8::StaticOrder, PG_ALIGN_BIG, true>(ring, g, S, E);
        if (p1_rem != 0 && IN(0) && bid >= p1_rem) p0_weights(a, lds, P0_I1, P0_NITEMS, (bid - p1_rem) * 8 + (int)(threadIdx.x >> 6), (G - p1_rem) * 8);
    }
    SEAM(1);
    if (IN(2)) { hgrn_local_phase(a, lds); }
    SEAM(2);
    if (IN(3)) {
        constexpr int N_ATT = 4 * 64 * 2, N_SAT = DEC_B;
        const int ns = (G >= 128) ? 64 : 0;
        if (G == 256) {
            if (bid < ns) {
                hgrn_scan(a, bid, ns, lds); STAMP(10);
                __syncthreads();
                { const int r = 448 + bid; attn_prompt_item(a, r >> 7, (r >> 1) & 63, r & 1, lds); }
                for (int r = 320 + 3 * bid; r < 320 + 3 * bid + 3; ++r) hgrn_sample_item(a, r >> 2, r & 3, lds);
            } else {
                const int j = bid - ns;
                if (j < 128) { attn_sample_item(a, j, lds);
                    for (int r = 2 * j; r < 2 * j + 2; ++r) attn_prompt_item(a, r >> 7, (r >> 1) & 63, r & 1, lds);
                    for (int r = 2 * j; r < 2 * j + 2; ++r) hgrn_sample_item(a, r >> 2, r & 3, lds); }
                else { for (int r = 256 + 3 * (j - 128); r < 256 + 3 * (j - 128) + 3; ++r) attn_prompt_item(a, r >> 7, (r >> 1) & 63, r & 1, lds);
                    { const int r = 256 + (j - 128); hgrn_sample_item(a, r >> 2, r & 3, lds); } }
            }
        } else {
            if (ns == 0) hgrn_scan(a, bid, G, lds); else if (bid < ns) hgrn_scan(a, bid, ns, lds);
            __syncthreads();
            if (bid >= ns) {
                for (int it = bid - ns; it < N_ATT + N_SAT; it += G - ns) {
                    if (it < N_ATT) attn_prompt_item(a, it >> 7, (it >> 1) & 63, it & 1, lds);
                    else attn_sample_item(a, it - N_ATT, lds);
                }
                for (int r = bid - ns; r < DEC_B * 4; r += G - ns) hgrn_sample_item(a, r >> 2, r & 3, lds);
            }
        }
    }
    SEAM(3);
    if (IN(4)) {
        hgrn_out_phase(a, lds);
    }
    SEAM(4);
    if (IN(5)) {
        p5_sample(a, lds);
        pg8::StaticOrder S; S.init(MP, 1024, G, bid);
        pg8::Gemm g{(const bf16*)(ws + WS_R6), (const bf16*)(ws + WS_WOH), MP, 1024, 1024, (const bf16*)(ws + WS_R10), 512, 8};
        pg8::EpiMerge E{(const bf16*)(ws + WS_R8), (const bf16*)(ws + WS_R9), (bf16*)(ws + WS_R3)};
        pg8::gemm_phase<pg8::EpiMerge, pg8::StaticOrder, PG_ALIGN_N1K, true, true>(ring, g, S, E);
    }
    SEAM(5);
    if (IN(6)) {
        p6_sample(a, lds);
        pg8::Gemm g{(const bf16*)(ws + WS_R3), (const bf16*)(ws + WS_WOUT), MP, 1024, 1024}; pg8::StaticOrder S; S.init(MP, 1024, G, bid);
        pg8::EpiRes1 E{a.x_prompt, (bf16*)(ws + WS_R8), (float*)(ws + WS_SUMSQ)};
        pg8::gemm_phase<pg8::EpiRes1, pg8::StaticOrder, PG_ALIGN_N1K, true>(ring, g, S, E);
    }
    SEAM(6);
    if (IN(7)) {
        pg8::Gemm g{(const bf16*)(ws + WS_R8), (const bf16*)(ws + WS_WGU), MT, 2 * DFF, 1024}; pg8::StaticOrder S; S.init(MT, 2 * DFF, G, bid);
        pg8::EpiFfn E{(const float*)(ws + WS_SUMSQ), (bf16*)(ws + WS_R0)};
        pg8::gemm_phase<pg8::EpiFfn, pg8::StaticOrder, PG_ALIGN_BIG, true>(ring, g, S, E);
    }
    SEAM(7);
    if (IN(8)) {
        p8_sample(a, lds);
        pg8::Gemm g{(const bf16*)(ws + WS_R0), (const bf16*)(ws + WS_WD), MP, 1024, DFF}; pg8::StaticOrder S; S.init(MP, 1024, G, bid);
        pg8::EpiRes2 E{(const bf16*)(ws + WS_R8), a.out + O_Y};
        pg8::gemm_phase<pg8::EpiRes2, pg8::StaticOrder, PG_ALIGN_N1K, true>(ring, g, S, E);
    }
#ifdef TPROBE_A
    {
        grid.sync(); STAMP(9);
        unsigned long long* pw = (unsigned long long*)(ws + WS_MISC + 2048);
        if (bid == 0 && threadIdx.x == 0) { volatile unsigned long long* t = (volatile unsigned long long*)(lds + 131072 + 64);
            pw[0] = (TPROBE_A >= 0) ? t[TPROBE_A + 1] - t[TPROBE_A] : 0ull; pw[1] = (TPROBE_B == 10) ? t[10] - t[3] : t[TPROBE_B + 1] - t[TPROBE_B]; __threadfence(); }
        grid.sync();
        const unsigned long long dA = __hip_atomic_load(pw, __ATOMIC_RELAXED, __HIP_MEMORY_SCOPE_AGENT), dB = __hip_atomic_load(pw + 1, __ATOMIC_RELAXED, __HIP_MEMORY_SCOPE_AGENT);
        const float eps = sqrtf(2e-5f + (float)dB * 0.01f * (float)(TPROBE_KB));
        f32x4* cvs = (f32x4*)(a.out + O_VS);
        for (int i = bid * NTHREADS + threadIdx.x; i < 128 * 128 * 128 / 4; i += G * NTHREADS) cvs[i] = cvs[i] * (1.f + eps);
        const unsigned long long t0 = __builtin_amdgcn_s_memrealtime();
        while (__builtin_amdgcn_s_memrealtime() - t0 < 4ull * dA) __builtin_amdgcn_s_sleep(8);
    }
#endif
#undef IN
#undef SEAM
}

__global__ void dump_ws(const unsigned short* w, float* o, size_t n, size_t tot) {
    for (size_t i = blockIdx.x * (size_t)blockDim.x + threadIdx.x; i < n; i += (size_t)gridDim.x * blockDim.x) { unsigned s = 0; for (size_t j = i; j < tot; j += n) s += w[j]; o[i] = (float)s; }
}
constexpr int N_PHASES = 9;
extern "C" void kernel_launch(void* const* d_in, const int* in_sizes, int n_in, void* d_out, int out_size, void* d_ws, size_t ws_size, hipStream_t stream) {
    static int grid = 0;
    if (grid == 0) {
        if (n_in != 19 || (size_t)out_size != O_END || ws_size < WS_END) { fprintf(stderr, "kernel_launch: unexpected shapes: n_in %d out %d ws %zu (need %zu)\n", n_in, out_size, ws_size, (size_t)WS_END); grid = -1; return; }
        int dev = 0, cus = 0, per_cu = 0;
        if (hipGetDevice(&dev) != hipSuccess || hipDeviceGetAttribute(&cus, hipDeviceAttributeMultiprocessorCount, dev) != hipSuccess) { grid = -1; return; }
        if (hipFuncSetAttribute((const void*)mk_fwd, hipFuncAttributeMaxDynamicSharedMemorySize, LDS_TOTAL) != hipSuccess) { fprintf(stderr, "kernel_launch: hipFuncSetAttribute failed\n"); grid = -1; return; }
        if (hipOccupancyMaxActiveBlocksPerMultiprocessor(&per_cu, (const void*)mk_fwd, NTHREADS, LDS_TOTAL) != hipSuccess || per_cu < 1) { fprintf(stderr, "kernel_launch: occupancy query says %d\n", per_cu); (void)hipGetLastError(); grid = -1; return; }
        grid = cus;
    }
    if (grid < 0) return;
    Args a{};
    const float** ap = (const float**)&a;
    for (int i = 0; i < 19; ++i) ap[i] = (const float*)d_in[i];
    a.out = (float*)d_out; a.ws = (unsigned char*)d_ws;
#if MK_N_LAUNCHES == 1
    if (hipMemsetAsync((char*)d_ws + WS_BAR, 0, XCD_BAR_WORDS * 4, stream) != hipSuccess) { fprintf(stderr, "kernel_launch: memset of the barrier words failed\n"); return; }
    a.ph_lo = 0; a.ph_hi = N_PHASES;
    void* args[] = {&a};
    hipError_t e = hipLaunchCooperativeKernel((const void*)mk_fwd, dim3(grid), dim3(NTHREADS), args, LDS_TOTAL, stream);
    if (e != hipSuccess) fprintf(stderr, "kernel_launch: cooperative launch failed: %s (grid %d)\n", hipGetErrorString(e), grid);
#else
#ifndef PROBE_K
#define PROBE_K 8
#endif
    for (int ph = 0; ph <= PROBE_K; ++ph) {
        a.ph_lo = ph; a.ph_hi = ph + 1;
        hipLaunchKernelGGL(mk_fwd, dim3(grid), dim3(NTHREADS), LDS_TOTAL, stream, a);
    }
#if PROBE_K < 8
    hipLaunchKernelGGL(dump_ws, dim3(2048), dim3(256), 0, stream, (const unsigned short*)d_ws, (float*)d_out, (size_t)out_size, (size_t)(WS_END / 2));
#endif
#endif
}
```

```cpp
#include <hip/hip_runtime.h>
#include <hip/hip_cooperative_groups.h>
#include <cstdio>
#include <cstdint>
namespace cg = cooperative_groups;

#ifndef MK_N_LAUNCHES
#define MK_N_LAUNCHES 1
#endif

constexpr int DM = 1024, SEQ = 8192, NBATCH = 4, MP = NBATCH * SEQ, DEC_B = 128, DEC_T = 4, MS = DEC_B * DEC_T, MT = MP + MS;
constexpr int PW = 4864, DFF = 2816;
constexpr float EPS = 1e-6f;

constexpr size_t UB = (size_t)MT * 512 * 2;
constexpr size_t WS_W1T = 0;
constexpr size_t WS_WOH = WS_W1T + (size_t)PW * DM * 2;
constexpr size_t WS_WOA = WS_WOH + (size_t)1024 * 512 * 2;
constexpr size_t WS_WOUT = WS_WOA + (size_t)1024 * 512 * 2;
constexpr size_t WS_WGU = WS_WOUT + (size_t)1024 * 1024 * 2;
constexpr size_t WS_WD = WS_WGU + (size_t)2 * DFF * DM * 2;
constexpr size_t WS_MISC = WS_WD + (size_t)DM * DFF * 2;
constexpr size_t WS_LBV = WS_MISC;
constexpr size_t WS_SUMSQ = WS_MISC + 4096;
constexpr size_t WS_DT = WS_MISC + 512 * 1024;
constexpr size_t WS_BAR = WS_MISC + 1536 * 1024;
constexpr size_t WS_R0 = (size_t)32 << 20;
constexpr size_t WS_R1 = WS_R0 + 2 * UB;
constexpr size_t WS_R2 = WS_R1 + UB;
constexpr size_t WS_R3 = WS_R2 + UB;
constexpr size_t WS_R4 = WS_R3 + 2 * UB;
constexpr size_t WS_R5 = WS_R4 + UB;
constexpr size_t WS_R6 = WS_R5 + UB;
constexpr size_t WS_R7 = WS_R6 + UB;
constexpr size_t WS_R8 = WS_R7 + UB / 2;
constexpr size_t WS_R9 = WS_R8 + 2 * UB;
constexpr size_t WS_R10 = WS_R9 + 2 * UB;
constexpr size_t WS_YAS = WS_R10 + UB;
constexpr size_t WS_END = WS_YAS + (size_t)MS * 512 * 2;
static_assert(WS_MISC == ((size_t)30 << 20) && WS_END <= ((size_t)512 << 20), "d_ws map");
static_assert((size_t)MT * DFF * 2 <= 6 * UB, "ACT fits R0..R3");

constexpr size_t O_Y = 0;
constexpr size_t O_SP = (size_t)MT * DM;
constexpr size_t O_KP = O_SP + (size_t)4 * 4 * 128 * 128;
constexpr size_t O_VP = O_KP + (size_t)4 * 128 * 128;
constexpr size_t O_SS = O_VP + (size_t)4 * 128 * 128;
constexpr size_t O_KS = O_SS + (size_t)128 * 4 * 128 * 128;
constexpr size_t O_VS = O_KS + (size_t)128 * 128 * 128;
constexpr size_t O_END = O_VS + (size_t)128 * 128 * 128;

constexpr int LDS_BYTES = 131072;
constexpr int LDS_TOTAL = LDS_BYTES + 256;
constexpr int NTHREADS = 512;

#define LAS __attribute__((address_space(3)))
typedef unsigned short bf16;
typedef float f32x4 __attribute__((ext_vector_type(4)));
typedef float f32x2 __attribute__((ext_vector_type(2)));
typedef unsigned u32x4 __attribute__((ext_vector_type(4)));
typedef unsigned u32x2 __attribute__((ext_vector_type(2)));
typedef short bf16x8 __attribute__((ext_vector_type(8)));
typedef short s16x4 __attribute__((ext_vector_type(4)));
typedef _Float16 h16x8 __attribute__((ext_vector_type(8)));
typedef float f32x8 __attribute__((ext_vector_type(8)));

__device__ __forceinline__ float bf2f(unsigned short u) { return __uint_as_float((unsigned)u << 16); }
__device__ __forceinline__ float bflo(unsigned w) { return __uint_as_float(w << 16); }
__device__ __forceinline__ float bfhi(unsigned w) { return __uint_as_float(w & 0xffff0000u); }
typedef __bf16 bf16x2_t __attribute__((ext_vector_type(2)));
__device__ __forceinline__ unsigned pk2(float lo, float hi) { f32x2 v = {lo, hi}; bf16x2_t b = __builtin_convertvector(v, bf16x2_t); return __builtin_bit_cast(unsigned, b); }
__device__ __forceinline__ float sigm(float x) { return __builtin_amdgcn_rcpf(1.f + __expf(-x)); }
__device__ __forceinline__ s16x4 tr_read(const bf16* p) {
    return __builtin_bit_cast(s16x4, __builtin_amdgcn_ds_read_tr16_b64_v4i16((LAS s16x4*)(LAS void*)p));
}
__device__ __forceinline__ bf16x8 cat8(s16x4 a, s16x4 b) { return (bf16x8){a[0], a[1], a[2], a[3], b[0], b[1], b[2], b[3]}; }
__device__ __forceinline__ bf16x8 pk8(f32x4 a, f32x4 b) { u32x4 w; w.x = pk2(a[0], a[1]); w.y = pk2(a[2], a[3]); w.z = pk2(b[0], b[1]); w.w = pk2(b[2], b[3]); return __builtin_bit_cast(bf16x8, w); }
#define MFMA16(a, b, c) __builtin_amdgcn_mfma_f32_16x16x32_bf16((a), (b), (c), 0, 0, 0)

namespace pg8 {
#define PG8_LAS __attribute__((address_space(3)))
typedef unsigned short bf16_t;
typedef short bf16x8 __attribute__((ext_vector_type(8)));
typedef float f32x4 __attribute__((ext_vector_type(4)));
typedef unsigned u32x4 __attribute__((ext_vector_type(4)));
constexpr int BM = 256, BK = 64, HALF = 128, HTB = HALF * BK * 2  , STAGE_BYTES = 8 * HTB, NXCD = 8, WGM = 8;

__host__ __device__ __forceinline__ int lds_byte(int r, int c) { const int st = (r >> 4) * 2 + (c >> 5), rr = r & 15, cc = c & 31, ob = rr * 64 + cc * 2; return st * 1024 + (ob ^ (((ob >> 9) & 1) << 5)); }
__host__ __device__ __forceinline__ void stage_rc(int b, int& R, int& C) { const int st = b / 1024, sb = b % 1024, swz = sb ^ (((sb >> 9) & 1) << 5); R = (st >> 1) * 16 + swz / 64; C = (st & 1) * 32 + (swz % 64) / 2; }
__host__ __device__ __forceinline__ int perm32(int rho) { const int n = rho >> 4, i = rho & 15; return 8 * (i >> 2) + 4 * n + (i & 3); }

struct Unit { int pm, pn; };
struct Gemm { const bf16_t* A; const bf16_t* Bt; int M, N, K; const bf16_t* A2; int lda, kmid; };

struct StaticOrder {
    int nM, nN, nwg, G, c;
    __host__ __device__ void init(int M, int N, int G_, int c_) { nM = M / BM; nN = N / BM; nwg = nM * nN; G = G_; c = c_; }
    __host__ __device__ bool next(int i, Unit& u) const {
        const long L = (long)i * G + c; if (L >= nwg) return false;
        int wgid = (int)L; { const int q = nwg / NXCD, r = nwg % NXCD, xcd = wgid % NXCD, off = wgid / NXCD; wgid = (xcd < r ? xcd * (q + 1) : r * (q + 1) + (xcd - r) * q) + off; }
        const int nig = WGM * nN, gid = wgid / nig, fm = gid * WGM, gsz = (nM - fm) < WGM ? (nM - fm) : WGM;
        u.pm = fm + ((wgid % nig) % gsz); u.pn = (wgid % nig) / gsz; return true;
    }
    __device__ __forceinline__ void a_ready(const Unit&) const {}
    __device__ __forceinline__ void done(const Unit&) const {}
};

__device__ __forceinline__ unsigned cvt_pk_bf16(float lo, float hi) { unsigned r; asm volatile("v_cvt_pk_bf16_f32 %0, %1, %2" : "=v"(r) : "v"(lo), "v"(hi)); return r; }

__device__ __forceinline__ f32x4 vexp2(f32x4 t) { f32x4 r; r[0] = __builtin_amdgcn_exp2f(t[0]); r[1] = __builtin_amdgcn_exp2f(t[1]); r[2] = __builtin_amdgcn_exp2f(t[2]); r[3] = __builtin_amdgcn_exp2f(t[3]); return r; }
__device__ __forceinline__ f32x4 vrcp(f32x4 t) { f32x4 r; r[0] = __builtin_amdgcn_rcpf(t[0]); r[1] = __builtin_amdgcn_rcpf(t[1]); r[2] = __builtin_amdgcn_rcpf(t[2]); r[3] = __builtin_amdgcn_rcpf(t[3]); return r; }
__device__ __forceinline__ f32x4 vlog2(f32x4 t) { f32x4 r; r[0] = __builtin_amdgcn_logf(t[0]); r[1] = __builtin_amdgcn_logf(t[1]); r[2] = __builtin_amdgcn_logf(t[2]); r[3] = __builtin_amdgcn_logf(t[3]); return r; }
__device__ __forceinline__ f32x4 vsig(f32x4 v) { return vrcp(vexp2(v * -1.4426950408889634f) + 1.f); }
struct EpiProj {
    static constexpr bool PERM = true, AFTER_DRAIN = false; static constexpr size_t MTR = 33280;
    bf16_t *QH, *KH, *VH, *OG, *QA, *KV, *GA, *GB; _Float16* GH; const float* lbv;
    __device__ __forceinline__ void operator()(const f32x4 (&acc)[2][2][4][2], const Unit& u, int wr, int wc, int fr, int fq) const {
        const int pn = u.pn; int mode, ld, cb; bf16_t* dst; float sc = 1.f; bool hm = false;
        if (pn < 2)        { mode = 1; dst = QH; ld = 512;  cb = pn * 256; sc = 0.08838834764831845f; hm = true; }
        else if (pn < 4)   { mode = 3; dst = KH; ld = 512;  cb = (pn - 2) * 256; hm = true; }
        else if (pn < 6)   { mode = 0; dst = VH; ld = 512;  cb = (pn - 4) * 256; hm = true; }
        else if (pn < 8)   { mode = 1; dst = OG; ld = 512;  cb = (pn - 6) * 256; hm = true; }
        else if (pn < 10)  { mode = 0; dst = QA; ld = 512;  cb = (pn - 8) * 256; }
        else if (pn == 10) { mode = 0; dst = KV; ld = 256;  cb = 0; }
        else               { mode = 4; dst = GA; ld = 1024; cb = (pn - 11) * 128; }
        const int row0 = u.pm * BM + wr * 64 + fr, col0 = cb + wc * 32 + 8 * fq;
        if (mode == 4) {
#pragma unroll
            for (int ai = 0; ai < 2; ++ai)
#pragma unroll
                for (int m = 0; m < 4; ++m) {
                    const size_t off = (size_t)(row0 + ai * HALF + m * 16) * 1024 + col0;
                    const f32x4 A0 = vexp2(acc[ai][0][m][0] * -1.4426950408889634f) + 1.f, A1 = vexp2(acc[ai][0][m][1] * -1.4426950408889634f) + 1.f;
                    const f32x4 B0 = vexp2(acc[ai][1][m][0] * -1.4426950408889634f) + 1.f, B1 = vexp2(acc[ai][1][m][1] * -1.4426950408889634f) + 1.f;
                    const f32x4 s0 = vrcp(B0), s1 = vrcp(B1), r0 = B0 * vrcp(A0), r1 = B1 * vrcp(A1);
                    u32x4 w; w.x = pk2(r0[0], r0[1]); w.y = pk2(r0[2], r0[3]); w.z = pk2(r1[0], r1[1]); w.w = pk2(r1[2], r1[3]);
                    *(u32x4*)(GA + off) = w;
                    w.x = pk2(s0[0], s0[1]); w.y = pk2(s0[2], s0[3]); w.z = pk2(s1[0], s1[1]); w.w = pk2(s1[2], s1[3]);
                    *(u32x4*)(GB + off) = w;
                }
            return;
        }
#pragma unroll
        for (int bj = 0; bj < 2; ++bj) {
            const int col = col0 + bj * HALF;
            f32x4 l0 = {0.f, 0.f, 0.f, 0.f}, l1 = l0;
            if (mode == 3) { l0 = *(const f32x4*)(lbv + col); l1 = *(const f32x4*)(lbv + col + 4); }
#pragma unroll
            for (int ai = 0; ai < 2; ++ai)
#pragma unroll
                for (int m = 0; m < 4; ++m) {
                    const size_t row = (size_t)(row0 + ai * HALF + m * 16);
                    f32x4 v0 = acc[ai][bj][m][0], v1 = acc[ai][bj][m][1];
                    if (mode == 1) {
                        v0 = (v0 * sc) * vsig(v0); v1 = (v1 * sc) * vsig(v1);
                    } else if (mode == 3) {
                        const f32x4 f0 = l0 + (1.f - l0) * vsig(v0), f1 = l1 + (1.f - l1) * vsig(v1);
                        const f32x4 g0 = vlog2(f0) * 0.6931471805599453f, g1 = vlog2(f1) * 0.6931471805599453f;
                        v0 = 1.f - f0; v1 = 1.f - f1;
                        const f32x8 g8 = {g0[0], g0[1], g0[2], g0[3], g1[0], g1[1], g1[2], g1[3]};
                        *(h16x8*)(GH + ((size_t)(col >> 7) * MTR + row) * 128 + (col & 127)) = __builtin_convertvector(g8, h16x8);
                    }
                    u32x4 w; w.x = pk2(v0[0], v0[1]); w.y = pk2(v0[2], v0[3]); w.z = pk2(v1[0], v1[1]); w.w = pk2(v1[2], v1[3]);
                    *(u32x4*)(dst + (hm ? ((size_t)(col >> 7) * MTR + row) * 128 + (col & 127) : row * ld + col)) = w;
                }
        }
    }
};
template <bool ADD> struct EpiGate {
    static constexpr bool PERM = true, AFTER_DRAIN = false;
    const bf16_t* gate; const bf16_t* T; bf16_t* O;
    __device__ __forceinline__ void operator()(const f32x4 (&acc)[2][2][4][2], const Unit& u, int wr, int wc, int fr, int fq) const {
        const int row0 = u.pm * BM + wr * 64 + fr, col0 = u.pn * BM + wc * 32 + 8 * fq;
#pragma unroll
        for (int ai = 0; ai < 2; ++ai)
#pragma unroll
            for (int m = 0; m < 4; ++m)
#pragma unroll
                for (int bj = 0; bj < 2; ++bj) {
                    const size_t off = (size_t)(row0 + ai * HALF + m * 16) * 1024 + col0 + bj * HALF;
                    const u32x4 gw = *(const u32x4*)(gate + off);
                    f32x4 v0 = acc[ai][bj][m][0], v1 = acc[ai][bj][m][1];
                    v0[0] *= bflo(gw.x); v0[1] *= bfhi(gw.x); v0[2] *= bflo(gw.y); v0[3] *= bfhi(gw.y);
                    v1[0] *= bflo(gw.z); v1[1] *= bfhi(gw.z); v1[2] *= bflo(gw.w); v1[3] *= bfhi(gw.w);
                    if (ADD) { const u32x4 tw = *(const u32x4*)(T + off);
                        v0[0] += bflo(tw.x); v0[1] += bfhi(tw.x); v0[2] += bflo(tw.y); v0[3] += bfhi(tw.y);
                        v1[0] += bflo(tw.z); v1[1] += bfhi(tw.z); v1[2] += bflo(tw.w); v1[3] += bfhi(tw.w); }
                    u32x4 w; w.x = pk2(v0[0], v0[1]); w.y = pk2(v0[2], v0[3]); w.z = pk2(v1[0], v1[1]); w.w = pk2(v1[2], v1[3]);
                    *(u32x4*)(O + off) = w;
                }
    }
};
struct EpiMerge {
    static constexpr bool PERM = true, AFTER_DRAIN = false;
    const bf16_t* GA; const bf16_t* GB; bf16_t* O;
    __device__ __forceinline__ void mid(f32x4 (&acc)[2][2][4][2], const Unit& u, int wr, int wc, int fr, int fq) const {
        int lane_ = (int)(threadIdx.x & 63); asm volatile("" : "+v"(lane_));
        const int row0 = u.pm * BM + wr * 64 + (lane_ & 15), col0 = u.pn * BM + wc * 32 + 8 * (lane_ >> 4);
#pragma unroll
        for (int ai = 0; ai < 2; ++ai)
#pragma unroll
            for (int m = 0; m < 4; ++m)
#pragma unroll
                for (int bj = 0; bj < 2; ++bj) {
                    const u32x4 a = *(const u32x4*)(GA + (size_t)(row0 + ai * HALF + m * 16) * 1024 + col0 + bj * HALF);
                    acc[ai][bj][m][0] = acc[ai][bj][m][0] * (f32x4){bflo(a.x), bfhi(a.x), bflo(a.y), bfhi(a.y)};
                    acc[ai][bj][m][1] = acc[ai][bj][m][1] * (f32x4){bflo(a.z), bfhi(a.z), bflo(a.w), bfhi(a.w)};
                    if (m == 3 && bj == 1) __builtin_amdgcn_sched_barrier(0);
                }
    }
    __device__ __forceinline__ void operator()(const f32x4 (&acc)[2][2][4][2], const Unit& u, int wr, int wc, int fr, int fq) const {
        const int row0 = u.pm * BM + wr * 64 + fr, col0 = u.pn * BM + wc * 32 + 8 * fq;
#pragma unroll
        for (int ai = 0; ai < 2; ++ai)
#pragma unroll
            for (int m = 0; m < 4; ++m)
#pragma unroll
                for (int bj = 0; bj < 2; ++bj) {
                    const size_t off = (size_t)(row0 + ai * HALF + m * 16) * 1024 + col0 + bj * HALF;
                    const u32x4 gw = *(const u32x4*)(GB + off);
                    const f32x4 v0 = acc[ai][bj][m][0], v1 = acc[ai][bj][m][1];
                    u32x4 w; w.x = pk2(v0[0] * bflo(gw.x), v0[1] * bfhi(gw.x)); w.y = pk2(v0[2] * bflo(gw.y), v0[3] * bfhi(gw.y));
                    w.z = pk2(v1[0] * bflo(gw.z), v1[1] * bfhi(gw.z)); w.w = pk2(v1[2] * bflo(gw.w), v1[3] * bfhi(gw.w));
                    *(u32x4*)(O + off) = w;
                }
    }
};
struct EpiRes1 {
    static constexpr bool PERM = true, AFTER_DRAIN = false;
    const float* xp; bf16_t* X1B; float* sumsq;
    __device__ __forceinline__ void operator()(const f32x4 (&acc)[2][2][4][2], const Unit& u, int wr, int wc, int fr, int fq) const {
        const int row0 = u.pm * BM + wr * 64 + fr, col0 = u.pn * BM + wc * 32 + 8 * fq;
#pragma unroll
        for (int ai = 0; ai < 2; ++ai)
#pragma unroll
            for (int m = 0; m < 4; ++m) {
                const int row = row0 + ai * HALF + m * 16; float ss = 0.f;
#pragma unroll
                for (int bj = 0; bj < 2; ++bj) {
                    const size_t off = (size_t)row * 1024 + col0 + bj * HALF;
                    const f32x4 v0 = acc[ai][bj][m][0] + *(const f32x4*)(xp + off), v1 = acc[ai][bj][m][1] + *(const f32x4*)(xp + off + 4);
                    ss += (v0[0] * v0[0] + v0[1] * v0[1]) + (v0[2] * v0[2] + v0[3] * v0[3]) + (v1[0] * v1[0] + v1[1] * v1[1]) + (v1[2] * v1[2] + v1[3] * v1[3]);
                    u32x4 w; w.x = pk2(v0[0], v0[1]); w.y = pk2(v0[2], v0[3]); w.z = pk2(v1[0], v1[1]); w.w = pk2(v1[2], v1[3]);
                    *(u32x4*)(X1B + off) = w;
                }
                ss += __shfl_xor(ss, 16); ss += __shfl_xor(ss, 32);
                if (fq == 0) atomicAdd(sumsq + row, ss);
            }
    }
};
struct EpiFfn {
    static constexpr bool PERM = true, AFTER_DRAIN = false;
    const float* sumsq; bf16_t* ACT;
    __device__ __forceinline__ void operator()(const f32x4 (&acc)[2][2][4][2], const Unit& u, int wr, int wc, int fr, int fq) const {
        const int row0 = u.pm * BM + wr * 64 + fr, col0 = u.pn * HALF + wc * 32 + 8 * fq;
        float sq[2][4];
#pragma unroll
        for (int ai = 0; ai < 2; ++ai)
#pragma unroll
            for (int m = 0; m < 4; ++m) sq[ai][m] = sumsq[row0 + ai * HALF + m * 16];
#pragma unroll
        for (int ai = 0; ai < 2; ++ai)
#pragma unroll
            for (int m = 0; m < 4; ++m) {
                const int row = row0 + ai * HALF + m * 16;
                const float r = __builtin_amdgcn_rsqf(sq[ai][m] * (1.f / 1024.f) + 1e-6f);
                const float nrl = r * -1.4426950408889634f, r2 = r * r;
                f32x4 o[2];
#pragma unroll
                for (int n = 0; n < 2; ++n) {
                    const f32x4 g = acc[ai][0][m][n], uu = acc[ai][1][m][n];
                    const f32x4 t = g * nrl;
                    f32x4 ex; ex[0] = __builtin_amdgcn_exp2f(t[0]); ex[1] = __builtin_amdgcn_exp2f(t[1]); ex[2] = __builtin_amdgcn_exp2f(t[2]); ex[3] = __builtin_amdgcn_exp2f(t[3]);
                    const f32x4 d = ex + 1.f;
                    f32x4 s; s[0] = __builtin_amdgcn_rcpf(d[0]); s[1] = __builtin_amdgcn_rcpf(d[1]); s[2] = __builtin_amdgcn_rcpf(d[2]); s[3] = __builtin_amdgcn_rcpf(d[3]);
                    o[n] = (g * uu) * (s * r2);
                }
                u32x4 w; w.x = pk2(o[0][0], o[0][1]); w.y = pk2(o[0][2], o[0][3]); w.z = pk2(o[1][0], o[1][1]); w.w = pk2(o[1][2], o[1][3]);
                *(u32x4*)(ACT + (size_t)row * 2816 + col0) = w;
            }
    }
};
struct EpiRes2 {
    static constexpr bool PERM = true, AFTER_DRAIN = false;
    const bf16_t* X1B; float* out;
    __device__ __forceinline__ void operator()(const f32x4 (&acc)[2][2][4][2], const Unit& u, int wr, int wc, int fr, int fq) const {
        const int row0 = u.pm * BM + wr * 64 + fr, col0 = u.pn * BM + wc * 32 + 8 * fq;
#pragma unroll
        for (int ai = 0; ai < 2; ++ai)
#pragma unroll
            for (int m = 0; m < 4; ++m)
#pragma unroll
                for (int bj = 0; bj < 2; ++bj) {
                    const size_t off = (size_t)(row0 + ai * HALF + m * 16) * 1024 + col0 + bj * HALF;
                    const u32x4 xw = *(const u32x4*)(X1B + off);
                    const f32x4 v0 = acc[ai][bj][m][0] + (f32x4){bflo(xw.x), bfhi(xw.x), bflo(xw.y), bfhi(xw.y)}, v1 = acc[ai][bj][m][1] + (f32x4){bflo(xw.z), bfhi(xw.z), bflo(xw.w), bfhi(xw.w)};
                    *(f32x4*)(out + off) = v0; *(f32x4*)(out + off + 4) = v1;
                }
    }
};
template <class Epi, class Sched, bool ALIGN_EPI = false, bool SP2 = false, bool MID = false>
__device__ __forceinline__ void gemm_phase(PG8_LAS unsigned char* lds, const Gemm g, const Sched& S, const Epi& E) {
    const int tid = threadIdx.x, wid = __builtin_amdgcn_readfirstlane(tid >> 6), lane = tid & 63, wr = wid >> 2, wc = wid & 3, fr = lane & 15, fq = lane >> 4;
    const int K = g.K, nt = K / BK;
    const int lda = g.lda ? g.lda : K, kmid = g.kmid ? g.kmid : nt;
    unsigned voffA[2], voffB[2];
#pragma unroll
    for (int i = 0; i < 2; ++i) { int R, C; stage_rc(tid * 16 + i * 8192, R, C); const int Rb = Epi::PERM ? ((R & ~31) + perm32(R & 31)) : R;
        voffA[i] = (unsigned)(R * lda + C) * 2u; voffB[i] = (unsigned)(Rb * K + C) * 2u; }
    const size_t kstep = (size_t)(BK * 2);
    const size_t hstepA = (size_t)HALF * lda * 2, hstepB = (size_t)HALF * K * 2;
    const size_t tstepA = 2 * hstepA, tstepB = 2 * hstepB;
    const long dA2 = g.A2 ? ((const char*)g.A2 - (const char*)g.A) - (long)kmid * (long)kstep : 0l;
    const unsigned ldsw = (unsigned)wid * 1024u;
    const int aoff = lds_byte(wr * 64 + fr, fq * 8), boff = lds_byte(wc * 32 + fr, fq * 8);
#define PG8_SA(b, h) (((b) * 2 + (h)) * HTB)
#define PG8_SB(b, h) ((4 + (b) * 2 + (h)) * HTB)
#define PG8_STAGE(bufoff, gbase, voff) do { _Pragma("unroll") for (int _i = 0; _i < 2; ++_i) \
        __builtin_amdgcn_global_load_lds((const unsigned*)((const char*)(gbase) + (voff)[_i]), (PG8_LAS unsigned*)(lds + (bufoff) + ldsw + _i * 8192), 16, 0, 0); } while (0)
#define PG8_LDA(dst, b, h) do { _Pragma("unroll") for (int m = 0; m < 4; ++m) _Pragma("unroll") for (int k = 0; k < 2; ++k) dst[m][k] = *(const PG8_LAS bf16x8*)(lds + PG8_SA(b, h) + aoff + m * 2048 + k * 1024); } while (0)
#define PG8_LDB(dst, b, h) do { _Pragma("unroll") for (int n = 0; n < 2; ++n) _Pragma("unroll") for (int k = 0; k < 2; ++k) dst[n][k] = *(const PG8_LAS bf16x8*)(lds + PG8_SB(b, h) + boff + n * 2048 + k * 1024); } while (0)
#define PG8_MMA(ai, bj, At, Bt) do { __builtin_amdgcn_s_setprio(1); _Pragma("unroll") for (int m = 0; m < 4; ++m) _Pragma("unroll") for (int n = 0; n < 2; ++n) _Pragma("unroll") for (int k = 0; k < 2; ++k) \
        acc[ai][bj][m][n] = __builtin_amdgcn_mfma_f32_16x16x32_bf16(Bt[n][k], At[m][k], acc[ai][bj][m][n], 0, 0, 0); __builtin_amdgcn_s_setprio(0); } while (0)
#define PG8_WAIT_V(n) asm volatile("s_waitcnt vmcnt(" #n ")" ::: "memory")
#define PG8_WAIT_L(n) asm volatile("s_waitcnt lgkmcnt(" #n ")" ::: "memory")
#define PG8_BAR __builtin_amdgcn_s_barrier()
#define PG8_SCHED __builtin_amdgcn_sched_barrier(0)
    Unit cur, nxt; int ui = 0;
    if (!S.next(0, cur)) return;
    f32x4 acc[2][2][4][2];
#pragma unroll
    for (int a = 0; a < 2; ++a)
#pragma unroll
        for (int b = 0; b < 2; ++b)
#pragma unroll
            for (int m = 0; m < 4; ++m)
#pragma unroll
                for (int n = 0; n < 2; ++n) acc[a][b][m][n] = (f32x4){0.f, 0.f, 0.f, 0.f};
    bf16x8 At[4][2], B0[2][2], B1[2][2];
    const char* cA = (const char*)g.A + (size_t)cur.pm * tstepA; const char* cB = (const char*)g.Bt + (size_t)cur.pn * tstepB;
    S.a_ready(cur);
    if constexpr (SP2) {
        PG8_STAGE(PG8_SB(0, 0), cB, voffB); PG8_STAGE(PG8_SB(0, 1), cB + hstepB, voffB); PG8_STAGE(PG8_SA(0, 0), cA, voffA); PG8_STAGE(PG8_SA(0, 1), cA + hstepA, voffA);
        if (wr == 1) PG8_BAR;
        PG8_WAIT_V(2); PG8_BAR;
        PG8_STAGE(PG8_SB(1, 0), cB + kstep, voffB); PG8_STAGE(PG8_SA(1, 0), cA + kstep, voffA); PG8_STAGE(PG8_SB(1, 1), cB + hstepB + kstep, voffB);
        PG8_WAIT_V(6); PG8_BAR;
    } else {
        PG8_STAGE(PG8_SB(0, 0), cB, voffB); PG8_STAGE(PG8_SA(0, 0), cA, voffA); PG8_STAGE(PG8_SB(0, 1), cB + hstepB, voffB); PG8_STAGE(PG8_SA(0, 1), cA + hstepA, voffA);
        if (wr == 1) PG8_BAR;
        PG8_WAIT_V(4); PG8_BAR;
        PG8_STAGE(PG8_SB(1, 0), cB + kstep, voffB); PG8_STAGE(PG8_SA(1, 0), cA + kstep, voffA); PG8_STAGE(PG8_SB(1, 1), cB + hstepB + kstep, voffB);
        PG8_WAIT_V(6); PG8_BAR;
    }
    for (;;) {
        const bool has_next = S.next(ui + 1, nxt);
        const char* nA = has_next ? (const char*)g.A + (size_t)nxt.pm * tstepA : cA; const char* nB = has_next ? (const char*)g.Bt + (size_t)nxt.pn * tstepB : cB;
        for (int t = 0; t < nt; t += 2) {
            const bool last = (t == nt - 2);
            const char* a1 = cA + ((t + 1 < kmid) ? 0l : dA2) + (size_t)(t + 1) * kstep;
            const char* a2 = last ? nA : cA + ((t + 2 < kmid) ? 0l : dA2) + (size_t)(t + 2) * kstep; const char* b2 = last ? nB : cB + (size_t)(t + 2) * kstep;
            if constexpr (MID) { if (t == kmid) E.mid(acc, cur, wr, wc, fr, fq); }
            const char* a3 = a2 + kstep; const char* b3 = b2 + kstep;
            if (last && has_next) S.a_ready(nxt);
            if constexpr (SP2) {
            PG8_LDB(B0, 0, 0); PG8_LDB(B1, 0, 1); PG8_SCHED; PG8_LDA(At, 0, 0); PG8_STAGE(PG8_SA(1, 1), a1 + hstepA, voffA);
            PG8_WAIT_V(8); PG8_WAIT_L(0); PG8_BAR; PG8_MMA(0, 0, At, B0); PG8_MMA(0, 1, At, B1); PG8_BAR; PG8_SCHED;
            PG8_LDA(At, 0, 1); PG8_STAGE(PG8_SB(0, 0), b2, voffB); PG8_STAGE(PG8_SB(0, 1), b2 + hstepB, voffB); PG8_STAGE(PG8_SA(0, 0), a2, voffA);
            PG8_WAIT_V(8); PG8_WAIT_L(0); PG8_BAR; PG8_MMA(1, 0, At, B0); PG8_MMA(1, 1, At, B1); PG8_BAR; PG8_SCHED;
            PG8_LDB(B0, 1, 0); PG8_LDB(B1, 1, 1); PG8_SCHED; PG8_LDA(At, 1, 0); PG8_STAGE(PG8_SA(0, 1), a2 + hstepA, voffA);
            PG8_WAIT_V(8); PG8_WAIT_L(0); PG8_BAR; PG8_MMA(0, 0, At, B0); PG8_MMA(0, 1, At, B1); PG8_BAR; PG8_SCHED;
            PG8_LDA(At, 1, 1); PG8_STAGE(PG8_SB(1, 0), b3, voffB); PG8_STAGE(PG8_SB(1, 1), b3 + hstepB, voffB); PG8_STAGE(PG8_SA(1, 0), a3, voffA);
            PG8_WAIT_V(8); PG8_WAIT_L(0); PG8_BAR; PG8_MMA(1, 0, At, B0); PG8_MMA(1, 1, At, B1); PG8_BAR; PG8_SCHED;
            } else {
            PG8_LDB(B0, 0, 0); PG8_SCHED; PG8_LDA(At, 0, 0); PG8_STAGE(PG8_SA(1, 1), a1 + hstepA, voffA);
            PG8_WAIT_L(8); PG8_BAR; PG8_WAIT_L(0); PG8_MMA(0, 0, At, B0); PG8_BAR; PG8_SCHED;
            PG8_LDB(B1, 0, 1); PG8_STAGE(PG8_SB(0, 0), b2, voffB);
            PG8_BAR; PG8_WAIT_L(0); PG8_MMA(0, 1, At, B1); PG8_BAR;
            PG8_LDA(At, 0, 1); PG8_STAGE(PG8_SA(0, 0), a2, voffA);
            PG8_BAR; PG8_WAIT_L(0); PG8_MMA(1, 0, At, B0); PG8_BAR; PG8_SCHED;
            PG8_STAGE(PG8_SB(0, 1), b2 + hstepB, voffB);
            PG8_WAIT_V(6); PG8_BAR; PG8_MMA(1, 1, At, B1); PG8_BAR;
            PG8_LDB(B0, 1, 0); PG8_SCHED; PG8_LDA(At, 1, 0); PG8_STAGE(PG8_SA(0, 1), a2 + hstepA, voffA);
            PG8_WAIT_L(8); PG8_BAR; PG8_WAIT_L(0); PG8_MMA(0, 0, At, B0); PG8_BAR; PG8_SCHED;
            PG8_LDB(B1, 1, 1); PG8_STAGE(PG8_SB(1, 0), b3, voffB);
            PG8_BAR; PG8_WAIT_L(0); PG8_MMA(0, 1, At, B1); PG8_BAR;
            PG8_LDA(At, 1, 1); PG8_STAGE(PG8_SA(1, 0), a3, voffA);
            PG8_BAR; PG8_WAIT_L(0); PG8_MMA(1, 0, At, B0); PG8_BAR; PG8_SCHED;
            PG8_STAGE(PG8_SB(1, 1), b3 + hstepB, voffB);
            PG8_WAIT_V(6); PG8_BAR; PG8_MMA(1, 1, At, B1); PG8_BAR;
            }
        }
        if constexpr (ALIGN_EPI) { if (wr == 0) PG8_BAR; }
        if constexpr (!Epi::AFTER_DRAIN) { E(acc, cur, wr, wc, fr, fq); S.done(cur); }
        if (!has_next) break;
#pragma unroll
        for (int a = 0; a < 2; ++a)
#pragma unroll
            for (int b = 0; b < 2; ++b)
#pragma unroll
                for (int m = 0; m < 4; ++m)
#pragma unroll
                    for (int n = 0; n < 2; ++n) acc[a][b][m][n] = (f32x4){0.f, 0.f, 0.f, 0.f};
        cur = nxt; cA = nA; cB = nB; ++ui;
        if constexpr (ALIGN_EPI) { if (wr == 1) PG8_BAR; }
    }
    PG8_WAIT_V(0);
    if constexpr (!ALIGN_EPI) { if (wr == 0) PG8_BAR; }
    PG8_BAR;
    if constexpr (Epi::AFTER_DRAIN) { E.fused(acc, cur, wr, wc, fr, fq, lds, wid, lane); S.done(cur); }
#undef PG8_SA
#undef PG8_SB
#undef PG8_STAGE
#undef PG8_LDA
#undef PG8_LDB
#undef PG8_MMA
#undef PG8_WAIT_V
#undef PG8_WAIT_L
#undef PG8_BAR
#undef PG8_SCHED
}
}

struct Args {
    const float *x_prompt, *x_sample, *state_hgrn, *cache_k, *cache_v, *norm1_w, *w_in, *lb_logits, *hgrn_norm_w, *q_norm_w, *k_norm_w, *sinks,
                *w_o_hgrn, *w_o_attn, *w_out, *norm2_w, *w_ffn_gate, *w_ffn_up, *w_ffn_down;
    float* out; unsigned char* ws; int ph_lo, ph_hi;
};

__device__ __forceinline__ float wave_sum(float v) {
#pragma unroll
    for (int o = 1; o < 64; o <<= 1) v += __shfl_xor(v, o);
    return v;
}

__device__ __forceinline__ void p0_transpose_item(const float* __restrict__ W, int ldw, int K, bf16* WT, int k0, int n0, int drow0, const float* __restrict__ ks, LAS float* scr, int lane, int kofs = 0) {
    float wv[32];
#pragma unroll
    for (int i = 0; i < 32; ++i) wv[i] = W[(size_t)(k0 + 2 * i + (lane >> 5)) * ldw + n0 + (lane & 31)];
#pragma unroll
    for (int i = 0; i < 32; ++i) { const int kk = 2 * i + (lane >> 5); const float s = ks ? ks[k0 + kk] : 1.f; scr[kk * 33 + (lane & 31)] = wv[i] * s; }
    asm volatile("s_waitcnt lgkmcnt(0)" ::: "memory");
    const int c = lane & 7;
#pragma unroll
    for (int j = 0; j < 4; ++j) { const int n = (lane >> 3) + 8 * j; const LAS float* s = scr + (8 * c) * 33 + n;
        u32x4 o; o.x = pk2(s[0 * 33], s[1 * 33]); o.y = pk2(s[2 * 33], s[3 * 33]); o.z = pk2(s[4 * 33], s[5 * 33]); o.w = pk2(s[6 * 33], s[7 * 33]);
        *(u32x4*)(WT + (size_t)(drow0 + n) * K + kofs + k0 + 8 * c) = o; }
    asm volatile("s_waitcnt lgkmcnt(0)" ::: "memory");
}

constexpr int P0_I1 = 16 * 152, P0_NITEMS = 16 * 152 + 2 * 8 * 32 + 16 * 32 + 2 * 16 * 88 + 44 * 32;
__device__ __forceinline__ void p0_weights(const Args& a, unsigned char* lds, int it_lo, int it_hi, int widx, int nwork) {
    const int tid = threadIdx.x, lane = tid & 63, wave = tid >> 6;
    LAS float* scr = (LAS float*)(LAS void*)(lds + wave * 16384);
    unsigned char* ws = a.ws;
    constexpr int I1 = 16 * 152, I2 = 8 * 32, I4 = 16 * 32, I5 = 16 * 88;
    for (int it = it_lo + widx; it < it_hi; it += nwork) {
        int r = it;
        if (r < I1) { const int n0 = 32 * (r % 152);
            const int dr = n0 < 2816 ? n0 : (n0 < 3840 ? 2816 + ((n0 - 2816) >> 7) * 256 + ((n0 - 2816) & 127) : 2816 + ((n0 - 3840) >> 7) * 256 + 128 + ((n0 - 3840) & 127));
            p0_transpose_item(a.w_in, PW, 1024, (bf16*)(ws + WS_W1T), 64 * (r / 152), n0, dr, a.norm1_w, scr, lane); continue; } r -= I1;
        if (r < I2) { p0_transpose_item(a.w_o_hgrn, 1024, 1024, (bf16*)(ws + WS_WOH), 64 * (r / 32), 32 * (r % 32), 32 * (r % 32), nullptr, scr, lane, 0); continue; } r -= I2;
        if (r < I2) { p0_transpose_item(a.w_o_attn, 1024, 1024, (bf16*)(ws + WS_WOH), 64 * (r / 32), 32 * (r % 32), 32 * (r % 32), nullptr, scr, lane, 512); continue; } r -= I2;
        if (r < I4) { p0_transpose_item(a.w_out, 1024, 1024, (bf16*)(ws + WS_WOUT), 64 * (r / 32), 32 * (r % 32), 32 * (r % 32), nullptr, scr, lane); continue; } r -= I4;
        if (r < I5) { const int n0 = 32 * (r % 88); p0_transpose_item(a.w_ffn_gate, DFF, 1024, (bf16*)(ws + WS_WGU), 64 * (r / 88), n0, (n0 >> 7) * 256 + (n0 & 127), a.norm2_w, scr, lane); continue; } r -= I5;
        if (r < I5) { const int n0 = 32 * (r % 88); p0_transpose_item(a.w_ffn_up, DFF, 1024, (bf16*)(ws + WS_WGU), 64 * (r / 88), n0, (n0 >> 7) * 256 + 128 + (n0 & 127), a.norm2_w, scr, lane); continue; } r -= I5;
        p0_transpose_item(a.w_ffn_down, 1024, DFF, (bf16*)(ws + WS_WD), 64 * (r / 32), 32 * (r % 32), 32 * (r % 32), nullptr, scr, lane);
    }
}
__device__ __forceinline__ void p0_prologue(const Args& a, unsigned char* lds, int w_hi) {
    const int tid = threadIdx.x, lane = tid & 63, wave = tid >> 6;
    const int gw = blockIdx.x * 8 + wave, NGW = gridDim.x * 8;
    unsigned char* ws = a.ws;
    p0_weights(a, lds, 0, w_hi, gw, NGW);
    bf16* XB = (bf16*)(ws + WS_R0);
    for (int m = gw; m < MT; m += 2 * NGW) {
        const int m1 = m + NGW; const bool has1 = m1 < MT;
        const float* xrow0 = (m < MP) ? a.x_prompt + (size_t)m * 1024 : a.x_sample + (size_t)(m - MP) * 1024;
        const float* xrow1 = !has1 ? xrow0 : (m1 < MP) ? a.x_prompt + (size_t)m1 * 1024 : a.x_sample + (size_t)(m1 - MP) * 1024;
        const f32x4* xr0 = (const f32x4*)xrow0 + lane; const f32x4* xr1 = (const f32x4*)xrow1 + lane;
        f32x4 v[4], u[4]; float s0 = 0.f, s1 = 0.f;
#pragma unroll
        for (int j = 0; j < 4; ++j) { v[j] = xr0[64 * j]; u[j] = xr1[64 * j]; }
#pragma unroll
        for (int j = 0; j < 4; ++j) { s0 += (v[j][0] * v[j][0] + v[j][1] * v[j][1]) + (v[j][2] * v[j][2] + v[j][3] * v[j][3]); s1 += (u[j][0] * u[j][0] + u[j][1] * u[j][1]) + (u[j][2] * u[j][2] + u[j][3] * u[j][3]); }
        const float r0 = __builtin_amdgcn_rsqf(wave_sum(s0) * (1.f / 1024.f) + EPS), r1 = __builtin_amdgcn_rsqf(wave_sum(s1) * (1.f / 1024.f) + EPS);
        u32x2* o0 = (u32x2*)(XB + (size_t)m * 1024) + lane; u32x2* o1 = (u32x2*)(XB + (size_t)m1 * 1024) + lane;
#pragma unroll
        for (int j = 0; j < 4; ++j) { u32x2 w; w.x = pk2(v[j][0] * r0, v[j][1] * r0); w.y = pk2(v[j][2] * r0, v[j][3] * r0); o0[64 * j] = w; }
        if (has1) {
#pragma unroll
            for (int j = 0; j < 4; ++j) { u32x2 w; w.x = pk2(u[j][0] * r1, u[j][1] * r1); w.y = pk2(u[j][2] * r1, u[j][3] * r1); o1[64 * j] = w; }
        }
    }
    float* sumsq = (float*)(ws + WS_SUMSQ);
    for (int i = blockIdx.x * NTHREADS + tid; i < MT; i += gridDim.x * NTHREADS) sumsq[i] = 0.f;
    if (blockIdx.x == 0) { float* lbv = (float*)(ws + WS_LBV); lbv[tid] = sigm(a.lb_logits[tid] - a.lb_logits[512 + tid]); }
}

__device__ __forceinline__ void hgrn_local_phase(const Args& a, unsigned char* lds) {
    const int tid = threadIdx.x, lane = tid & 63, wid = tid >> 6, G = gridDim.x;
    float* cumS = (float*)lds; float* segT = (float*)(lds + 32768); bf16* KdS = (bf16*)(lds + 34816); bf16* VS = (bf16*)(lds + 52224);
    unsigned char* ws = a.ws;
    constexpr int N_LOC = 512 * 4;
    h16x8 gr[2]; u32x4 vr[2];
    int it = blockIdx.x;
#define HL_LOAD(IT) do { const size_t r0_ = (size_t)((IT) >> 2) * 64; const int h_ = (IT) & 3; \
        const size_t ho_ = ((size_t)h_ * MT + r0_) * 128; const _Float16* G_ = (const _Float16*)(ws + WS_R3) + ho_; const bf16* V_ = (const bf16*)(ws + WS_R4) + ho_; \
        _Pragma("unroll") for (int i = 0; i < 2; ++i) { const int idx = tid + 512 * i; gr[i] = *(const h16x8*)(G_ + 8 * idx); } \
        _Pragma("unroll") for (int i = 0; i < 2; ++i) { const int idx = tid + 512 * i; vr[i] = *(const u32x4*)(V_ + 8 * idx); } } while (0)
    if (it < N_LOC) HL_LOAD(it);
    for (; it < N_LOC; it += G) {
        const int cidx = it >> 2, h = it & 3;
        const size_t r0 = (size_t)cidx * 64;
        bf16* Gp = (bf16*)(ws + WS_R3) + ((size_t)h * MT + r0) * 128;
#pragma unroll
        for (int i = 0; i < 2; ++i) { const int idx = tid + 512 * i; const f32x8 g8 = __builtin_convertvector(gr[i], f32x8);
            *(f32x4*)(cumS + 8 * idx) = (f32x4){g8[0], g8[1], g8[2], g8[3]}; *(f32x4*)(cumS + 8 * idx + 4) = (f32x4){g8[4], g8[5], g8[6], g8[7]}; }
        __syncthreads();
        {
            const int k = tid & 127, seg = tid >> 7; float v[16]; float run = 0.f;
#pragma unroll
            for (int i = 0; i < 16; ++i) { run += cumS[(seg * 16 + i) * 128 + k]; v[i] = run; }
            segT[seg * 128 + k] = run;
            __syncthreads();
            float off = 0.f;
#pragma unroll
            for (int s = 0; s < 3; ++s) off += (s < seg) ? segT[s * 128 + k] : 0.f;
#pragma unroll
            for (int i = 0; i < 16; ++i) cumS[(seg * 16 + i) * 128 + k] = v[i] + off;
        }
        __syncthreads();
#pragma unroll
        for (int i = 0; i < 2; ++i) { const int idx = tid + 512 * i;
            const f32x4 ca = *(const f32x4*)(cumS + 8 * idx), cb = *(const f32x4*)(cumS + 8 * idx + 4);
            u32x4 w; w.x = pk2(__expf(ca[0]), __expf(ca[1])); w.y = pk2(__expf(ca[2]), __expf(ca[3])); w.z = pk2(__expf(cb[0]), __expf(cb[1])); w.w = pk2(__expf(cb[2]), __expf(cb[3]));
            *(u32x4*)(Gp + 8 * idx) = w; }
        if (tid < 128) ((float*)(ws + WS_DT))[(size_t)(cidx * 4 + h) * 128 + tid] = __expf(cumS[63 * 128 + tid]);
#pragma unroll
        for (int i = 0; i < 2; ++i) {
            const int idx = tid + 512 * i, j = idx >> 4, k8 = (idx & 15) * 8;
            const f32x4 c0 = *(const f32x4*)(cumS + j * 128 + k8), c1 = *(const f32x4*)(cumS + j * 128 + k8 + 4);
            const f32x4 z4 = {0.f, 0.f, 0.f, 0.f};
            const f32x4 p0 = j ? *(const f32x4*)(cumS + (j - 1) * 128 + k8) : z4, p1 = j ? *(const f32x4*)(cumS + (j - 1) * 128 + k8 + 4) : z4;
            const f32x4 l0 = *(const f32x4*)(cumS + 63 * 128 + k8), l1 = *(const f32x4*)(cumS + 63 * 128 + k8 + 4);
            float kk[8];
#pragma unroll
            for (int x = 0; x < 4; ++x) { kk[x] = 1.f - __expf(c0[x] - p0[x]); kk[4 + x] = 1.f - __expf(c1[x] - p1[x]); }
            u32x4 w;
            w.x = pk2(kk[0] * __expf(l0[0] - c0[0]), kk[1] * __expf(l0[1] - c0[1]));
            w.y = pk2(kk[2] * __expf(l0[2] - c0[2]), kk[3] * __expf(l0[3] - c0[3]));
            w.z = pk2(kk[4] * __expf(l1[0] - c1[0]), kk[5] * __expf(l1[1] - c1[1]));
            w.w = pk2(kk[6] * __expf(l1[2] - c1[2]), kk[7] * __expf(l1[3] - c1[3]));
            *(u32x4*)(KdS + j * 136 + k8) = w;
            *(u32x4*)(VS + j * 136 + k8) = vr[i];
        }
        __syncthreads();
        if (it + G < N_LOC) HL_LOAD(it + G);
        {
            const int i16 = lane & 15, g = lane >> 4, q = i16 >> 2, p = i16 & 3;
            bf16x8 af[2];
#pragma unroll
            for (int jc = 0; jc < 2; ++jc) af[jc] = cat8(tr_read(KdS + (32 * jc + 8 * g + q) * 136 + 16 * wid + 4 * p), tr_read(KdS + (32 * jc + 8 * g + 4 + q) * 136 + 16 * wid + 4 * p));
            bf16* SLT = (bf16*)(ws + WS_R0) + (size_t)(cidx * 4 + h) * 16384;
#pragma unroll
            for (int nt = 0; nt < 8; ++nt) {
                f32x4 acc = {0.f, 0.f, 0.f, 0.f};
#pragma unroll
                for (int jc = 0; jc < 2; ++jc) {
                    const bf16x8 bfr = cat8(tr_read(VS + (32 * jc + 8 * g + q) * 136 + 16 * nt + 4 * p), tr_read(VS + (32 * jc + 8 * g + 4 + q) * 136 + 16 * nt + 4 * p));
                    acc = MFMA16(af[jc], bfr, acc);
                }
                u32x2 w; w.x = pk2(acc[0], acc[1]); w.y = pk2(acc[2], acc[3]);
                *(u32x2*)(SLT + (size_t)(16 * nt + i16) * 128 + 16 * wid + 4 * g) = w;
            }
        }
        __syncthreads();
    }
#undef HL_LOAD
}

__device__ __forceinline__ void attn_prompt_item(const Args& a, int b, int qb, int kvh, unsigned char* lds) {
    const int tid = threadIdx.x, lane = tid & 63, wid = __builtin_amdgcn_readfirstlane(tid >> 6);
    bf16* KS = (bf16*)lds; bf16* VS = (bf16*)(lds + 36864);
    unsigned char* ws = a.ws;
    const bf16* QA = (const bf16*)(ws + WS_R6); const bf16* KV = (const bf16*)(ws + WS_R7); bf16* YB = (bf16*)(ws + WS_R10);
    {
        const int key = tid >> 1, half = tid & 1;
        u32x4 kw[4], vw[4];
        const bool zero = (qb == 0 && key < 128);
        const size_t row = (size_t)b * SEQ + (size_t)(qb - 1) * 128 + key;
#pragma unroll
        for (int c = 0; c < 4; ++c) {
            if (zero) { kw[c] = (u32x4){0u, 0u, 0u, 0u}; vw[c] = kw[c]; }
            else { kw[c] = *(const u32x4*)(KV + row * 256 + kvh * 64 + half * 32 + 8 * c); vw[c] = *(const u32x4*)(KV + row * 256 + 128 + kvh * 64 + half * 32 + 8 * c); }
        }
        float ss = 0.f;
#pragma unroll
        for (int c = 0; c < 4; ++c) { const float e0 = bflo(kw[c].x), e1 = bfhi(kw[c].x), e2 = bflo(kw[c].y), e3 = bfhi(kw[c].y), e4 = bflo(kw[c].z), e5 = bfhi(kw[c].z), e6 = bflo(kw[c].w), e7 = bfhi(kw[c].w);
            ss += (e0 * e0 + e1 * e1) + (e2 * e2 + e3 * e3) + (e4 * e4 + e5 * e5) + (e6 * e6 + e7 * e7); }
        ss += __shfl_xor(ss, 1);
        const float rstd = __builtin_amdgcn_rsqf(ss * (1.f / 64.f) + EPS);
        const bool wr_cache = (qb == SEQ / 128 - 1) && key >= 128;
        float* ck = a.out + O_KP + ((size_t)(b * 128 + (key - 128)) * 2 + kvh) * 64 + half * 32;
        float* cv = a.out + O_VP + ((size_t)(b * 128 + (key - 128)) * 2 + kvh) * 64 + half * 32;
#pragma unroll
        for (int c = 0; c < 4; ++c) {
            const f32x4 w0 = *(const f32x4*)(a.k_norm_w + half * 32 + 8 * c), w1 = *(const f32x4*)(a.k_norm_w + half * 32 + 8 * c + 4);
            f32x4 n0, n1;
            n0[0] = bflo(kw[c].x) * rstd * w0[0]; n0[1] = bfhi(kw[c].x) * rstd * w0[1]; n0[2] = bflo(kw[c].y) * rstd * w0[2]; n0[3] = bfhi(kw[c].y) * rstd * w0[3];
            n1[0] = bflo(kw[c].z) * rstd * w1[0]; n1[1] = bfhi(kw[c].z) * rstd * w1[1]; n1[2] = bflo(kw[c].w) * rstd * w1[2]; n1[3] = bfhi(kw[c].w) * rstd * w1[3];
            u32x4 w; w.x = pk2(n0[0], n0[1]); w.y = pk2(n0[2], n0[3]); w.z = pk2(n1[0], n1[1]); w.w = pk2(n1[2], n1[3]);
            *(u32x4*)(KS + key * 72 + half * 32 + 8 * c) = w;
            *(u32x4*)(VS + key * 72 + half * 32 + 8 * c) = vw[c];
            if (wr_cache) {
                *(f32x4*)(ck + 8 * c) = n0; *(f32x4*)(ck + 8 * c + 4) = n1;
                *(f32x4*)(cv + 8 * c) = (f32x4){bflo(vw[c].x), bfhi(vw[c].x), bflo(vw[c].y), bfhi(vw[c].y)};
                *(f32x4*)(cv + 8 * c + 4) = (f32x4){bflo(vw[c].z), bfhi(vw[c].z), bflo(vw[c].w), bfhi(vw[c].w)};
            }
        }
    }
    __syncthreads();
    const int i16 = lane & 15, g = lane >> 4, q = i16 >> 2, p = i16 & 3;
    const int qt = wid, t0 = qt > 0 ? qt - 1 : 0;
    const size_t row = (size_t)b * SEQ + (size_t)qb * 128 + 16 * qt + i16;
    f32x4 dl2[10];
    {
        const int qz = (qb == 0) ? -1 : 0, band0 = 16 * t0 + 4 * g, dist0 = 128 + 16 * qt + i16 - band0;
#pragma unroll
        for (int t = 0; t < 10; ++t)
#pragma unroll
            for (int r = 0; r < 4; ++r) {
                const int band = band0 + 16 * t + r, dist = dist0 - 16 * t - r;
                const int msk = ((dist | (127 - dist)) >> 31) | (((band - 128) >> 31) & qz);
                dl2[t][r] = msk ? 1e30f : (float)dist * 1.4426950408889634f;
            }
    }
    u32x4 qnx[2];
    qnx[0] = *(const u32x4*)(QA + row * 512 + kvh * 256 + 8 * g); qnx[1] = *(const u32x4*)(QA + row * 512 + kvh * 256 + 32 + 8 * g);
#pragma unroll 1
    for (int g4 = 0; g4 < 4; ++g4) {
        asm volatile("" ::: "memory");
        const int hq = kvh * 4 + g4;
        bf16x8 bq[2];
        {
            u32x4 qw[2]; float ss = 0.f;
            qw[0] = qnx[0]; qw[1] = qnx[1];
            if (g4 < 3) { qnx[0] = *(const u32x4*)(QA + row * 512 + (hq + 1) * 64 + 8 * g); qnx[1] = *(const u32x4*)(QA + row * 512 + (hq + 1) * 64 + 32 + 8 * g); }
#pragma unroll
            for (int c = 0; c < 2; ++c) {
                const float e0 = bflo(qw[c].x), e1 = bfhi(qw[c].x), e2 = bflo(qw[c].y), e3 = bfhi(qw[c].y), e4 = bflo(qw[c].z), e5 = bfhi(qw[c].z), e6 = bflo(qw[c].w), e7 = bfhi(qw[c].w);
                ss += (e0 * e0 + e1 * e1) + (e2 * e2 + e3 * e3) + (e4 * e4 + e5 * e5) + (e6 * e6 + e7 * e7); }
            ss += __shfl_xor(ss, 16); ss += __shfl_xor(ss, 32);
            const float rstd = __builtin_amdgcn_rsqf(ss * (1.f / 64.f) + EPS);
#pragma unroll
            for (int c = 0; c < 2; ++c) {
                const f32x4 w0 = *(const f32x4*)(a.q_norm_w + 32 * c + 8 * g), w1 = *(const f32x4*)(a.q_norm_w + 32 * c + 8 * g + 4);
                u32x4 w;
                w.x = pk2(bflo(qw[c].x) * rstd * w0[0], bfhi(qw[c].x) * rstd * w0[1]); w.y = pk2(bflo(qw[c].y) * rstd * w0[2], bfhi(qw[c].y) * rstd * w0[3]);
                w.z = pk2(bflo(qw[c].z) * rstd * w1[0], bfhi(qw[c].z) * rstd * w1[1]); w.w = pk2(bflo(qw[c].w) * rstd * w1[2], bfhi(qw[c].w) * rstd * w1[3]);
                bq[c] = __builtin_bit_cast(bf16x8, w);
            }
        }
        const float nslope = -exp2f(-(float)(hq + 1)), sink2 = a.sinks[hq] * 1.4426950408889634f;
        f32x4 sc[10]; float mx = -3.0e38f;
#pragma unroll
        for (int t = 0; t < 10; ++t) {
            f32x4 s = {0.f, 0.f, 0.f, 0.f};
#pragma unroll
            for (int c = 0; c < 2; ++c) s = MFMA16(*(const bf16x8*)(KS + (16 * (t0 + t) + i16) * 72 + 32 * c + 8 * g), bq[c], s);
            s = s * (0.125f * 1.4426950408889634f) + dl2[t] * nslope;
            mx = fmaxf(mx, fmaxf(fmaxf(s[0], s[1]), fmaxf(s[2], s[3])));
            sc[t] = s;
        }
        mx = fmaxf(mx, __shfl_xor(mx, 16)); mx = fmaxf(mx, __shfl_xor(mx, 32)); mx = fmaxf(mx, sink2);
        f32x4 sum4 = {0.f, 0.f, 0.f, 0.f};
#pragma unroll
        for (int t = 0; t < 10; ++t) {
            const f32x4 d = sc[t] - mx; f32x4 ev;
            ev[0] = __builtin_amdgcn_exp2f(d[0]); ev[1] = __builtin_amdgcn_exp2f(d[1]); ev[2] = __builtin_amdgcn_exp2f(d[2]); ev[3] = __builtin_amdgcn_exp2f(d[3]);
            sc[t] = ev; sum4 += ev;
        }
        float sum = (sum4[0] + sum4[1]) + (sum4[2] + sum4[3]);
        sum += __shfl_xor(sum, 16); sum += __shfl_xor(sum, 32);
        const float inv = 1.f / (sum + __builtin_amdgcn_exp2f(sink2 - mx));
        bf16x8 pb[5];
#pragma unroll
        for (int ch = 0; ch < 5; ++ch) pb[ch] = pk8(sc[2 * ch], sc[2 * ch + 1]);
#pragma unroll
        for (int dt = 0; dt < 4; ++dt) {
            f32x4 acc = {0.f, 0.f, 0.f, 0.f};
#pragma unroll
            for (int ch = 0; ch < 5; ++ch) {
                const bf16x8 av = cat8(tr_read(VS + (16 * (t0 + 2 * ch) + 4 * g + q) * 72 + 16 * dt + 4 * p), tr_read(VS + (16 * (t0 + 2 * ch + 1) + 4 * g + q) * 72 + 16 * dt + 4 * p));
                acc = MFMA16(av, pb[ch], acc);
            }
            u32x2 w; w.x = pk2(acc[0] * inv, acc[1] * inv); w.y = pk2(acc[2] * inv, acc[3] * inv);
            *(u32x2*)(YB + row * 512 + hq * 64 + 16 * dt + 4 * g) = w;
        }
    }
    __syncthreads();
}

__device__ __forceinline__ void attn_sample_item(const Args& a, int b, unsigned char* lds) {
    const int tid = threadIdx.x;
    float* qn = (float*)lds; float* knew = (float*)(lds + 8192); float* vnew = (float*)(lds + 10240); float* sc = (float*)(lds + 12288); float* invs = (float*)(lds + 29696); float* cb = (float*)(lds + 32768);
    unsigned char* ws = a.ws;
    const bf16* QA = (const bf16*)(ws + WS_R6); const bf16* KV = (const bf16*)(ws + WS_R7); bf16* YB = (bf16*)(ws + WS_R10);
    const size_t rb = (size_t)MP + (size_t)b * 4;
    const float* ck = a.cache_k + (size_t)b * 16384; const float* cv = a.cache_v + (size_t)b * 16384;
    f32x4 kreg[8];
#pragma unroll
    for (int i = 0; i < 8; ++i) kreg[i] = *(const f32x4*)(ck + 4 * (tid + 512 * i));
    {
        const int pair = tid >> 4, d4 = (tid & 15) * 4, hq = pair >> 2, t = pair & 3;
        const u32x2 w = *(const u32x2*)(QA + (rb + t) * 512 + hq * 64 + d4);
        const float e0 = bflo(w.x), e1 = bfhi(w.x), e2 = bflo(w.y), e3 = bfhi(w.y);
        float ss = (e0 * e0 + e1 * e1) + (e2 * e2 + e3 * e3);
        ss += __shfl_xor(ss, 1); ss += __shfl_xor(ss, 2); ss += __shfl_xor(ss, 4); ss += __shfl_xor(ss, 8);
        const float rstd = __builtin_amdgcn_rsqf(ss * (1.f / 64.f) + EPS);
        const f32x4 nw = *(const f32x4*)(a.q_norm_w + d4);
        *(f32x4*)(qn + pair * 64 + d4) = (f32x4){e0 * rstd * nw[0], e1 * rstd * nw[1], e2 * rstd * nw[2], e3 * rstd * nw[3]};
    }
    if (tid < 128) {
        const int t = tid >> 5, kvh = (tid >> 4) & 1, d4 = (tid & 15) * 4;
        const u32x2 w = *(const u32x2*)(KV + (rb + t) * 256 + kvh * 64 + d4);
        const float e0 = bflo(w.x), e1 = bfhi(w.x), e2 = bflo(w.y), e3 = bfhi(w.y);
        float ss = (e0 * e0 + e1 * e1) + (e2 * e2 + e3 * e3);
        ss += __shfl_xor(ss, 1); ss += __shfl_xor(ss, 2); ss += __shfl_xor(ss, 4); ss += __shfl_xor(ss, 8);
        const float rstd = __builtin_amdgcn_rsqf(ss * (1.f / 64.f) + EPS);
        const f32x4 nw = *(const f32x4*)(a.k_norm_w + d4);
        *(f32x4*)(knew + t * 128 + kvh * 64 + d4) = (f32x4){e0 * rstd * nw[0], e1 * rstd * nw[1], e2 * rstd * nw[2], e3 * rstd * nw[3]};
        const u32x2 v = *(const u32x2*)(KV + (rb + t) * 256 + 128 + kvh * 64 + d4);
        *(f32x4*)(vnew + t * 128 + kvh * 64 + d4) = (f32x4){bflo(v.x), bfhi(v.x), bflo(v.y), bfhi(v.y)};
    }
    {
        float* ok = a.out + O_KS + (size_t)b * 16384;
#pragma unroll
        for (int i = 0; i < 8; ++i) { const int f = 4 * (tid + 512 * i); *(f32x4*)(cb + f) = kreg[i];
            if (f >= 512) *(f32x4*)(ok + f - 512) = kreg[i]; }
    }
    __syncthreads();
    if (tid < 128) { const int f = 4 * tid;
        *(f32x4*)(a.out + O_KS + (size_t)b * 16384 + 124 * 128 + f) = *(const f32x4*)(knew + f); *(f32x4*)(a.out + O_VS + (size_t)b * 16384 + 124 * 128 + f) = *(const f32x4*)(vnew + f); }
    for (int idx = tid; idx < 132 * 32; idx += 512) {
        const int key = idx >> 5, pair = idx & 31, hq = pair >> 2, t = pair & 3, kvh = hq >> 2;
        const float* qp = qn + pair * 64; float dot = 0.f;
        const float* kp = key < 128 ? cb + (key * 2 + kvh) * 64 : knew + (key - 128) * 128 + kvh * 64;
#pragma unroll
        for (int d = 0; d < 64; d += 4) { const f32x4 kk = *(const f32x4*)(kp + d), qq = *(const f32x4*)(qp + d); dot += (kk[0] * qq[0] + kk[1] * qq[1]) + (kk[2] * qq[2] + kk[3] * qq[3]); }
        const int dist = key < 128 ? t + 128 - key : t - (key - 128);
        const bool valid = dist >= 0 && dist < 128;
        sc[pair * 136 + key] = valid ? dot * 0.125f - exp2f(-(float)(hq + 1)) * (float)dist : -1e30f;
    }
    __syncthreads();
    f32x4 vreg[8];
#pragma unroll
    for (int i = 0; i < 8; ++i) vreg[i] = *(const f32x4*)(cv + 4 * (tid + 512 * i));
    {
        const int pair = tid >> 4, l16 = tid & 15, hq = pair >> 2; const float sink = a.sinks[hq];
        float mx = -3.0e38f;
        for (int key = l16; key < 132; key += 16) mx = fmaxf(mx, sc[pair * 136 + key]);
        mx = fmaxf(mx, __shfl_xor(mx, 1)); mx = fmaxf(mx, __shfl_xor(mx, 2)); mx = fmaxf(mx, __shfl_xor(mx, 4)); mx = fmaxf(mx, __shfl_xor(mx, 8));
        mx = fmaxf(mx, sink);
        float sum = 0.f;
        for (int key = l16; key < 132; key += 16) { const float e = __expf(sc[pair * 136 + key] - mx); sc[pair * 136 + key] = e; sum += e; }
        sum += __shfl_xor(sum, 1); sum += __shfl_xor(sum, 2); sum += __shfl_xor(sum, 4); sum += __shfl_xor(sum, 8);
        if (l16 == 0) invs[pair] = 1.f / (sum + __expf(sink - mx));
    }
    { float* ov = a.out + O_VS + (size_t)b * 16384;
#pragma unroll
      for (int i = 0; i < 8; ++i) { const int f = 4 * (tid + 512 * i); *(f32x4*)(cb + f) = vreg[i]; if (f >= 512) *(f32x4*)(ov + f - 512) = vreg[i]; } }
    __syncthreads();
    {
        const int pair = tid >> 4, d4 = (tid & 15) * 4, hq = pair >> 2, t = pair & 3, kvh = hq >> 2;
        f32x4 acc = {0.f, 0.f, 0.f, 0.f};
#pragma unroll 8
        for (int key = 0; key < 128; ++key) { const float pv = sc[pair * 136 + key]; acc += pv * *(const f32x4*)(cb + (key * 2 + kvh) * 64 + d4); }
#pragma unroll
        for (int key = 0; key < 4; ++key) { const float pv = sc[pair * 136 + 128 + key]; acc += pv * *(const f32x4*)(vnew + key * 128 + kvh * 64 + d4); }
        const float inv = invs[pair];
        u32x2 w; w.x = pk2(acc[0] * inv, acc[1] * inv); w.y = pk2(acc[2] * inv, acc[3] * inv);
        *(u32x2*)(YB + (rb + t) * 512 + hq * 64 + d4) = w;
    }
    __syncthreads();
}

__device__ __forceinline__ void hgrn_scan(const Args& a, int sb, int ns, unsigned char* lds) {
    unsigned char* ws = a.ws;
    bf16* SLT = (bf16*)(ws + WS_R0); const float* DT = (const float*)(ws + WS_DT);
    float* dts = (float*)lds;
    for (int e0 = sb * NTHREADS; e0 < 4 * 4 * 128 * 16; e0 += ns * NTHREADS) {
        const int e = e0 + threadIdx.x;
        const int k8 = (e & 15) * 8, v = (e >> 4) & 127, h = (e0 >> 11) & 3, b = e0 >> 13;
        __syncthreads();
#pragma unroll
        for (int i = 0; i < 8; ++i) { const int idx = threadIdx.x + 512 * i, c = idx >> 5, k4 = (idx & 31) * 4; *(f32x4*)(dts + c * 128 + k4) = *(const f32x4*)(DT + (size_t)((b * 128 + c) * 4 + h) * 128 + k4); }
        __syncthreads();
        float st[8];
#pragma unroll
        for (int j = 0; j < 8; ++j) st[j] = 0.f;
        for (int c0 = 0; c0 < 128; c0 += 16) {
            u32x4 loc[16];
#pragma unroll
            for (int i = 0; i < 16; ++i) { const size_t ci = (size_t)((b * 128 + c0 + i) * 4 + h); loc[i] = *(const u32x4*)(SLT + (ci * 128 + v) * 128 + k8); }
#pragma unroll
            for (int i = 0; i < 16; ++i) { const size_t ci = (size_t)((b * 128 + c0 + i) * 4 + h);
                const f32x4 d0 = *(const f32x4*)(dts + (c0 + i) * 128 + k8), d1 = *(const f32x4*)(dts + (c0 + i) * 128 + k8 + 4);
                u32x4 w; w.x = pk2(st[0], st[1]); w.y = pk2(st[2], st[3]); w.z = pk2(st[4], st[5]); w.w = pk2(st[6], st[7]);
                *(u32x4*)(SLT + (ci * 128 + v) * 128 + k8) = w;
                st[0] = d0[0] * st[0] + bflo(loc[i].x); st[1] = d0[1] * st[1] + bfhi(loc[i].x); st[2] = d0[2] * st[2] + bflo(loc[i].y); st[3] = d0[3] * st[3] + bfhi(loc[i].y);
                st[4] = d1[0] * st[4] + bflo(loc[i].z); st[5] = d1[1] * st[5] + bfhi(loc[i].z); st[6] = d1[2] * st[6] + bflo(loc[i].w); st[7] = d1[3] * st[7] + bfhi(loc[i].w); }
        }
        float* o = a.out + O_SP + ((size_t)(b * 4 + h) * 128 + k8) * 128 + v;
#pragma unroll
        for (int j = 0; j < 8; ++j) o[j * 128] = st[j];
    }
}

__device__ __forceinline__ void hgrn_out_phase(const Args& a, unsigned char* lds) {
    const int tid = threadIdx.x, lane = tid & 63, wid = tid >> 6, G = gridDim.x;
    bf16* QdS = (bf16*)lds; bf16* KxS = (bf16*)(lds + 17408); bf16* VS = (bf16*)(lds + 34816); bf16* SS = (bf16*)(lds + 52224); float* red = (float*)(lds + 87040);
    unsigned char* ws = a.ws;
    constexpr int N_OUT = 512 * 4;
    u32x4 er[2], qr[2], kr[2], vr[2], sr[4];
#define HO_LOAD(IT) do { const size_t r0_ = (size_t)((IT) >> 2) * 64; const int h_ = (IT) & 3; \
        const size_t ho_ = ((size_t)h_ * MT + r0_) * 128; const bf16* CU_ = (const bf16*)(ws + WS_R3) + ho_; const bf16* Q_ = (const bf16*)(ws + WS_R1) + ho_; \
        const bf16* K_ = (const bf16*)(ws + WS_R2) + ho_; const bf16* V_ = (const bf16*)(ws + WS_R4) + ho_; const bf16* S_ = (const bf16*)(ws + WS_R0) + (size_t)(IT) * 16384; \
        _Pragma("unroll") for (int i = 0; i < 2; ++i) { const int idx = tid + 512 * i; \
            er[i] = *(const u32x4*)(CU_ + 8 * idx); \
            qr[i] = *(const u32x4*)(Q_ + 8 * idx); kr[i] = *(const u32x4*)(K_ + 8 * idx); vr[i] = *(const u32x4*)(V_ + 8 * idx); } \
        _Pragma("unroll") for (int i = 0; i < 4; ++i) { const int idx = tid + 512 * i, v = idx >> 4, c8 = (idx & 15) * 8; sr[i] = *(const u32x4*)(S_ + (size_t)v * 128 + c8); } } while (0)
    int it = blockIdx.x;
    if (it < N_OUT) HO_LOAD(it);
    for (; it < N_OUT; it += G) {
        const int cidx = it >> 2, h = it & 3;
        const size_t r0 = (size_t)cidx * 64;
        const bf16* OG = (const bf16*)(ws + WS_R5) + ((size_t)h * MT + r0) * 128;
        bf16* YA = (bf16*)(ws + WS_R6) + r0 * 512 + h * 128;
#pragma unroll
        for (int i = 0; i < 2; ++i) {
            const int idx = tid + 512 * i, j = idx >> 4, k8 = (idx & 15) * 8;
            const u32x4 ew = er[i], qw = qr[i], kw = kr[i];
            const float e[8] = {bflo(ew.x), bfhi(ew.x), bflo(ew.y), bfhi(ew.y), bflo(ew.z), bfhi(ew.z), bflo(ew.w), bfhi(ew.w)};
            float ei[8];
#pragma unroll
            for (int x = 0; x < 8; ++x) ei[x] = __builtin_amdgcn_rcpf(e[x]);
            u32x4 w;
            w.x = pk2(bflo(qw.x) * e[0], bfhi(qw.x) * e[1]); w.y = pk2(bflo(qw.y) * e[2], bfhi(qw.y) * e[3]); w.z = pk2(bflo(qw.z) * e[4], bfhi(qw.z) * e[5]); w.w = pk2(bflo(qw.w) * e[6], bfhi(qw.w) * e[7]);
            *(u32x4*)(QdS + j * 136 + k8) = w;
            w.x = pk2(bflo(kw.x) * ei[0], bfhi(kw.x) * ei[1]); w.y = pk2(bflo(kw.y) * ei[2], bfhi(kw.y) * ei[3]); w.z = pk2(bflo(kw.z) * ei[4], bfhi(kw.z) * ei[5]); w.w = pk2(bflo(kw.w) * ei[6], bfhi(kw.w) * ei[7]);
            *(u32x4*)(KxS + j * 136 + k8) = w;
            *(u32x4*)(VS + j * 136 + k8) = vr[i];
        }
#pragma unroll
        for (int i = 0; i < 4; ++i) { const int idx = tid + 512 * i, v = idx >> 4, c8 = (idx & 15) * 8; *(u32x4*)(SS + v * 136 + c8) = sr[i]; }
        __syncthreads();
        if (it + G < N_OUT) HO_LOAD(it + G);
        const int i16 = lane & 15, g = lane >> 4, q = i16 >> 2, p = i16 & 3, tt = wid & 3, vh = wid >> 2;
        u32x2 ogr[4];
#pragma unroll
        for (int vt = 0; vt < 4; ++vt) ogr[vt] = *(const u32x2*)(OG + (size_t)(16 * tt + i16) * 128 + vh * 64 + 16 * vt + 4 * g);
        bf16x8 bq[4];
#pragma unroll
        for (int kc = 0; kc < 4; ++kc) bq[kc] = *(const bf16x8*)(QdS + (16 * tt + i16) * 136 + 32 * kc + 8 * g);
        f32x4 sc[4];
#pragma unroll
        for (int jt = 0; jt < 4; ++jt) {
            f32x4 sv = {0.f, 0.f, 0.f, 0.f};
            if (jt <= tt) {
#pragma unroll
                for (int kc = 0; kc < 4; ++kc) sv = MFMA16(*(const bf16x8*)(KxS + (16 * jt + i16) * 136 + 32 * kc + 8 * g), bq[kc], sv);
                if (jt == tt) {
#pragma unroll
                    for (int r = 0; r < 4; ++r) sv[r] = (4 * g + r > i16) ? 0.f : sv[r];
                }
            }
            sc[jt] = sv;
        }
        bf16x8 pb[2];
        pb[0] = pk8(sc[0], sc[1]); pb[1] = pk8(sc[2], sc[3]);
        f32x4 acc[4]; float ss = 0.f;
#pragma unroll
        for (int vt = 0; vt < 4; ++vt) {
            const int v0 = vh * 64 + 16 * vt;
            f32x4 c = {0.f, 0.f, 0.f, 0.f};
#pragma unroll
            for (int kc = 0; kc < 4; ++kc) c = MFMA16(*(const bf16x8*)(SS + (v0 + i16) * 136 + 32 * kc + 8 * g), bq[kc], c);
#pragma unroll
            for (int jc = 0; jc < 2; ++jc) {
                const bf16x8 av = cat8(tr_read(VS + (32 * jc + 4 * g + q) * 136 + v0 + 4 * p), tr_read(VS + (32 * jc + 16 + 4 * g + q) * 136 + v0 + 4 * p));
                c = MFMA16(av, pb[jc], c);
            }
            acc[vt] = c; ss += (c[0] * c[0] + c[1] * c[1]) + (c[2] * c[2] + c[3] * c[3]);
        }
        ss += __shfl_xor(ss, 16); ss += __shfl_xor(ss, 32);
        if (g == 0) red[vh * 64 + 16 * tt + i16] = ss;
        __syncthreads();
        const float rstd = __builtin_amdgcn_rsqf((red[16 * tt + i16] + red[64 + 16 * tt + i16]) * (1.f / 128.f) + EPS);
#pragma unroll
        for (int vt = 0; vt < 4; ++vt) {
            const int col = vh * 64 + 16 * vt + 4 * g; const size_t t = (size_t)(16 * tt + i16);
            const u32x2 ow = ogr[vt]; const f32x4 nw = *(const f32x4*)(a.hgrn_norm_w + h * 128 + col);
            u32x2 w; w.x = pk2(acc[vt][0] * rstd * nw[0] * bflo(ow.x), acc[vt][1] * rstd * nw[1] * bfhi(ow.x)); w.y = pk2(acc[vt][2] * rstd * nw[2] * bflo(ow.y), acc[vt][3] * rstd * nw[3] * bfhi(ow.y));
            *(u32x2*)(YA + t * 512 + col) = w;
        }
        __syncthreads();
    }
#undef HO_LOAD
}

__device__ __forceinline__ void hgrn_sample_item(const Args& a, int b, int h, unsigned char* lds) {
    const int tid = threadIdx.x, lane = tid & 63, wid = tid >> 6;
    float* part = (float*)lds;
    float* wsum = (float*)(lds + 32768);
    unsigned char* ws = a.ws;
    const int v4 = (tid & 31) * 4, kg = tid >> 5;
    const float* S0 = a.state_hgrn + ((size_t)(b * 4 + h) * 128 + 8 * kg) * 128 + v4;
    float* S1 = a.out + O_SS + ((size_t)(b * 4 + h) * 128 + 8 * kg) * 128 + v4;
    f32x4 S[8];
#pragma unroll
    for (int e = 0; e < 8; ++e) S[e] = *(const f32x4*)(S0 + e * 128);
    const size_t rb = (size_t)MP + (size_t)b * 4;
#pragma unroll
    for (int t = 0; t < 4; ++t) {
        const size_t off = ((size_t)h * MT + rb + t) * 128;
        const f32x8 g8 = __builtin_convertvector(*(const h16x8*)((const _Float16*)(ws + WS_R3) + off + 8 * kg), f32x8);
        const f32x4 g0 = {g8[0], g8[1], g8[2], g8[3]}, g1 = {g8[4], g8[5], g8[6], g8[7]};
        const u32x4 kw = *(const u32x4*)((const bf16*)(ws + WS_R2) + off + 8 * kg), qw = *(const u32x4*)((const bf16*)(ws + WS_R1) + off + 8 * kg);
        const u32x2 vw = *(const u32x2*)((const bf16*)(ws + WS_R4) + off + v4);
        const f32x4 vv = {bflo(vw.x), bfhi(vw.x), bflo(vw.y), bfhi(vw.y)};
        const float f[8] = {__expf(g0[0]), __expf(g0[1]), __expf(g0[2]), __expf(g0[3]), __expf(g1[0]), __expf(g1[1]), __expf(g1[2]), __expf(g1[3])};
        const float kk[8] = {bflo(kw.x), bfhi(kw.x), bflo(kw.y), bfhi(kw.y), bflo(kw.z), bfhi(kw.z), bflo(kw.w), bfhi(kw.w)};
        const float qq[8] = {bflo(qw.x), bfhi(qw.x), bflo(qw.y), bfhi(qw.y), bflo(qw.z), bfhi(qw.z), bflo(qw.w), bfhi(qw.w)};
        f32x4 po = {0.f, 0.f, 0.f, 0.f};
#pragma unroll
        for (int e = 0; e < 8; ++e) { S[e] = f[e] * S[e] + kk[e] * vv; po += qq[e] * S[e]; }
        *(f32x4*)(part + (t * 16 + kg) * 128 + v4) = po;
    }
#pragma unroll
    for (int e = 0; e < 8; ++e) *(f32x4*)(S1 + e * 128) = S[e];
    __syncthreads();
    const int t = tid >> 7, v = tid & 127;
    float o = 0.f;
#pragma unroll
    for (int k = 0; k < 16; ++k) o += part[(t * 16 + k) * 128 + v];
    const float s2 = wave_sum(o * o);
    if (lane == 0) wsum[wid] = s2;
    __syncthreads();
    const float rstd = __builtin_amdgcn_rsqf((wsum[2 * t] + wsum[2 * t + 1]) * (1.f / 128.f) + EPS);
    const float y = o * rstd * a.hgrn_norm_w[h * 128 + v] * bf2f(((const bf16*)(ws + WS_R5))[((size_t)h * MT + rb + t) * 128 + v]);
    ((bf16*)(ws + WS_YAS))[((size_t)b * 4 + t) * 512 + h * 128 + v] = (bf16)(pk2(y, 0.f) & 0xffffu);
    __syncthreads();
}


template <int K, int LDW = K> __device__ __forceinline__ f32x4 mini_gemm(const bf16* __restrict__ X, const bf16* __restrict__ W, unsigned char* lds, f32x4 acc) {
    const int tid = threadIdx.x, lane = tid & 63, wid = tid >> 6, i16 = lane & 15, g = lane >> 4, rw = wid & 1, cw = wid >> 1;
    const int sr = tid >> 5, sc = (tid & 31) * 8;
    constexpr int NT = K / 256, P = 264, XB_ = 32 * P * 2, BUF = (32 + 64) * P * 2;
    static_assert(K % 256 == 0, "mini_gemm: K must be a multiple of 256");
    const bf16* xp = X + (size_t)sr * K + sc; const bf16* wp = W + (size_t)sr * LDW + sc;
    u32x4 xr[2], wv[4];
#pragma unroll
    for (int i = 0; i < 2; ++i) xr[i] = *(const u32x4*)(xp + (size_t)(16 * i) * K);
#pragma unroll
    for (int i = 0; i < 4; ++i) wv[i] = *(const u32x4*)(wp + (size_t)(16 * i) * LDW);
    __syncthreads();
#pragma unroll 1
    for (int kt = 0; kt < NT; ++kt) {
        unsigned char* b = lds + (kt & 1) * BUF;
#pragma unroll
        for (int i = 0; i < 2; ++i) *(u32x4*)(b + ((sr + 16 * i) * P + sc) * 2) = xr[i];
#pragma unroll
        for (int i = 0; i < 4; ++i) *(u32x4*)(b + XB_ + ((sr + 16 * i) * P + sc) * 2) = wv[i];
        __syncthreads();
        if (kt + 1 < NT) {
#pragma unroll
            for (int i = 0; i < 2; ++i) xr[i] = *(const u32x4*)(xp + (size_t)(16 * i) * K + 256 * (kt + 1));
#pragma unroll
            for (int i = 0; i < 4; ++i) wv[i] = *(const u32x4*)(wp + (size_t)(16 * i) * LDW + 256 * (kt + 1));
        }
        const bf16* xs = (const bf16*)b + (16 * rw + i16) * P + 8 * g; const bf16* wsm = (const bf16*)(b + XB_) + (16 * cw + i16) * P + 8 * g;
#pragma unroll
        for (int kc = 0; kc < 8; ++kc) acc = MFMA16(*(const bf16x8*)(wsm + 32 * kc), *(const bf16x8*)(xs + 32 * kc), acc);
    }
    return acc;
}
#define SAMPLE_TILE_VARS const int lane = threadIdx.x & 63, wid = threadIdx.x >> 6, i16 = lane & 15, g = lane >> 4; \
    const int row0 = MP + 32 * (tile & 15), colb = 64 * (tile >> 4), row = row0 + 16 * (wid & 1) + i16, col0 = colb + 16 * (wid >> 1); const size_t off = (size_t)row * 1024 + col0 + 4 * g
__device__ __forceinline__ void p5_sample(const Args& a, unsigned char* lds) {
    unsigned char* ws = a.ws;
    for (int tile = blockIdx.x; tile < 256; tile += gridDim.x) {
        SAMPLE_TILE_VARS;
        const f32x4 z = {0.f, 0.f, 0.f, 0.f};
        const f32x4 pa = mini_gemm<512, 1024>((const bf16*)(ws + WS_YAS) + (size_t)(row0 - MP) * 512, (const bf16*)(ws + WS_WOH) + (size_t)colb * 1024, lds, z);
        const f32x4 pb = mini_gemm<512, 1024>((const bf16*)(ws + WS_R10) + (size_t)row0 * 512, (const bf16*)(ws + WS_WOH) + (size_t)colb * 1024 + 512, lds, z);
        const u32x2 ga = *(const u32x2*)((const bf16*)(ws + WS_R8) + off), gb = *(const u32x2*)((const bf16*)(ws + WS_R9) + off);
        u32x2 w; w.x = pk2(bflo(gb.x) * (bflo(ga.x) * pa[0] + pb[0]), bfhi(gb.x) * (bfhi(ga.x) * pa[1] + pb[1])); w.y = pk2(bflo(gb.y) * (bflo(ga.y) * pa[2] + pb[2]), bfhi(gb.y) * (bfhi(ga.y) * pa[3] + pb[3]));
        *(u32x2*)((bf16*)(ws + WS_R3) + off) = w;
    }
    __syncthreads();
}
__device__ __forceinline__ void p6_sample(const Args& a, unsigned char* lds) {
    unsigned char* ws = a.ws;
    for (int tile = blockIdx.x; tile < 256; tile += gridDim.x) {
        SAMPLE_TILE_VARS;
        const f32x4 z = {0.f, 0.f, 0.f, 0.f};
        const f32x4 p = mini_gemm<1024>((const bf16*)(ws + WS_R3) + (size_t)row0 * 1024, (const bf16*)(ws + WS_WOUT) + (size_t)colb * 1024, lds, z);
        const f32x4 v = p + *(const f32x4*)(a.x_sample + off - (size_t)MP * 1024);
        u32x2 w; w.x = pk2(v[0], v[1]); w.y = pk2(v[2], v[3]);
        *(u32x2*)((bf16*)(ws + WS_R8) + off) = w;
        float ss = (v[0] * v[0] + v[1] * v[1]) + (v[2] * v[2] + v[3] * v[3]);
        ss += __shfl_xor(ss, 16); ss += __shfl_xor(ss, 32);
        if (g == 0) atomicAdd((float*)(ws + WS_SUMSQ) + row, ss);
    }
    __syncthreads();
}
__device__ __forceinline__ void p8_sample(const Args& a, unsigned char* lds) {
    unsigned char* ws = a.ws;
    for (int tile = blockIdx.x; tile < 256; tile += gridDim.x) {
        SAMPLE_TILE_VARS;
        const f32x4 z = {0.f, 0.f, 0.f, 0.f};
        const f32x4 p = mini_gemm<DFF>((const bf16*)(ws + WS_R0) + (size_t)row0 * DFF, (const bf16*)(ws + WS_WD) + (size_t)colb * DFF, lds, z);
        const u32x2 xw = *(const u32x2*)((const bf16*)(ws + WS_R8) + off);
        *(f32x4*)(a.out + O_Y + off) = (f32x4){p[0] + bflo(xw.x), p[1] + bfhi(xw.x), p[2] + bflo(xw.y), p[3] + bfhi(xw.y)};
    }
    __syncthreads();
}
#define XB_TMO      128
#define XB_XCNT(j)  (256  + 64 * (j))
#define XB_XSUB(j)  (1280 + 64 * (j))
#define XB_XGEN(j)  (2304 + 64 * (j))
#define XB_TOP      3328
#define XB_TOPGEN   3392
#define XCD_BAR_WORDS 3456
#define XB_SPIN_CAP (1u << 18)

__device__ __forceinline__ unsigned xb_ld(unsigned* p)              { return __hip_atomic_load(p, __ATOMIC_RELAXED, __HIP_MEMORY_SCOPE_AGENT); }
__device__ __forceinline__ unsigned xb_add(unsigned* p, unsigned v) { return __hip_atomic_fetch_add(p, v, __ATOMIC_RELAXED, __HIP_MEMORY_SCOPE_AGENT); }
__device__ __forceinline__ unsigned xb_xcc_id() { return (unsigned)__builtin_amdgcn_s_getreg((3 << 11) | 20) & 0xFu; }
#define XB_SPIN(cond, bar) do { unsigned _sp = 0; while (cond) { __builtin_amdgcn_s_sleep(1); \
    if ((++_sp & 255u) == 0u) { if (xb_ld(&(bar)[XB_TMO])) break; if (_sp > XB_SPIN_CAP) { atomicAdd(&(bar)[XB_TMO], 1u); break; } } } } while (0)

struct XcdBarrier {
    unsigned* bar; unsigned x;
    volatile LAS unsigned* st;
};

__device__ __forceinline__ XcdBarrier xcd_barrier_post(unsigned* bar, volatile LAS unsigned* st) {
    XcdBarrier b; b.bar = bar; b.x = xb_xcc_id(); b.st = st;
    if (threadIdx.x == 0) (void)xb_add(&bar[XB_XCNT(b.x)], 1u);
    return b;
}
__device__ __forceinline__ void xcd_barrier_complete(unsigned* bar, unsigned x, unsigned& nloc, unsigned& nx) {
    const unsigned G = gridDim.x * gridDim.y * gridDim.z;
    unsigned sum, cnt, mine, sp = 0u;
    for (;;) {
        sum = 0u; cnt = 0u; mine = 0u;
#pragma unroll
        for (unsigned j = 0; j < 16; ++j) { const unsigned c = xb_ld(&bar[XB_XCNT(j)]); sum += c; cnt += (c > 0u) ? 1u : 0u; mine = (j == x) ? c : mine; }
        if (sum == G) break;
        __builtin_amdgcn_s_sleep(1);
        if ((++sp & 255u) == 0u) { if (xb_ld(&bar[XB_TMO])) break; if (sp > XB_SPIN_CAP) { atomicAdd(&bar[XB_TMO], 1u); break; } }
    }
    nloc = mine > 0u ? mine : 1u; nx = cnt > 0u ? cnt : 1u;
}

__device__ __forceinline__ void xcd_barrier(const XcdBarrier& b) {
    asm volatile("s_waitcnt vmcnt(0)" ::: "memory");
    __syncthreads();
    if (threadIdx.x == 0) {
        unsigned* bar = b.bar;
        __builtin_amdgcn_s_waitcnt(0);
        unsigned nloc = b.st[0], nx = b.st[1];
        if (nloc == 0u) { xcd_barrier_complete(bar, b.x, nloc, nx); b.st[0] = nloc; b.st[1] = nx; }
        const unsigned old = xb_add(&bar[XB_XSUB(b.x)], 1u);
        const unsigned gen = old / nloc;
        if (old + 1u == (gen + 1u) * nloc) {
            __builtin_amdgcn_fence(__ATOMIC_RELEASE, "agent");
            asm volatile("s_waitcnt vmcnt(0)" ::: "memory");
            const unsigned og = xb_add(&bar[XB_TOP], 1u);
            const unsigned tg = og / nx;
            if (og + 1u == (tg + 1u) * nx) xb_add(&bar[XB_TOPGEN], 1u);
            else XB_SPIN(xb_ld(&bar[XB_TOPGEN]) == tg, bar);
            __builtin_amdgcn_fence(__ATOMIC_ACQUIRE, "agent");
            xb_add(&bar[XB_XGEN(b.x)], 1u);
            asm volatile("s_waitcnt vmcnt(0)" ::: "memory");
        } else {
            XB_SPIN(xb_ld(&bar[XB_XGEN(b.x)]) == gen, bar);
            __builtin_amdgcn_fence(__ATOMIC_ACQUIRE, "agent");
            asm volatile("s_waitcnt vmcnt(0)" ::: "memory");
        }
    }
    __syncthreads();
}


#ifndef PG_ALIGN_BIG
#define PG_ALIGN_BIG true
#endif
#ifndef PG_ALIGN_N1K
#define PG_ALIGN_N1K true
#endif
__global__ void __launch_bounds__(NTHREADS, 2) mk_fwd(Args a) {
    extern __shared__ __attribute__((aligned(16))) unsigned char lds[];
    cg::grid_group grid = cg::this_grid();
    const int lo = a.ph_lo, hi = a.ph_hi, G = gridDim.x, bid = blockIdx.x;
    unsigned char* ws = a.ws;
    LAS unsigned char* ring = (LAS unsigned char*)(LAS void*)lds;
#ifdef PH_MASK
#define IN(k) (((PH_MASK) >> (k)) & 1)
#else
#define IN(k) (lo <= (k) && (k) < hi)
#endif
#ifdef TPROBE_A
#define STAMP(k) do { if (bid == 0 && threadIdx.x == 0) ((volatile unsigned long long*)(lds + 131072 + 64))[k] = __builtin_amdgcn_s_memrealtime(); } while (0)
#else
#define STAMP(k) do { } while (0)
#endif
    if (threadIdx.x < 2) ((volatile LAS unsigned*)(LAS void*)(lds + LDS_BYTES))[threadIdx.x] = 0u;
    __syncthreads();
    XcdBarrier xbar = xcd_barrier_post((unsigned*)(ws + WS_BAR), (volatile LAS unsigned*)(LAS void*)(lds + LDS_BYTES));
#define SEAM(k) do { if (IN(k) && IN((k) + 1)) { if (hi > 1000) grid.sync(); else xcd_barrier(xbar); } STAMP((k) + 1); } while (0)
    STAMP(0);

    constexpr int P1_NWG = (MT / 256) * (PW / 256);
    const int p1_rem = P1_NWG % G;
    if (IN(0)) { p0_prologue(a, lds, (p1_rem != 0 && IN(1)) ? P0_I1 : P0_NITEMS); }
    SEAM(0);
    if (IN(1)) {
        pg8::Gemm g{(const bf16*)(ws + WS_R0), (const bf16*)(ws + WS_W1T), MT, PW, 1024}; pg8::StaticOrder S; S.init(MT, PW, G, bid);
        pg8::EpiProj E{(bf16*)(ws + WS_R1), (bf16*)(ws + WS_R2), (bf16*)(ws + WS_R4), (bf16*)(ws + WS_R5), (bf16*)(ws + WS_R6), (bf16*)(ws + WS_R7), (bf16*)(ws + WS_R8), (bf16*)(ws + WS_R9),
                       (_Float16*)(ws + WS_R3), (const float*)(ws + WS_LBV)};
        pg8::gemm_phase<pg8::EpiProj, pg8::StaticOrder, PG_ALIGN_BIG, true>(ring, g, S, E);
        if (p1_rem != 0 && IN(0) && bid >= p1_rem) p0_weights(a, lds, P0_I1, P0_NITEMS, (bid - p1_rem) * 8 + (int)(threadIdx.x >> 6), (G - p1_rem) * 8);
    }
    SEAM(1);
    if (IN(2)) { hgrn_local_phase(a, lds); }
    SEAM(2);
    if (IN(3)) {
        constexpr int N_ATT = 4 * 64 * 2, N_SAT = DEC_B;
        const int ns = (G >= 128) ? 64 : 0;
        if (G == 256) {
            if (bid < ns) {
                hgrn_scan(a, bid, ns, lds); STAMP(10);
                __syncthreads();
                { const int r = 448 + bid; attn_prompt_item(a, r >> 7, (r >> 1) & 63, r & 1, lds); }
                for (int r = 320 + 3 * bid; r < 320 + 3 * bid + 3; ++r) hgrn_sample_item(a, r >> 2, r & 3, lds);
            } else {
                const int j = bid - ns;
                if (j < 128) { attn_sample_item(a, j, lds);
                    for (int r = 2 * j; r < 2 * j + 2; ++r) attn_prompt_item(a, r >> 7, (r >> 1) & 63, r & 1, lds);
                    for (int r = 2 * j; r < 2 * j + 2; ++r) hgrn_sample_item(a, r >> 2, r & 3, lds); }
                else { for (int r = 256 + 3 * (j - 128); r < 256 + 3 * (j - 128) + 3; ++r) attn_prompt_item(a, r >> 7, (r >> 1) & 63, r & 1, lds);
                    { const int r = 256 + (j - 128); hgrn_sample_item(a, r >> 2, r & 3, lds); } }
            }
        } else {
            if (ns == 0) hgrn_scan(a, bid, G, lds); else if (bid < ns) hgrn_scan(a, bid, ns, lds);
            __syncthreads();
            if (bid >= ns) {
                for (int it = bid - ns; it < N_ATT + N_SAT; it += G - ns) {
                    if (it < N_ATT) attn_prompt_item(a, it >> 7, (it >> 1) & 63, it & 1, lds);
                    else attn_sample_item(a, it - N_ATT, lds);
                }
                for (int r = bid - ns; r < DEC_B * 4; r += G - ns) hgrn_sample_item(a, r >> 2, r & 3, lds);
            }
        }
    }
    SEAM(3);
    if (IN(4)) {
        hgrn_out_phase(a, lds);
    }
    SEAM(4);
    if (IN(5)) {
        p5_sample(a, lds);
        pg8::StaticOrder S; S.init(MP, 1024, G, bid);
        pg8::Gemm g{(const bf16*)(ws + WS_R6), (const bf16*)(ws + WS_WOH), MP, 1024, 1024, (const bf16*)(ws + WS_R10), 512, 8};
        pg8::EpiMerge E{(const bf16*)(ws + WS_R8), (const bf16*)(ws + WS_R9), (bf16*)(ws + WS_R3)};
        pg8::gemm_phase<pg8::EpiMerge, pg8::StaticOrder, PG_ALIGN_N1K, true, true>(ring, g, S, E);
    }
    SEAM(5);
    if (IN(6)) {
        p6_sample(a, lds);
        pg8::Gemm g{(const bf16*)(ws + WS_R3), (const bf16*)(ws + WS_WOUT), MP, 1024, 1024}; pg8::StaticOrder S; S.init(MP, 1024, G, bid);
        pg8::EpiRes1 E{a.x_prompt, (bf16*)(ws + WS_R8), (float*)(ws + WS_SUMSQ)};
        pg8::gemm_phase<pg8::EpiRes1, pg8::StaticOrder, PG_ALIGN_N1K, true>(ring, g, S, E);
    }
    SEAM(6);
    if (IN(7)) {
        pg8::Gemm g{(const bf16*)(ws + WS_R8), (const bf16*)(ws + WS_WGU), MT, 2 * DFF, 1024}; pg8::StaticOrder S; S.init(MT, 2 * DFF, G, bid);
        pg8::EpiFfn E{(const float*)(ws + WS_SUMSQ), (bf16*)(ws + WS_R0)};
        pg8::gemm_phase<pg8::EpiFfn, pg8::StaticOrder, PG_ALIGN_BIG, true>(ring, g, S, E);
    }
    SEAM(7);
    if (IN(8)) {
        p8_sample(a, lds);
        pg8::Gemm g{(const bf16*)(ws + WS_R0), (const bf16*)(ws + WS_WD), MP, 1024, DFF}; pg8::StaticOrder S; S.init(MP, 1024, G, bid);
        pg8::EpiRes2 E{(const bf16*)(ws + WS_R8), a.out + O_Y};
        pg8::gemm_phase<pg8::EpiRes2, pg8::StaticOrder, PG_ALIGN_N1K, true>(ring, g, S, E);
    }
#ifdef TPROBE_A
    {
        grid.sync(); STAMP(9);
        unsigned long long* pw = (unsigned long long*)(ws + WS_MISC + 2048);
        if (bid == 0 && threadIdx.x == 0) { volatile unsigned long long* t = (volatile unsigned long long*)(lds + 131072 + 64);
            pw[0] = (TPROBE_A >= 0) ? t[TPROBE_A + 1] - t[TPROBE_A] : 0ull; pw[1] = (TPROBE_B == 10) ? t[10] - t[3] : t[TPROBE_B + 1] - t[TPROBE_B]; __threadfence(); }
        grid.sync();
        const unsigned long long dA = __hip_atomic_load(pw, __ATOMIC_RELAXED, __HIP_MEMORY_SCOPE_AGENT), dB = __hip_atomic_load(pw + 1, __ATOMIC_RELAXED, __HIP_MEMORY_SCOPE_AGENT);
        const float eps = sqrtf(2e-5f + (float)dB * 0.01f * (float)(TPROBE_KB));
        f32x4* cvs = (f32x4*)(a.out + O_VS);
        for (int i = bid * NTHREADS + threadIdx.x; i < 128 * 128 * 128 / 4; i += G * NTHREADS) cvs[i] = cvs[i] * (1.f + eps);
        const unsigned long long t0 = __builtin_amdgcn_s_memrealtime();
        while (__builtin_amdgcn_s_memrealtime() - t0 < 4ull * dA) __builtin_amdgcn_s_sleep(8);
    }
#endif
#undef IN
#undef SEAM
}

__global__ void dump_ws(const unsigned short* w, float* o, size_t n, size_t tot) {
    for (size_t i = blockIdx.x * (size_t)blockDim.x + threadIdx.x; i < n; i += (size_t)gridDim.x * blockDim.x) { unsigned s = 0; for (size_t j = i; j < tot; j += n) s += w[j]; o[i] = (float)s; }
}
constexpr int N_PHASES = 9;
extern "C" void kernel_launch(void* const* d_in, const int* in_sizes, int n_in, void* d_out, int out_size, void* d_ws, size_t ws_size, hipStream_t stream) {
    static int grid = 0;
    if (grid == 0) {
        if (n_in != 19 || (size_t)out_size != O_END || ws_size < WS_END) { fprintf(stderr, "kernel_launch: unexpected shapes: n_in %d out %d ws %zu (need %zu)\n", n_in, out_size, ws_size, (size_t)WS_END); grid = -1; return; }
        int dev = 0, cus = 0, per_cu = 0;
        if (hipGetDevice(&dev) != hipSuccess || hipDeviceGetAttribute(&cus, hipDeviceAttributeMultiprocessorCount, dev) != hipSuccess) { grid = -1; return; }
        if (hipFuncSetAttribute((const void*)mk_fwd, hipFuncAttributeMaxDynamicSharedMemorySize, LDS_TOTAL) != hipSuccess) { fprintf(stderr, "kernel_launch: hipFuncSetAttribute failed\n"); grid = -1; return; }
        if (hipOccupancyMaxActiveBlocksPerMultiprocessor(&per_cu, (const void*)mk_fwd, NTHREADS, LDS_TOTAL) != hipSuccess || per_cu < 1) { fprintf(stderr, "kernel_launch: occupancy query says %d\n", per_cu); (void)hipGetLastError(); grid = -1; return; }
        grid = cus;
    }
    if (grid < 0) return;
    Args a{};
    const float** ap = (const float**)&a;
    for (int i = 0; i < 19; ++i) ap[i] = (const float*)d_in[i];
    a.out = (float*)d_out; a.ws = (unsigned char*)d_ws;
#if MK_N_LAUNCHES == 1
    if (hipMemsetAsync((char*)d_ws + WS_BAR, 0, XCD_BAR_WORDS * 4, stream) != hipSuccess) { fprintf(stderr, "kernel_launch: memset of the barrier words failed\n"); return; }
    a.ph_lo = 0; a.ph_hi = N_PHASES;
    void* args[] = {&a};
    hipError_t e = hipLaunchCooperativeKernel((const void*)mk_fwd, dim3(grid), dim3(NTHREADS), args, LDS_TOTAL, stream);
    if (e != hipSuccess) fprintf(stderr, "kernel_launch: cooperative launch failed: %s (grid %d)\n", hipGetErrorString(e), grid);
#else
#ifndef PROBE_K
#define PROBE_K 8
#endif
    for (int ph = 0; ph <= PROBE_K; ++ph) {
        a.ph_lo = ph; a.ph_hi = ph + 1;
        hipLaunchKernelGGL(mk_fwd, dim3(grid), dim3(NTHREADS), LDS_TOTAL, stream, a);
    }
#if PROBE_K < 8
    hipLaunchKernelGGL(dump_ws, dim3(2048), dim3(256), 0, stream, (const unsigned short*)d_ws, (float*)d_out, (size_t)out_size, (size_t)(WS_END / 2));
#endif
#endif
}
```

```cpp
#include <hip/hip_runtime.h>
#include <hip/hip_cooperative_groups.h>
#include <cstdio>
#include <cstdint>
namespace cg = cooperative_groups;

#ifndef MK_N_LAUNCHES
#define MK_N_LAUNCHES 1
#endif

constexpr int DM = 1024, SEQ = 8192, NBATCH = 4, MP = NBATCH * SEQ, DEC_B = 128, DEC_T = 4, MS = DEC_B * DEC_T, MT = MP + MS;
constexpr int PW = 4864, DFF = 2816;
constexpr float EPS = 1e-6f;

constexpr size_t UB = (size_t)MT * 512 * 2;
constexpr size_t WS_W1T = 0;
constexpr size_t WS_WOH = WS_W1T + (size_t)PW * DM * 2;
constexpr size_t WS_WOA = WS_WOH + (size_t)1024 * 512 * 2;
constexpr size_t WS_WOUT = WS_WOA + (size_t)1024 * 512 * 2;
constexpr size_t WS_WGU = WS_WOUT + (size_t)1024 * 1024 * 2;
constexpr size_t WS_WD = WS_WGU + (size_t)2 * DFF * DM * 2;
constexpr size_t WS_MISC = WS_WD + (size_t)DM * DFF * 2;
constexpr size_t WS_LBV = WS_MISC;
constexpr size_t WS_SUMSQ = WS_MISC + 4096;
constexpr size_t WS_DT = WS_MISC + 512 * 1024;
constexpr size_t WS_BAR = WS_MISC + 1536 * 1024;
constexpr size_t WS_R0 = (size_t)32 << 20;
constexpr size_t WS_R1 = WS_R0 + 2 * UB;
constexpr size_t WS_R2 = WS_R1 + UB;
constexpr size_t WS_R3 = WS_R2 + UB;
constexpr size_t WS_R4 = WS_R3 + 2 * UB;
constexpr size_t WS_R5 = WS_R4 + UB;
constexpr size_t WS_R6 = WS_R5 + UB;
constexpr size_t WS_R7 = WS_R6 + UB;
constexpr size_t WS_R8 = WS_R7 + UB / 2;
constexpr size_t WS_R9 = WS_R8 + 2 * UB;
constexpr size_t WS_R10 = WS_R9 + 2 * UB;
constexpr size_t WS_YAS = WS_R10 + UB;
constexpr size_t WS_END = WS_YAS + (size_t)MS * 512 * 2;
static_assert(WS_MISC == ((size_t)30 << 20) && WS_END <= ((size_t)512 << 20), "d_ws map");
static_assert((size_t)MT * DFF * 2 <= 6 * UB, "ACT fits R0..R3");

constexpr size_t O_Y = 0;
constexpr size_t O_SP = (size_t)MT * DM;
constexpr size_t O_KP = O_SP + (size_t)4 * 4 * 128 * 128;
constexpr size_t O_VP = O_KP + (size_t)4 * 128 * 128;
constexpr size_t O_SS = O_VP + (size_t)4 * 128 * 128;
constexpr size_t O_KS = O_SS + (size_t)128 * 4 * 128 * 128;
constexpr size_t O_VS = O_KS + (size_t)128 * 128 * 128;
constexpr size_t O_END = O_VS + (size_t)128 * 128 * 128;

constexpr int LDS_BYTES = 131072;
constexpr int LDS_TOTAL = LDS_BYTES + 256;
constexpr int NTHREADS = 512;

#define LAS __attribute__((address_space(3)))
typedef unsigned short bf16;
typedef float f32x4 __attribute__((ext_vector_type(4)));
typedef float f32x2 __attribute__((ext_vector_type(2)));
typedef unsigned u32x4 __attribute__((ext_vector_type(4)));
typedef unsigned u32x2 __attribute__((ext_vector_type(2)));
typedef short bf16x8 __attribute__((ext_vector_type(8)));
typedef short s16x4 __attribute__((ext_vector_type(4)));
typedef _Float16 h16x8 __attribute__((ext_vector_type(8)));
typedef float f32x8 __attribute__((ext_vector_type(8)));

__device__ __forceinline__ float bf2f(unsigned short u) { return __uint_as_float((unsigned)u << 16); }
__device__ __forceinline__ float bflo(unsigned w) { return __uint_as_float(w << 16); }
__device__ __forceinline__ float bfhi(unsigned w) { return __uint_as_float(w & 0xffff0000u); }
typedef __bf16 bf16x2_t __attribute__((ext_vector_type(2)));
__device__ __forceinline__ unsigned pk2(float lo, float hi) { f32x2 v = {lo, hi}; bf16x2_t b = __builtin_convertvector(v, bf16x2_t); return __builtin_bit_cast(unsigned, b); }
__device__ __forceinline__ float sigm(float x) { return __builtin_amdgcn_rcpf(1.f + __expf(-x)); }
__device__ __forceinline__ s16x4 tr_read(const bf16* p) {
    return __builtin_bit_cast(s16x4, __builtin_amdgcn_ds_read_tr16_b64_v4i16((LAS s16x4*)(LAS void*)p));
}
__device__ __forceinline__ bf16x8 cat8(s16x4 a, s16x4 b) { return (bf16x8){a[0], a[1], a[2], a[3], b[0], b[1], b[2], b[3]}; }
__device__ __forceinline__ bf16x8 pk8(f32x4 a, f32x4 b) { u32x4 w; w.x = pk2(a[0], a[1]); w.y = pk2(a[2], a[3]); w.z = pk2(b[0], b[1]); w.w = pk2(b[2], b[3]); return __builtin_bit_cast(bf16x8, w); }
#define MFMA16(a, b, c) __builtin_amdgcn_mfma_f32_16x16x32_bf16((a), (b), (c), 0, 0, 0)

namespace pg8 {
#define PG8_LAS __attribute__((address_space(3)))
typedef unsigned short bf16_t;
typedef short bf16x8 __attribute__((ext_vector_type(8)));
typedef float f32x4 __attribute__((ext_vector_type(4)));
typedef unsigned u32x4 __attribute__((ext_vector_type(4)));
constexpr int BM = 256, BK = 64, HALF = 128, HTB = HALF * BK * 2  , STAGE_BYTES = 8 * HTB, NXCD = 8, WGM = 8;

__host__ __device__ __forceinline__ int lds_byte(int r, int c) { const int st = (r >> 4) * 2 + (c >> 5), rr = r & 15, cc = c & 31, ob = rr * 64 + cc * 2; return st * 1024 + (ob ^ (((ob >> 9) & 1) << 5)); }
__host__ __device__ __forceinline__ void stage_rc(int b, int& R, int& C) { const int st = b / 1024, sb = b % 1024, swz = sb ^ (((sb >> 9) & 1) << 5); R = (st >> 1) * 16 + swz / 64; C = (st & 1) * 32 + (swz % 64) / 2; }
__host__ __device__ __forceinline__ int perm32(int rho) { const int n = rho >> 4, i = rho & 15; return 8 * (i >> 2) + 4 * n + (i & 3); }

struct Unit { int pm, pn; };
struct Gemm { const bf16_t* A; const bf16_t* Bt; int M, N, K; const bf16_t* A2; int lda, kmid; };

struct StaticOrder {
    int nM, nN, nwg, G, c;
    __host__ __device__ void init(int M, int N, int G_, int c_) { nM = M / BM; nN = N / BM; nwg = nM * nN; G = G_; c = c_; }
    __host__ __device__ bool next(int i, Unit& u) const {
        const long L = (long)i * G + c; if (L >= nwg) return false;
        int wgid = (int)L; { const int q = nwg / NXCD, r = nwg % NXCD, xcd = wgid % NXCD, off = wgid / NXCD; wgid = (xcd < r ? xcd * (q + 1) : r * (q + 1) + (xcd - r) * q) + off; }
        const int nig = WGM * nN, gid = wgid / nig, fm = gid * WGM, gsz = (nM - fm) < WGM ? (nM - fm) : WGM;
        u.pm = fm + ((wgid % nig) % gsz); u.pn = (wgid % nig) / gsz; return true;
    }
    __device__ __forceinline__ void a_ready(const Unit&) const {}
    __device__ __forceinline__ void done(const Unit&) const {}
};

__device__ __forceinline__ unsigned cvt_pk_bf16(float lo, float hi) { unsigned r; asm volatile("v_cvt_pk_bf16_f32 %0, %1, %2" : "=v"(r) : "v"(lo), "v"(hi)); return r; }

__device__ __forceinline__ f32x4 vexp2(f32x4 t) { f32x4 r; r[0] = __builtin_amdgcn_exp2f(t[0]); r[1] = __builtin_amdgcn_exp2f(t[1]); r[2] = __builtin_amdgcn_exp2f(t[2]); r[3] = __builtin_amdgcn_exp2f(t[3]); return r; }
__device__ __forceinline__ f32x4 vrcp(f32x4 t) { f32x4 r; r[0] = __builtin_amdgcn_rcpf(t[0]); r[1] = __builtin_amdgcn_rcpf(t[1]); r[2] = __builtin_amdgcn_rcpf(t[2]); r[3] = __builtin_amdgcn_rcpf(t[3]); return r; }
__device__ __forceinline__ f32x4 vlog2(f32x4 t) { f32x4 r; r[0] = __builtin_amdgcn_logf(t[0]); r[1] = __builtin_amdgcn_logf(t[1]); r[2] = __builtin_amdgcn_logf(t[2]); r[3] = __builtin_amdgcn_logf(t[3]); return r; }
__device__ __forceinline__ f32x4 vsig(f32x4 v) { return vrcp(vexp2(v * -1.4426950408889634f) + 1.f); }
struct EpiProj {
    static constexpr bool PERM = true, AFTER_DRAIN = false; static constexpr size_t MTR = 33280;
    bf16_t *QH, *KH, *VH, *OG, *QA, *KV, *GA, *GB; _Float16* GH; const float* lbv;
    __device__ __forceinline__ void operator()(const f32x4 (&acc)[2][2][4][2], const Unit& u, int wr, int wc, int fr, int fq) const {
        const int pn = u.pn; int mode, ld, cb; bf16_t* dst; float sc = 1.f; bool hm = false;
        if (pn < 2)        { mode = 1; dst = QH; ld = 512;  cb = pn * 256; sc = 0.08838834764831845f; hm = true; }
        else if (pn < 4)   { mode = 3; dst = KH; ld = 512;  cb = (pn - 2) * 256; hm = true; }
        else if (pn < 6)   { mode = 0; dst = VH; ld = 512;  cb = (pn - 4) * 256; hm = true; }
        else if (pn < 8)   { mode = 1; dst = OG; ld = 512;  cb = (pn - 6) * 256; hm = true; }
        else if (pn < 10)  { mode = 0; dst = QA; ld = 512;  cb = (pn - 8) * 256; }
        else if (pn == 10) { mode = 0; dst = KV; ld = 256;  cb = 0; }
        else               { mode = 4; dst = GA; ld = 1024; cb = (pn - 11) * 128; }
        const int row0 = u.pm * BM + wr * 64 + fr, col0 = cb + wc * 32 + 8 * fq;
        if (mode == 4) {
#pragma unroll
            for (int ai = 0; ai < 2; ++ai)
#pragma unroll
                for (int m = 0; m < 4; ++m) {
                    const size_t off = (size_t)(row0 + ai * HALF + m * 16) * 1024 + col0;
                    const f32x4 A0 = vexp2(acc[ai][0][m][0] * -1.4426950408889634f) + 1.f, A1 = vexp2(acc[ai][0][m][1] * -1.4426950408889634f) + 1.f;
                    const f32x4 B0 = vexp2(acc[ai][1][m][0] * -1.4426950408889634f) + 1.f, B1 = vexp2(acc[ai][1][m][1] * -1.4426950408889634f) + 1.f;
                    const f32x4 s0 = vrcp(B0), s1 = vrcp(B1), r0 = B0 * vrcp(A0), r1 = B1 * vrcp(A1);
                    u32x4 w; w.x = pk2(r0[0], r0[1]); w.y = pk2(r0[2], r0[3]); w.z = pk2(r1[0], r1[1]); w.w = pk2(r1[2], r1[3]);
                    *(u32x4*)(GA + off) = w;
                    w.x = pk2(s0[0], s0[1]); w.y = pk2(s0[2], s0[3]); w.z = pk2(s1[0], s1[1]); w.w = pk2(s1[2], s1[3]);
                    *(u32x4*)(GB + off) = w;
                }
            return;
        }
#pragma unroll
        for (int bj = 0; bj < 2; ++bj) {
            const int col = col0 + bj * HALF;
            f32x4 l0 = {0.f, 0.f, 0.f, 0.f}, l1 = l0;
            if (mode == 3) { l0 = *(const f32x4*)(lbv + col); l1 = *(const f32x4*)(lbv + col + 4); }
#pragma unroll
            for (int ai = 0; ai < 2; ++ai)
#pragma unroll
                for (int m = 0; m < 4; ++m) {
                    const size_t row = (size_t)(row0 + ai * HALF + m * 16);
                    f32x4 v0 = acc[ai][bj][m][0], v1 = acc[ai][bj][m][1];
                    if (mode == 1) {
                        v0 = (v0 * sc) * vsig(v0); v1 = (v1 * sc) * vsig(v1);
                    } else if (mode == 3) {
                        const f32x4 f0 = l0 + (1.f - l0) * vsig(v0), f1 = l1 + (1.f - l1) * vsig(v1);
                        const f32x4 g0 = vlog2(f0) * 0.6931471805599453f, g1 = vlog2(f1) * 0.6931471805599453f;
                        v0 = 1.f - f0; v1 = 1.f - f1;
                        const f32x8 g8 = {g0[0], g0[1], g0[2], g0[3], g1[0], g1[1], g1[2], g1[3]};
                        *(h16x8*)(GH + ((size_t)(col >> 7) * MTR + row) * 128 + (col & 127)) = __builtin_convertvector(g8, h16x8);
                    }
                    u32x4 w; w.x = pk2(v0[0], v0[1]); w.y = pk2(v0[2], v0[3]); w.z = pk2(v1[0], v1[1]); w.w = pk2(v1[2], v1[3]);
                    *(u32x4*)(dst + (hm ? ((size_t)(col >> 7) * MTR + row) * 128 + (col & 127) : row * ld + col)) = w;
                }
        }
    }
};
template <bool ADD> struct EpiGate {
    static constexpr bool PERM = true, AFTER_DRAIN = false;
    const bf16_t* gate; const bf16_t* T; bf16_t* O;
    __device__ __forceinline__ void operator()(const f32x4 (&acc)[2][2][4][2], const Unit& u, int wr, int wc, int fr, int fq) const {
        const int row0 = u.pm * BM + wr * 64 + fr, col0 = u.pn * BM + wc * 32 + 8 * fq;
#pragma unroll
        for (int ai = 0; ai < 2; ++ai)
#pragma unroll
            for (int m = 0; m < 4; ++m)
#pragma unroll
                for (int bj = 0; bj < 2; ++bj) {
                    const size_t off = (size_t)(row0 + ai * HALF + m * 16) * 1024 + col0 + bj * HALF;
                    const u32x4 gw = *(const u32x4*)(gate + off);
                    f32x4 v0 = acc[ai][bj][m][0], v1 = acc[ai][bj][m][1];
                    v0[0] *= bflo(gw.x); v0[1] *= bfhi(gw.x); v0[2] *= bflo(gw.y); v0[3] *= bfhi(gw.y);
                    v1[0] *= bflo(gw.z); v1[1] *= bfhi(gw.z); v1[2] *= bflo(gw.w); v1[3] *= bfhi(gw.w);
                    if (ADD) { const u32x4 tw = *(const u32x4*)(T + off);
                        v0[0] += bflo(tw.x); v0[1] += bfhi(tw.x); v0[2] += bflo(tw.y); v0[3] += bfhi(tw.y);
                        v1[0] += bflo(tw.z); v1[1] += bfhi(tw.z); v1[2] += bflo(tw.w); v1[3] += bfhi(tw.w); }
                    u32x4 w; w.x = pk2(v0[0], v0[1]); w.y = pk2(v0[2], v0[3]); w.z = pk2(v1[0], v1[1]); w.w = pk2(v1[2], v1[3]);
                    *(u32x4*)(O + off) = w;
                }
    }
};
struct EpiMerge {
    static constexpr bool PERM = true, AFTER_DRAIN = false;
    const bf16_t* GA; const bf16_t* GB; bf16_t* O;
    __device__ __forceinline__ void mid(f32x4 (&acc)[2][2][4][2], const Unit& u, int wr, int wc, int fr, int fq) const {
        int lane_ = (int)(threadIdx.x & 63); asm volatile("" : "+v"(lane_));
        const int row0 = u.pm * BM + wr * 64 + (lane_ & 15), col0 = u.pn * BM + wc * 32 + 8 * (lane_ >> 4);
#pragma unroll
        for (int ai = 0; ai < 2; ++ai)
#pragma unroll
            for (int m = 0; m < 4; ++m)
#pragma unroll
                for (int bj = 0; bj < 2; ++bj) {
                    const u32x4 a = *(const u32x4*)(GA + (size_t)(row0 + ai * HALF + m * 16) * 1024 + col0 + bj * HALF);
                    acc[ai][bj][m][0] = acc[ai][bj][m][0] * (f32x4){bflo(a.x), bfhi(a.x), bflo(a.y), bfhi(a.y)};
                    acc[ai][bj][m][1] = acc[ai][bj][m][1] * (f32x4){bflo(a.z), bfhi(a.z), bflo(a.w), bfhi(a.w)};
                    if (m == 3 && bj == 1) __builtin_amdgcn_sched_barrier(0);
                }
    }
    __device__ __forceinline__ void operator()(const f32x4 (&acc)[2][2][4][2], const Unit& u, int wr, int wc, int fr, int fq) const {
        const int row0 = u.pm * BM + wr * 64 + fr, col0 = u.pn * BM + wc * 32 + 8 * fq;
#pragma unroll
        for (int ai = 0; ai < 2; ++ai)
#pragma unroll
            for (int m = 0; m < 4; ++m)
#pragma unroll
                for (int bj = 0; bj < 2; ++bj) {
                    const size_t off = (size_t)(row0 + ai * HALF + m * 16) * 1024 + col0 + bj * HALF;
                    const u32x4 gw = *(const u32x4*)(GB + off);
                    const f32x4 v0 = acc[ai][bj][m][0], v1 = acc[ai][bj][m][1];
                    u32x4 w; w.x = pk2(v0[0] * bflo(gw.x), v0[1] * bfhi(gw.x)); w.y = pk2(v0[2] * bflo(gw.y), v0[3] * bfhi(gw.y));
                    w.z = pk2(v1[0] * bflo(gw.z), v1[1] * bfhi(gw.z)); w.w = pk2(v1[2] * bflo(gw.w), v1[3] * bfhi(gw.w));
                    *(u32x4*)(O + off) = w;
                }
    }
};
struct EpiRes1 {
    static constexpr bool PERM = true, AFTER_DRAIN = false;
    const float* xp; bf16_t* X1B; float* sumsq;
    __device__ __forceinline__ void operator()(const f32x4 (&acc)[2][2][4][2], const Unit& u, int wr, int wc, int fr, int fq) const {
        const int row0 = u.pm * BM + wr * 64 + fr, col0 = u.pn * BM + wc * 32 + 8 * fq;
#pragma unroll
        for (int ai = 0; ai < 2; ++ai)
#pragma unroll
            for (int m = 0; m < 4; ++m) {
                const int row = row0 + ai * HALF + m * 16; float ss = 0.f;
#pragma unroll
                for (int bj = 0; bj < 2; ++bj) {
                    const size_t off = (size_t)row * 1024 + col0 + bj * HALF;
                    const f32x4 v0 = acc[ai][bj][m][0] + *(const f32x4*)(xp + off), v1 = acc[ai][bj][m][1] + *(const f32x4*)(xp + off + 4);
                    ss += (v0[0] * v0[0] + v0[1] * v0[1]) + (v0[2] * v0[2] + v0[3] * v0[3]) + (v1[0] * v1[0] + v1[1] * v1[1]) + (v1[2] * v1[2] + v1[3] * v1[3]);
                    u32x4 w; w.x = pk2(v0[0], v0[1]); w.y = pk2(v0[2], v0[3]); w.z = pk2(v1[0], v1[1]); w.w = pk2(v1[2], v1[3]);
                    *(u32x4*)(X1B + off) = w;
                }
                ss += __shfl_xor(ss, 16); ss += __shfl_xor(ss, 32);
                if (fq == 0) atomicAdd(sumsq + row, ss);
            }
    }
};
struct EpiFfn {
    static constexpr bool PERM = true, AFTER_DRAIN = false;
    const float* sumsq; bf16_t* ACT;
    __device__ __forceinline__ void operator()(const f32x4 (&acc)[2][2][4][2], const Unit& u, int wr, int wc, int fr, int fq) const {
        const int row0 = u.pm * BM + wr * 64 + fr, col0 = u.pn * HALF + wc * 32 + 8 * fq;
        float sq[2][4];
#pragma unroll
        for (int ai = 0; ai < 2; ++ai)
#pragma unroll
            for (int m = 0; m < 4; ++m) sq[ai][m] = sumsq[row0 + ai * HALF + m * 16];
#pragma unroll
        for (int ai = 0; ai < 2; ++ai)
#pragma unroll
            for (int m = 0; m < 4; ++m) {
                const int row = row0 + ai * HALF + m * 16;
                const float r = __builtin_amdgcn_rsqf(sq[ai][m] * (1.f / 1024.f) + 1e-6f);
                const float nrl = r * -1.4426950408889634f, r2 = r * r;
                f32x4 o[2];
#pragma unroll
                for (int n = 0; n < 2; ++n) {
                    const f32x4 g = acc[ai][0][m][n], uu = acc[ai][1][m][n];
                    const f32x4 t = g * nrl;
                    f32x4 ex; ex[0] = __builtin_amdgcn_exp2f(t[0]); ex[1] = __builtin_amdgcn_exp2f(t[1]); ex[2] = __builtin_amdgcn_exp2f(t[2]); ex[3] = __builtin_amdgcn_exp2f(t[3]);
                    const f32x4 d = ex + 1.f;
                    f32x4 s; s[0] = __builtin_amdgcn_rcpf(d[0]); s[1] = __builtin_amdgcn_rcpf(d[1]); s[2] = __builtin_amdgcn_rcpf(d[2]); s[3] = __builtin_amdgcn_rcpf(d[3]);
                    o[n] = (g * uu) * (s * r2);
                }
                u32x4 w; w.x = pk2(o[0][0], o[0][1]); w.y = pk2(o[0][2], o[0][3]); w.z = pk2(o[1][0], o[1][1]); w.w = pk2(o[1][2], o[1][3]);
                *(u32x4*)(ACT + (size_t)row * 2816 + col0) = w;
            }
    }
};
struct EpiRes2 {
    static constexpr bool PERM = true, AFTER_DRAIN = false;
    const bf16_t* X1B; float* out;
    __device__ __forceinline__ void operator()(const f32x4 (&acc)[2][2][4][2], const Unit& u, int wr, int wc, int fr, int fq) const {
        const int row0 = u.pm * BM + wr * 64 + fr, col0 = u.pn * BM + wc * 32 + 8 * fq;
#pragma unroll
        for (int ai = 0; ai < 2; ++ai)
#pragma unroll
            for (int m = 0; m < 4; ++m)
#pragma unroll
                for (int bj = 0; bj < 2; ++bj) {
                    const size_t off = (size_t)(row0 + ai * HALF + m * 16) * 1024 + col0 + bj * HALF;
                    const u32x4 xw = *(const u32x4*)(X1B + off);
                    const f32x4 v0 = acc[ai][bj][m][0] + (f32x4){bflo(xw.x), bfhi(xw.x), bflo(xw.y), bfhi(xw.y)}, v1 = acc[ai][bj][m][1] + (f32x4){bflo(xw.z), bfhi(xw.z), bflo(xw.w), bfhi(xw.w)};
                    *(f32x4*)(out + off) = v0; *(f32x4*)(out + off + 4) = v1;
                }
    }
};
template <class Epi, class Sched, bool ALIGN_EPI = false, bool SP2 = false, bool MID = false>
__device__ __forceinline__ void gemm_phase(PG8_LAS unsigned char* lds, const Gemm g, const Sched& S, const Epi& E) {
    const int tid = threadIdx.x, wid = __builtin_amdgcn_readfirstlane(tid >> 6), lane = tid & 63, wr = wid >> 2, wc = wid & 3, fr = lane & 15, fq = lane >> 4;
    const int K = g.K, nt = K / BK;
    const int lda = g.lda ? g.lda : K, kmid = g.kmid ? g.kmid : nt;
    unsigned voffA[2], voffB[2];
#pragma unroll
    for (int i = 0; i < 2; ++i) { int R, C; stage_rc(tid * 16 + i * 8192, R, C); const int Rb = Epi::PERM ? ((R & ~31) + perm32(R & 31)) : R;
        voffA[i] = (unsigned)(R * lda + C) * 2u; voffB[i] = (unsigned)(Rb * K + C) * 2u; }
    const size_t kstep = (size_t)(BK * 2);
    const size_t hstepA = (size_t)HALF * lda * 2, hstepB = (size_t)HALF * K * 2;
    const size_t tstepA = 2 * hstepA, tstepB = 2 * hstepB;
    const long dA2 = g.A2 ? ((const char*)g.A2 - (const char*)g.A) - (long)kmid * (long)kstep : 0l;
    const unsigned ldsw = (unsigned)wid * 1024u;
    const int aoff = lds_byte(wr * 64 + fr, fq * 8), boff = lds_byte(wc * 32 + fr, fq * 8);
#define PG8_SA(b, h) (((b) * 2 + (h)) * HTB)
#define PG8_SB(b, h) ((4 + (b) * 2 + (h)) * HTB)
#define PG8_STAGE(bufoff, gbase, voff) do { _Pragma("unroll") for (int _i = 0; _i < 2; ++_i) \
        __builtin_amdgcn_global_load_lds((const unsigned*)((const char*)(gbase) + (voff)[_i]), (PG8_LAS unsigned*)(lds + (bufoff) + ldsw + _i * 8192), 16, 0, 0); } while (0)
#define PG8_LDA(dst, b, h) do { _Pragma("unroll") for (int m = 0; m < 4; ++m) _Pragma("unroll") for (int k = 0; k < 2; ++k) dst[m][k] = *(const PG8_LAS bf16x8*)(lds + PG8_SA(b, h) + aoff + m * 2048 + k * 1024); } while (0)
#define PG8_LDB(dst, b, h) do { _Pragma("unroll") for (int n = 0; n < 2; ++n) _Pragma("unroll") for (int k = 0; k < 2; ++k) dst[n][k] = *(const PG8_LAS bf16x8*)(lds + PG8_SB(b, h) + boff + n * 2048 + k * 1024); } while (0)
#define PG8_MMA(ai, bj, At, Bt) do { __builtin_amdgcn_s_setprio(1); _Pragma("unroll") for (int m = 0; m < 4; ++m) _Pragma("unroll") for (int n = 0; n < 2; ++n) _Pragma("unroll") for (int k = 0; k < 2; ++k) \
        acc[ai][bj][m][n] = __builtin_amdgcn_mfma_f32_16x16x32_bf16(Bt[n][k], At[m][k], acc[ai][bj][m][n], 0, 0, 0); __builtin_amdgcn_s_setprio(0); } while (0)
#define PG8_WAIT_V(n) asm volatile("s_waitcnt vmcnt(" #n ")" ::: "memory")
#define PG8_WAIT_L(n) asm volatile("s_waitcnt lgkmcnt(" #n ")" ::: "memory")
#define PG8_BAR __builtin_amdgcn_s_barrier()
#define PG8_SCHED __builtin_amdgcn_sched_barrier(0)
    Unit cur, nxt; int ui = 0;
    if (!S.next(0, cur)) return;
    f32x4 acc[2][2][4][2];
#pragma unroll
    for (int a = 0; a < 2; ++a)
#pragma unroll
        for (int b = 0; b < 2; ++b)
#pragma unroll
            for (int m = 0; m < 4; ++m)
#pragma unroll
                for (int n = 0; n < 2; ++n) acc[a][b][m][n] = (f32x4){0.f, 0.f, 0.f, 0.f};
    bf16x8 At[4][2], B0[2][2], B1[2][2];
    const char* cA = (const char*)g.A + (size_t)cur.pm * tstepA; const char* cB = (const char*)g.Bt + (size_t)cur.pn * tstepB;
    S.a_ready(cur);
    if constexpr (SP2) {
        PG8_STAGE(PG8_SB(0, 0), cB, voffB); PG8_STAGE(PG8_SB(0, 1), cB + hstepB, voffB); PG8_STAGE(PG8_SA(0, 0), cA, voffA); PG8_STAGE(PG8_SA(0, 1), cA + hstepA, voffA);
        if (wr == 1) PG8_BAR;
        PG8_WAIT_V(2); PG8_BAR;
        PG8_STAGE(PG8_SB(1, 0), cB + kstep, voffB); PG8_STAGE(PG8_SA(1, 0), cA + kstep, voffA); PG8_STAGE(PG8_SB(1, 1), cB + hstepB + kstep, voffB);
        PG8_WAIT_V(6); PG8_BAR;
    } else {
        PG8_STAGE(PG8_SB(0, 0), cB, voffB); PG8_STAGE(PG8_SA(0, 0), cA, voffA); PG8_STAGE(PG8_SB(0, 1), cB + hstepB, voffB); PG8_STAGE(PG8_SA(0, 1), cA + hstepA, voffA);
        if (wr == 1) PG8_BAR;
        PG8_WAIT_V(4); PG8_BAR;
        PG8_STAGE(PG8_SB(1, 0), cB + kstep, voffB); PG8_STAGE(PG8_SA(1, 0), cA + kstep, voffA); PG8_STAGE(PG8_SB(1, 1), cB + hstepB + kstep, voffB);
        PG8_WAIT_V(6); PG8_BAR;
    }
    for (;;) {
        const bool has_next = S.next(ui + 1, nxt);
        const char* nA = has_next ? (const char*)g.A + (size_t)nxt.pm * tstepA : cA; const char* nB = has_next ? (const char*)g.Bt + (size_t)nxt.pn * tstepB : cB;
        for (int t = 0; t < nt; t += 2) {
            const bool last = (t == nt - 2);
            const char* a1 = cA + ((t + 1 < kmid) ? 0l : dA2) + (size_t)(t + 1) * kstep;
            const char* a2 = last ? nA : cA + ((t + 2 < kmid) ? 0l : dA2) + (size_t)(t + 2) * kstep; const char* b2 = last ? nB : cB + (size_t)(t + 2) * kstep;
            if constexpr (MID) { if (t == kmid) E.mid(acc, cur, wr, wc, fr, fq); }
            const char* a3 = a2 + kstep; const char* b3 = b2 + kstep;
            if (last && has_next) S.a_ready(nxt);
            if constexpr (SP2) {
            PG8_LDB(B0, 0, 0); PG8_LDB(B1, 0, 1); PG8_SCHED; PG8_LDA(At, 0, 0); PG8_STAGE(PG8_SA(1, 1), a1 + hstepA, voffA);
            PG8_WAIT_V(8); PG8_WAIT_L(0); PG8_BAR; PG8_MMA(0, 0, At, B0); PG8_MMA(0, 1, At, B1); PG8_BAR; PG8_SCHED;
            PG8_LDA(At, 0, 1); PG8_STAGE(PG8_SB(0, 0), b2, voffB); PG8_STAGE(PG8_SB(0, 1), b2 + hstepB, voffB); PG8_STAGE(PG8_SA(0, 0), a2, voffA);
            PG8_WAIT_V(8); PG8_WAIT_L(0); PG8_BAR; PG8_MMA(1, 0, At, B0); PG8_MMA(1, 1, At, B1); PG8_BAR; PG8_SCHED;
            PG8_LDB(B0, 1, 0); PG8_LDB(B1, 1, 1); PG8_SCHED; PG8_LDA(At, 1, 0); PG8_STAGE(PG8_SA(0, 1), a2 + hstepA, voffA);
            PG8_WAIT_V(8); PG8_WAIT_L(0); PG8_BAR; PG8_MMA(0, 0, At, B0); PG8_MMA(0, 1, At, B1); PG8_BAR; PG8_SCHED;
            PG8_LDA(At, 1, 1); PG8_STAGE(PG8_SB(1, 0), b3, voffB); PG8_STAGE(PG8_SB(1, 1), b3 + hstepB, voffB); PG8_STAGE(PG8_SA(1, 0), a3, voffA);
            PG8_WAIT_V(8); PG8_WAIT_L(0); PG8_BAR; PG8_MMA(1, 0, At, B0); PG8_MMA(1, 1, At, B1); PG8_BAR; PG8_SCHED;
            } else {
            PG8_LDB(B0, 0, 0); PG8_SCHED; PG8_LDA(At, 0, 0); PG8_STAGE(PG8_SA(1, 1), a1 + hstepA, voffA);
            PG8_WAIT_L(8); PG8_BAR; PG8_WAIT_L(0); PG8_MMA(0, 0, At, B0); PG8_BAR; PG8_SCHED;
            PG8_LDB(B1, 0, 1); PG8_STAGE(PG8_SB(0, 0), b2, voffB);
            PG8_BAR; PG8_WAIT_L(0); PG8_MMA(0, 1, At, B1); PG8_BAR;
            PG8_LDA(At, 0, 1); PG8_STAGE(PG8_SA(0, 0), a2, voffA);
            PG8_BAR; PG8_WAIT_L(0); PG8_MMA(1, 0, At, B0); PG8_BAR; PG8_SCHED;
            PG8_STAGE(PG8_SB(0, 1), b2 + hstepB, voffB);
            PG8_WAIT_V(6); PG8_BAR; PG8_MMA(1, 1, At, B1); PG8_BAR;
            PG8_LDB(B0, 1, 0); PG8_SCHED; PG8_LDA(At, 1, 0); PG8_STAGE(PG8_SA(0, 1), a2 + hstepA, voffA);
            PG8_WAIT_L(8); PG8_BAR; PG8_WAIT_L(0); PG8_MMA(0, 0, At, B0); PG8_BAR; PG8_SCHED;
            PG8_LDB(B1, 1, 1); PG8_STAGE(PG8_SB(1, 0), b3, voffB);
            PG8_BAR; PG8_WAIT_L(0); PG8_MMA(0, 1, At, B1); PG8_BAR;
            PG8_LDA(At, 1, 1); PG8_STAGE(PG8_SA(1, 0), a3, voffA);
            PG8_BAR; PG8_WAIT_L(0); PG8_MMA(1, 0, At, B0); PG8_BAR; PG8_SCHED;
            PG8_STAGE(PG8_SB(1, 1), b3 + hstepB, voffB);
            PG8_WAIT_V(6); PG8_BAR; PG8_MMA(1, 1, At, B1); PG8_BAR;
            }
        }
        if constexpr (ALIGN_EPI) { if (wr == 0) PG8_BAR; }
        if constexpr (!Epi::AFTER_DRAIN) { E(acc, cur, wr, wc, fr, fq); S.done(cur); }
        if (!has_next) break;
#pragma unroll
        for (int a = 0; a < 2; ++a)
#pragma unroll
            for (int b = 0; b < 2; ++b)
#pragma unroll
                for (int m = 0; m < 4; ++m)
#pragma unroll
                    for (int n = 0; n < 2; ++n) acc[a][b][m][n] = (f32x4){0.f, 0.f, 0.f, 0.f};
        cur = nxt; cA = nA; cB = nB; ++ui;
        if constexpr (ALIGN_EPI) { if (wr == 1) PG8_BAR; }
    }
    PG8_WAIT_V(0);
    if constexpr (!ALIGN_EPI) { if (wr == 0) PG8_BAR; }
    PG8_BAR;
    if constexpr (Epi::AFTER_DRAIN) { E.fused(acc, cur, wr, wc, fr, fq, lds, wid, lane); S.done(cur); }
#undef PG8_SA
#undef PG8_SB
#undef PG8_STAGE
#undef PG8_LDA
#undef PG8_LDB
#undef PG8_MMA
#undef PG8_WAIT_V
#undef PG8_WAIT_L
#undef PG8_BAR
#undef PG8_SCHED
}
}

struct Args {
    const float *x_prompt, *x_sample, *state_hgrn, *cache_k, *cache_v, *norm1_w, *w_in, *lb_logits, *hgrn_norm_w, *q_norm_w, *k_norm_w, *sinks,
                *w_o_hgrn, *w_o_attn, *w_out, *norm2_w, *w_ffn_gate, *w_ffn_up, *w_ffn_down;
    float* out; unsigned char* ws; int ph_lo, ph_hi;
};

__device__ __forceinline__ float wave_sum(float v) {
#pragma unroll
    for (int o = 1; o < 64; o <<= 1) v += __shfl_xor(v, o);
    return v;
}

__device__ __forceinline__ void p0_transpose_item(const float* __restrict__ W, int ldw, int K, bf16* WT, int k0, int n0, int drow0, const float* __restrict__ ks, LAS float* scr, int lane, int kofs = 0) {
    float wv[32];
#pragma unroll
    for (int i = 0; i < 32; ++i) wv[i] = W[(size_t)(k0 + 2 * i + (lane >> 5)) * ldw + n0 + (lane & 31)];
#pragma unroll
    for (int i = 0; i < 32; ++i) { const int kk = 2 * i + (lane >> 5); const float s = ks ? ks[k0 + kk] : 1.f; scr[kk * 33 + (lane & 31)] = wv[i] * s; }
    asm volatile("s_waitcnt lgkmcnt(0)" ::: "memory");
    const int c = lane & 7;
#pragma unroll
    for (int j = 0; j < 4; ++j) { const int n = (lane >> 3) + 8 * j; const LAS float* s = scr + (8 * c) * 33 + n;
        u32x4 o; o.x = pk2(s[0 * 33], s[1 * 33]); o.y = pk2(s[2 * 33], s[3 * 33]); o.z = pk2(s[4 * 33], s[5 * 33]); o.w = pk2(s[6 * 33], s[7 * 33]);
        *(u32x4*)(WT + (size_t)(drow0 + n) * K + kofs + k0 + 8 * c) = o; }
    asm volatile("s_waitcnt lgkmcnt(0)" ::: "memory");
}

constexpr int P0_I1 = 16 * 152, P0_NITEMS = 16 * 152 + 2 * 8 * 32 + 16 * 32 + 2 * 16 * 88 + 44 * 32;
__device__ __forceinline__ void p0_weights(const Args& a, unsigned char* lds, int it_lo, int it_hi, int widx, int nwork) {
    const int tid = threadIdx.x, lane = tid & 63, wave = tid >> 6;
    LAS float* scr = (LAS float*)(LAS void*)(lds + wave * 16384);
    unsigned char* ws = a.ws;
    constexpr int I1 = 16 * 152, I2 = 8 * 32, I4 = 16 * 32, I5 = 16 * 88;
    for (int it = it_lo + widx; it < it_hi; it += nwork) {
        int r = it;
        if (r < I1) { const int n0 = 32 * (r % 152);
            const int dr = n0 < 2816 ? n0 : (n0 < 3840 ? 2816 + ((n0 - 2816) >> 7) * 256 + ((n0 - 2816) & 127) : 2816 + ((n0 - 3840) >> 7) * 256 + 128 + ((n0 - 3840) & 127));
            p0_transpose_item(a.w_in, PW, 1024, (bf16*)(ws + WS_W1T), 64 * (r / 152), n0, dr, a.norm1_w, scr, lane); continue; } r -= I1;
        if (r < I2) { p0_transpose_item(a.w_o_hgrn, 1024, 1024, (bf16*)(ws + WS_WOH), 64 * (r / 32), 32 * (r % 32), 32 * (r % 32), nullptr, scr, lane, 0); continue; } r -= I2;
        if (r < I2) { p0_transpose_item(a.w_o_attn, 1024, 1024, (bf16*)(ws + WS_WOH), 64 * (r / 32), 32 * (r % 32), 32 * (r % 32), nullptr, scr, lane, 512); continue; } r -= I2;
        if (r < I4) { p0_transpose_item(a.w_out, 1024, 1024, (bf16*)(ws + WS_WOUT), 64 * (r / 32), 32 * (r % 32), 32 * (r % 32), nullptr, scr, lane); continue; } r -= I4;
        if (r < I5) { const int n0 = 32 * (r % 88); p0_transpose_item(a.w_ffn_gate, DFF, 1024, (bf16*)(ws + WS_WGU), 64 * (r / 88), n0, (n0 >> 7) * 256 + (n0 & 127), a.norm2_w, scr, lane); continue; } r -= I5;
        if (r < I5) { const int n0 = 32 * (r % 88); p0_transpose_item(a.w_ffn_up, DFF, 1024, (bf16*)(ws + WS_WGU), 64 * (r / 88), n0, (n0 >> 7) * 256 + 128 + (n0 & 127), a.norm2_w, scr, lane); continue; } r -= I5;
        p0_transpose_item(a.w_ffn_down, 1024, DFF, (bf16*)(ws + WS_WD), 64 * (r / 32), 32 * (r % 32), 32 * (r % 32), nullptr, scr, lane);
    }
}
__device__ __forceinline__ void p0_prologue(const Args& a, unsigned char* lds, int w_hi) {
    const int tid = threadIdx.x, lane = tid & 63, wave = tid >> 6;
    const int gw = blockIdx.x * 8 + wave, NGW = gridDim.x * 8;
    unsigned char* ws = a.ws;
    p0_weights(a, lds, 0, w_hi, gw, NGW);
    bf16* XB = (bf16*)(ws + WS_R0);
    for (int m = gw; m < MT; m += 2 * NGW) {
        const int m1 = m + NGW; const bool has1 = m1 < MT;
        const float* xrow0 = (m < MP) ? a.x_prompt + (size_t)m * 1024 : a.x_sample + (size_t)(m - MP) * 1024;
        const float* xrow1 = !has1 ? xrow0 : (m1 < MP) ? a.x_prompt + (size_t)m1 * 1024 : a.x_sample + (size_t)(m1 - MP) * 1024;
        const f32x4* xr0 = (const f32x4*)xrow0 + lane; const f32x4* xr1 = (const f32x4*)xrow1 + lane;
        f32x4 v[4], u[4]; float s0 = 0.f, s1 = 0.f;
#pragma unroll
        for (int j = 0; j < 4; ++j) { v[j] = xr0[64 * j]; u[j] = xr1[64 * j]; }
#pragma unroll
        for (int j = 0; j < 4; ++j) { s0 += (v[j][0] * v[j][0] + v[j][1] * v[j][1]) + (v[j][2] * v[j][2] + v[j][3] * v[j][3]); s1 += (u[j][0] * u[j][0] + u[j][1] * u[j][1]) + (u[j][2] * u[j][2] + u[j][3] * u[j][3]); }
        const float r0 = __builtin_amdgcn_rsqf(wave_sum(s0) * (1.f / 1024.f) + EPS), r1 = __builtin_amdgcn_rsqf(wave_sum(s1) * (1.f / 1024.f) + EPS);
        u32x2* o0 = (u32x2*)(XB + (size_t)m * 1024) + lane; u32x2* o1 = (u32x2*)(XB + (size_t)m1 * 1024) + lane;
#pragma unroll
        for (int j = 0; j < 4; ++j) { u32x2 w; w.x = pk2(v[j][0] * r0, v[j][1] * r0); w.y = pk2(v[j][2] * r0, v[j][3] * r0); o0[64 * j] = w; }
        if (has1) {
#pragma unroll
            for (int j = 0; j < 4; ++j) { u32x2 w; w.x = pk2(u[j][0] * r1, u[j][1] * r1); w.y = pk2(u[j][2] * r1, u[j][3] * r1); o1[64 * j] = w; }
        }
    }
    float* sumsq = (float*)(ws + WS_SUMSQ);
    for (int i = blockIdx.x * NTHREADS + tid; i < MT; i += gridDim.x * NTHREADS) sumsq[i] = 0.f;
    if (blockIdx.x == 0) { float* lbv = (float*)(ws + WS_LBV); lbv[tid] = sigm(a.lb_logits[tid] - a.lb_logits[512 + tid]); }
}

__device__ __forceinline__ void hgrn_local_phase(const Args& a, unsigned char* lds) {
    const int tid = threadIdx.x, lane = tid & 63, wid = tid >> 6, G = gridDim.x;
    float* cumS = (float*)lds; float* segT = (float*)(lds + 32768); bf16* KdS = (bf16*)(lds + 34816); bf16* VS = (bf16*)(lds + 52224);
    unsigned char* ws = a.ws;
    constexpr int N_LOC = 512 * 4;
    h16x8 gr[2]; u32x4 vr[2];
    int it = blockIdx.x;
#define HL_LOAD(IT) do { const size_t r0_ = (size_t)((IT) >> 2) * 64; const int h_ = (IT) & 3; \
        const size_t ho_ = ((size_t)h_ * MT + r0_) * 128; const _Float16* G_ = (const _Float16*)(ws + WS_R3) + ho_; const bf16* V_ = (const bf16*)(ws + WS_R4) + ho_; \
        _Pragma("unroll") for (int i = 0; i < 2; ++i) { const int idx = tid + 512 * i; gr[i] = *(const h16x8*)(G_ + 8 * idx); } \
        _Pragma("unroll") for (int i = 0; i < 2; ++i) { const int idx = tid + 512 * i; vr[i] = *(const u32x4*)(V_ + 8 * idx); } } while (0)
    if (it < N_LOC) HL_LOAD(it);
    for (; it < N_LOC; it += G) {
        const int cidx = it >> 2, h = it & 3;
        const size_t r0 = (size_t)cidx * 64;
        bf16* Gp = (bf16*)(ws + WS_R3) + ((size_t)h * MT + r0) * 128;
#pragma unroll
        for (int i = 0; i < 2; ++i) { const int idx = tid + 512 * i; const f32x8 g8 = __builtin_convertvector(gr[i], f32x8);
            *(f32x4*)(cumS + 8 * idx) = (f32x4){g8[0], g8[1], g8[2], g8[3]}; *(f32x4*)(cumS + 8 * idx + 4) = (f32x4){g8[4], g8[5], g8[6], g8[7]}; }
        __syncthreads();
        {
            const int k = tid & 127, seg = tid >> 7; float v[16]; float run = 0.f;
#pragma unroll
            for (int i = 0; i < 16; ++i) { run += cumS[(seg * 16 + i) * 128 + k]; v[i] = run; }
            segT[seg * 128 + k] = run;
            __syncthreads();
            float off = 0.f;
#pragma unroll
            for (int s = 0; s < 3; ++s) off += (s < seg) ? segT[s * 128 + k] : 0.f;
#pragma unroll
            for (int i = 0; i < 16; ++i) cumS[(seg * 16 + i) * 128 + k] = v[i] + off;
        }
        __syncthreads();
#pragma unroll
        for (int i = 0; i < 2; ++i) { const int idx = tid + 512 * i;
            const f32x4 ca = *(const f32x4*)(cumS + 8 * idx), cb = *(const f32x4*)(cumS + 8 * idx + 4);
            u32x4 w; w.x = pk2(__expf(ca[0]), __expf(ca[1])); w.y = pk2(__expf(ca[2]), __expf(ca[3])); w.z = pk2(__expf(cb[0]), __expf(cb[1])); w.w = pk2(__expf(cb[2]), __expf(cb[3]));
            *(u32x4*)(Gp + 8 * idx) = w; }
        if (tid < 128) ((float*)(ws + WS_DT))[(size_t)(cidx * 4 + h) * 128 + tid] = __expf(cumS[63 * 128 + tid]);
#pragma unroll
        for (int i = 0; i < 2; ++i) {
            const int idx = tid + 512 * i, j = idx >> 4, k8 = (idx & 15) * 8;
            const f32x4 c0 = *(const f32x4*)(cumS + j * 128 + k8), c1 = *(const f32x4*)(cumS + j * 128 + k8 + 4);
            const f32x4 z4 = {0.f, 0.f, 0.f, 0.f};
            const f32x4 p0 = j ? *(const f32x4*)(cumS + (j - 1) * 128 + k8) : z4, p1 = j ? *(const f32x4*)(cumS + (j - 1) * 128 + k8 + 4) : z4;
            const f32x4 l0 = *(const f32x4*)(cumS + 63 * 128 + k8), l1 = *(const f32x4*)(cumS + 63 * 128 + k8 + 4);
            float kk[8];
#pragma unroll
            for (int x = 0; x < 4; ++x) { kk[x] = 1.f - __expf(c0[x] - p0[x]); kk[4 + x] = 1.f - __expf(c1[x] - p1[x]); }
            u32x4 w;
            w.x = pk2(kk[0] * __expf(l0[0] - c0[0]), kk[1] * __expf(l0[1] - c0[1]));
            w.y = pk2(kk[2] * __expf(l0[2] - c0[2]), kk[3] * __expf(l0[3] - c0[3]));
            w.z = pk2(kk[4] * __expf(l1[0] - c1[0]), kk[5] * __expf(l1[1] - c1[1]));
            w.w = pk2(kk[6] * __expf(l1[2] - c1[2]), kk[7] * __expf(l1[3] - c1[3]));
            *(u32x4*)(KdS + j * 136 + k8) = w;
            *(u32x4*)(VS + j * 136 + k8) = vr[i];
        }
        __syncthreads();
        if (it + G < N_LOC) HL_LOAD(it + G);
        {
            const int i16 = lane & 15, g = lane >> 4, q = i16 >> 2, p = i16 & 3;
            bf16x8 af[2];
#pragma unroll
            for (int jc = 0; jc < 2; ++jc) af[jc] = cat8(tr_read(KdS + (32 * jc + 8 * g + q) * 136 + 16 * wid + 4 * p), tr_read(KdS + (32 * jc + 8 * g + 4 + q) * 136 + 16 * wid + 4 * p));
            bf16* SLT = (bf16*)(ws + WS_R0) + (size_t)(cidx * 4 + h) * 16384;
#pragma unroll
            for (int nt = 0; nt < 8; ++nt) {
                f32x4 acc = {0.f, 0.f, 0.f, 0.f};
#pragma unroll
                for (int jc = 0; jc < 2; ++jc) {
                    const bf16x8 bfr = cat8(tr_read(VS + (32 * jc + 8 * g + q) * 136 + 16 * nt + 4 * p), tr_read(VS + (32 * jc + 8 * g + 4 + q) * 136 + 16 * nt + 4 * p));
                    acc = MFMA16(af[jc], bfr, acc);
                }
                u32x2 w; w.x = pk2(acc[0], acc[1]); w.y = pk2(acc[2], acc[3]);
                *(u32x2*)(SLT + (size_t)(16 * nt + i16) * 128 + 16 * wid + 4 * g) = w;
            }
        }
        __syncthreads();
    }
#undef HL_LOAD
}

__device__ __forceinline__ void attn_prompt_item(const Args& a, int b, int qb, int kvh, unsigned char* lds) {
    const int tid = threadIdx.x, lane = tid & 63, wid = __builtin_amdgcn_readfirstlane(tid >> 6);
    bf16* KS = (bf16*)lds; bf16* VS = (bf16*)(lds + 36864);
    unsigned char* ws = a.ws;
    const bf16* QA = (const bf16*)(ws + WS_R6); const bf16* KV = (const bf16*)(ws + WS_R7); bf16* YB = (bf16*)(ws + WS_R10);
    {
        const int key = tid >> 1, half = tid & 1;
        u32x4 kw[4], vw[4];
        const bool zero = (qb == 0 && key < 128);
        const size_t row = (size_t)b * SEQ + (size_t)(qb - 1) * 128 + key;
#pragma unroll
        for (int c = 0; c < 4; ++c) {
            if (zero) { kw[c] = (u32x4){0u, 0u, 0u, 0u}; vw[c] = kw[c]; }
            else { kw[c] = *(const u32x4*)(KV + row * 256 + kvh * 64 + half * 32 + 8 * c); vw[c] = *(const u32x4*)(KV + row * 256 + 128 + kvh * 64 + half * 32 + 8 * c); }
        }
        float ss = 0.f;
#pragma unroll
        for (int c = 0; c < 4; ++c) { const float e0 = bflo(kw[c].x), e1 = bfhi(kw[c].x), e2 = bflo(kw[c].y), e3 = bfhi(kw[c].y), e4 = bflo(kw[c].z), e5 = bfhi(kw[c].z), e6 = bflo(kw[c].w), e7 = bfhi(kw[c].w);
            ss += (e0 * e0 + e1 * e1) + (e2 * e2 + e3 * e3) + (e4 * e4 + e5 * e5) + (e6 * e6 + e7 * e7); }
        ss += __shfl_xor(ss, 1);
        const float rstd = __builtin_amdgcn_rsqf(ss * (1.f / 64.f) + EPS);
        const bool wr_cache = (qb == SEQ / 128 - 1) && key >= 128;
        float* ck = a.out + O_KP + ((size_t)(b * 128 + (key - 128)) * 2 + kvh) * 64 + half * 32;
        float* cv = a.out + O_VP + ((size_t)(b * 128 + (key - 128)) * 2 + kvh) * 64 + half * 32;
#pragma unroll
        for (int c = 0; c < 4; ++c) {
            const f32x4 w0 = *(const f32x4*)(a.k_norm_w + half * 32 + 8 * c), w1 = *(const f32x4*)(a.k_norm_w + half * 32 + 8 * c + 4);
            f32x4 n0, n1;
            n0[0] = bflo(kw[c].x) * rstd * w0[0]; n0[1] = bfhi(kw[c].x) * rstd * w0[1]; n0[2] = bflo(kw[c].y) * rstd * w0[2]; n0[3] = bfhi(kw[c].y) * rstd * w0[3];
            n1[0] = bflo(kw[c].z) * rstd * w1[0]; n1[1] = bfhi(kw[c].z) * rstd * w1[1]; n1[2] = bflo(kw[c].w) * rstd * w1[2]; n1[3] = bfhi(kw[c].w) * rstd * w1[3];
            u32x4 w; w.x = pk2(n0[0], n0[1]); w.y = pk2(n0[2], n0[3]); w.z = pk2(n1[0], n1[1]); w.w = pk2(n1[2], n1[3]);
            *(u32x4*)(KS + key * 72 + half * 32 + 8 * c) = w;
            *(u32x4*)(VS + key * 72 + half * 32 + 8 * c) = vw[c];
            if (wr_cache) {
                *(f32x4*)(ck + 8 * c) = n0; *(f32x4*)(ck + 8 * c + 4) = n1;
                *(f32x4*)(cv + 8 * c) = (f32x4){bflo(vw[c].x), bfhi(vw[c].x), bflo(vw[c].y), bfhi(vw[c].y)};
                *(f32x4*)(cv + 8 * c + 4) = (f32x4){bflo(vw[c].z), bfhi(vw[c].z), bflo(vw[c].w), bfhi(vw[c].w)};
            }
        }
    }
    __syncthreads();
    const int i16 = lane & 15, g = lane >> 4, q = i16 >> 2, p = i16 & 3;
    const int qt = wid, t0 = qt > 0 ? qt - 1 : 0;
    const size_t row = (size_t)b * SEQ + (size_t)qb * 128 + 16 * qt + i16;
    f32x4 dl2[10];
    {
        const int qz = (qb == 0) ? -1 : 0, band0 = 16 * t0 + 4 * g, dist0 = 128 + 16 * qt + i16 - band0;
#pragma unroll
        for (int t = 0; t < 10; ++t)
#pragma unroll
            for (int r = 0; r < 4; ++r) {
                const int band = band0 + 16 * t + r, dist = dist0 - 16 * t - r;
                const int msk = ((dist | (127 - dist)) >> 31) | (((band - 128) >> 31) & qz);
                dl2[t][r] = msk ? 1e30f : (float)dist * 1.4426950408889634f;
            }
    }
    u32x4 qnx[2];
    qnx[0] = *(const u32x4*)(QA + row * 512 + kvh * 256 + 8 * g); qnx[1] = *(const u32x4*)(QA + row * 512 + kvh * 256 + 32 + 8 * g);
#pragma unroll 1
    for (int g4 = 0; g4 < 4; ++g4) {
        asm volatile("" ::: "memory");
        const int hq = kvh * 4 + g4;
        bf16x8 bq[2];
        {
            u32x4 qw[2]; float ss = 0.f;
            qw[0] = qnx[0]; qw[1] = qnx[1];
            if (g4 < 3) { qnx[0] = *(const u32x4*)(QA + row * 512 + (hq + 1) * 64 + 8 * g); qnx[1] = *(const u32x4*)(QA + row * 512 + (hq + 1) * 64 + 32 + 8 * g); }
#pragma unroll
            for (int c = 0; c < 2; ++c) {
                const float e0 = bflo(qw[c].x), e1 = bfhi(qw[c].x), e2 = bflo(qw[c].y), e3 = bfhi(qw[c].y), e4 = bflo(qw[c].z), e5 = bfhi(qw[c].z), e6 = bflo(qw[c].w), e7 = bfhi(qw[c].w);
                ss += (e0 * e0 + e1 * e1) + (e2 * e2 + e3 * e3) + (e4 * e4 + e5 * e5) + (e6 * e6 + e7 * e7); }
            ss += __shfl_xor(ss, 16); ss += __shfl_xor(ss, 32);
            const float rstd = __builtin_amdgcn_rsqf(ss * (1.f / 64.f) + EPS);
#pragma unroll
            for (int c = 0; c < 2; ++c) {
                const f32x4 w0 = *(const f32x4*)(a.q_norm_w + 32 * c + 8 * g), w1 = *(const f32x4*)(a.q_norm_w + 32 * c + 8 * g + 4);
                u32x4 w;
                w.x = pk2(bflo(qw[c].x) * rstd * w0[0], bfhi(qw[c].x) * rstd * w0[1]); w.y = pk2(bflo(qw[c].y) * rstd * w0[2], bfhi(qw[c].y) * rstd * w0[3]);
                w.z = pk2(bflo(qw[c].z) * rstd * w1[0], bfhi(qw[c].z) * rstd * w1[1]); w.w = pk2(bflo(qw[c].w) * rstd * w1[2], bfhi(qw[c].w) * rstd * w1[3]);
                bq[c] = __builtin_bit_cast(bf16x8, w);
            }
        }
        const float nslope = -exp2f(-(float)(hq + 1)), sink2 = a.sinks[hq] * 1.4426950408889634f;
        f32x4 sc[10]; float mx = -3.0e38f;
#pragma unroll
        for (int t = 0; t < 10; ++t) {
            f32x4 s = {0.f, 0.f, 0.f, 0.f};
#pragma unroll
            for (int c = 0; c < 2; ++c) s = MFMA16(*(const bf16x8*)(KS + (16 * (t0 + t) + i16) * 72 + 32 * c + 8 * g), bq[c], s);
            s = s * (0.125f * 1.4426950408889634f) + dl2[t] * nslope;
            mx = fmaxf(mx, fmaxf(fmaxf(s[0], s[1]), fmaxf(s[2], s[3])));
            sc[t] = s;
        }
        mx = fmaxf(mx, __shfl_xor(mx, 16)); mx = fmaxf(mx, __shfl_xor(mx, 32)); mx = fmaxf(mx, sink2);
        f32x4 sum4 = {0.f, 0.f, 0.f, 0.f};
#pragma unroll
        for (int t = 0; t < 10; ++t) {
            const f32x4 d = sc[t] - mx; f32x4 ev;
            ev[0] = __builtin_amdgcn_exp2f(d[0]); ev[1] = __builtin_amdgcn_exp2f(d[1]); ev[2] = __builtin_amdgcn_exp2f(d[2]); ev[3] = __builtin_amdgcn_exp2f(d[3]);
            sc[t] = ev; sum4 += ev;
        }
        float sum = (sum4[0] + sum4[1]) + (sum4[2] + sum4[3]);
        sum += __shfl_xor(sum, 16); sum += __shfl_xor(sum, 32);
        const float inv = 1.f / (sum + __builtin_amdgcn_exp2f(sink2 - mx));
        bf16x8 pb[5];
#pragma unroll
        for (int ch = 0; ch < 5; ++ch) pb[ch] = pk8(sc[2 * ch], sc[2 * ch + 1]);
#pragma unroll
        for (int dt = 0; dt < 4; ++dt) {
            f32x4 acc = {0.f, 0.f, 0.f, 0.f};
#pragma unroll
            for (int ch = 0; ch < 5; ++ch) {
                const bf16x8 av = cat8(tr_read(VS + (16 * (t0 + 2 * ch) + 4 * g + q) * 72 + 16 * dt + 4 * p), tr_read(VS + (16 * (t0 + 2 * ch + 1) + 4 * g + q) * 72 + 16 * dt + 4 * p));
                acc = MFMA16(av, pb[ch], acc);
            }
            u32x2 w; w.x = pk2(acc[0] * inv, acc[1] * inv); w.y = pk2(acc[2] * inv, acc[3] * inv);
            *(u32x2*)(YB + row * 512 + hq * 64 + 16 * dt + 4 * g) = w;
        }
    }
    __syncthreads();
}

__device__ __forceinline__ void attn_sample_item(const Args& a, int b, unsigned char* lds) {
    const int tid = threadIdx.x;
    float* qn = (float*)lds; float* knew = (float*)(lds + 8192); float* vnew = (float*)(lds + 10240); float* sc = (float*)(lds + 12288); float* invs = (float*)(lds + 29696); float* cb = (float*)(lds + 32768);
    unsigned char* ws = a.ws;
    const bf16* QA = (const bf16*)(ws + WS_R6); const bf16* KV = (const bf16*)(ws + WS_R7); bf16* YB = (bf16*)(ws + WS_R10);
    const size_t rb = (size_t)MP + (size_t)b * 4;
    const float* ck = a.cache_k + (size_t)b * 16384; const float* cv = a.cache_v + (size_t)b * 16384;
    f32x4 kreg[8];
#pragma unroll
    for (int i = 0; i < 8; ++i) kreg[i] = *(const f32x4*)(ck + 4 * (tid + 512 * i));
    {
        const int pair = tid >> 4, d4 = (tid & 15) * 4, hq = pair >> 2, t = pair & 3;
        const u32x2 w = *(const u32x2*)(QA + (rb + t) * 512 + hq * 64 + d4);
        const float e0 = bflo(w.x), e1 = bfhi(w.x), e2 = bflo(w.y), e3 = bfhi(w.y);
        float ss = (e0 * e0 + e1 * e1) + (e2 * e2 + e3 * e3);
        ss += __shfl_xor(ss, 1); ss += __shfl_xor(ss, 2); ss += __shfl_xor(ss, 4); ss += __shfl_xor(ss, 8);
        const float rstd = __builtin_amdgcn_rsqf(ss * (1.f / 64.f) + EPS);
        const f32x4 nw = *(const f32x4*)(a.q_norm_w + d4);
        *(f32x4*)(qn + pair * 64 + d4) = (f32x4){e0 * rstd * nw[0], e1 * rstd * nw[1], e2 * rstd * nw[2], e3 * rstd * nw[3]};
    }
    if (tid < 128) {
        const int t = tid >> 5, kvh = (tid >> 4) & 1, d4 = (tid & 15) * 4;
        const u32x2 w = *(const u32x2*)(KV + (rb + t) * 256 + kvh * 64 + d4);
        const float e0 = bflo(w.x), e1 = bfhi(w.x), e2 = bflo(w.y), e3 = bfhi(w.y);
        float ss = (e0 * e0 + e1 * e1) + (e2 * e2 + e3 * e3);
        ss += __shfl_xor(ss, 1); ss += __shfl_xor(ss, 2); ss += __shfl_xor(ss, 4); ss += __shfl_xor(ss, 8);
        const float rstd = __builtin_amdgcn_rsqf(ss * (1.f / 64.f) + EPS);
        const f32x4 nw = *(const f32x4*)(a.k_norm_w + d4);
        *(f32x4*)(knew + t * 128 + kvh * 64 + d4) = (f32x4){e0 * rstd * nw[0], e1 * rstd * nw[1], e2 * rstd * nw[2], e3 * rstd * nw[3]};
        const u32x2 v = *(const u32x2*)(KV + (rb + t) * 256 + 128 + kvh * 64 + d4);
        *(f32x4*)(vnew + t * 128 + kvh * 64 + d4) = (f32x4){bflo(v.x), bfhi(v.x), bflo(v.y), bfhi(v.y)};
    }
    {
        float* ok = a.out + O_KS + (size_t)b * 16384;
#pragma unroll
        for (int i = 0; i < 8; ++i) { const int f = 4 * (tid + 512 * i); *(f32x4*)(cb + f) = kreg[i];
            if (f >= 512) *(f32x4*)(ok + f - 512) = kreg[i]; }
    }
    __syncthreads();
    if (tid < 128) { const int f = 4 * tid;
        *(f32x4*)(a.out + O_KS + (size_t)b * 16384 + 124 * 128 + f) = *(const f32x4*)(knew + f); *(f32x4*)(a.out + O_VS + (size_t)b * 16384 + 124 * 128 + f) = *(const f32x4*)(vnew + f); }
    for (int idx = tid; idx < 132 * 32; idx += 512) {
        const int key = idx >> 5, pair = idx & 31, hq = pair >> 2, t = pair & 3, kvh = hq >> 2;
        const float* qp = qn + pair * 64; float dot = 0.f;
        const float* kp = key < 128 ? cb + (key * 2 + kvh) * 64 : knew + (key - 128) * 128 + kvh * 64;
#pragma unroll
        for (int d = 0; d < 64; d += 4) { const f32x4 kk = *(const f32x4*)(kp + d), qq = *(const f32x4*)(qp + d); dot += (kk[0] * qq[0] + kk[1] * qq[1]) + (kk[2] * qq[2] + kk[3] * qq[3]); }
        const int dist = key < 128 ? t + 128 - key : t - (key - 128);
        const bool valid = dist >= 0 && dist < 128;
        sc[pair * 136 + key] = valid ? dot * 0.125f - exp2f(-(float)(hq + 1)) * (float)dist : -1e30f;
    }
    __syncthreads();
    f32x4 vreg[8];
#pragma unroll
    for (int i = 0; i < 8; ++i) vreg[i] = *(const f32x4*)(cv + 4 * (tid + 512 * i));
    {
        const int pair = tid >> 4, l16 = tid & 15, hq = pair >> 2; const float sink = a.sinks[hq];
        float mx = -3.0e38f;
        for (int key = l16; key < 132; key += 16) mx = fmaxf(mx, sc[pair * 136 + key]);
        mx = fmaxf(mx, __shfl_xor(mx, 1)); mx = fmaxf(mx, __shfl_xor(mx, 2)); mx = fmaxf(mx, __shfl_xor(mx, 4)); mx = fmaxf(mx, __shfl_xor(mx, 8));
        mx = fmaxf(mx, sink);
        float sum = 0.f;
        for (int key = l16; key < 132; key += 16) { const float e = __expf(sc[pair * 136 + key] - mx); sc[pair * 136 + key] = e; sum += e; }
        sum += __shfl_xor(sum, 1); sum += __shfl_xor(sum, 2); sum += __shfl_xor(sum, 4); sum += __shfl_xor(sum, 8);
        if (l16 == 0) invs[pair] = 1.f / (sum + __expf(sink - mx));
    }
    { float* ov = a.out + O_VS + (size_t)b * 16384;
#pragma unroll
      for (int i = 0; i < 8; ++i) { const int f = 4 * (tid + 512 * i); *(f32x4*)(cb + f) = vreg[i]; if (f >= 512) *(f32x4*)(ov + f - 512) = vreg[i]; } }
    __syncthreads();
    {
        const int pair = tid >> 4, d4 = (tid & 15) * 4, hq = pair >> 2, t = pair & 3, kvh = hq >> 2;
        f32x4 acc = {0.f, 0.f, 0.f, 0.f};
#pragma unroll 8
        for (int key = 0; key < 128; ++key) { const float pv = sc[pair * 136 + key]; acc += pv * *(const f32x4*)(cb + (key * 2 + kvh) * 64 + d4); }
#pragma unroll
        for (int key = 0; key < 4; ++key) { const float pv = sc[pair * 136 + 128 + key]; acc += pv * *(const f32x4*)(vnew + key * 128 + kvh * 64 + d4); }
        const float inv = invs[pair];
        u32x2 w; w.x = pk2(acc[0] * inv, acc[1] * inv); w.y = pk2(acc[2] * inv, acc[3] * inv);
        *(u32x2*)(YB + (rb + t) * 512 + hq * 64 + d4) = w;
    }
    __syncthreads();
}

__device__ __forceinline__ void hgrn_scan(const Args& a, int sb, int ns, unsigned char* lds) {
    unsigned char* ws = a.ws;
    bf16* SLT = (bf16*)(ws + WS_R0); const float* DT = (const float*)(ws + WS_DT);
    float* dts = (float*)lds;
    for (int e0 = sb * NTHREADS; e0 < 4 * 4 * 128 * 16; e0 += ns * NTHREADS) {
        const int e = e0 + threadIdx.x;
        const int k8 = (e & 15) * 8, v = (e >> 4) & 127, h = (e0 >> 11) & 3, b = e0 >> 13;
        __syncthreads();
#pragma unroll
        for (int i = 0; i < 8; ++i) { const int idx = threadIdx.x + 512 * i, c = idx >> 5, k4 = (idx & 31) * 4; *(f32x4*)(dts + c * 128 + k4) = *(const f32x4*)(DT + (size_t)((b * 128 + c) * 4 + h) * 128 + k4); }
        __syncthreads();
        float st[8];
#pragma unroll
        for (int j = 0; j < 8; ++j) st[j] = 0.f;
        for (int c0 = 0; c0 < 128; c0 += 16) {
            u32x4 loc[16];
#pragma unroll
            for (int i = 0; i < 16; ++i) { const size_t ci = (size_t)((b * 128 + c0 + i) * 4 + h); loc[i] = *(const u32x4*)(SLT + (ci * 128 + v) * 128 + k8); }
#pragma unroll
            for (int i = 0; i < 16; ++i) { const size_t ci = (size_t)((b * 128 + c0 + i) * 4 + h);
                const f32x4 d0 = *(const f32x4*)(dts + (c0 + i) * 128 + k8), d1 = *(const f32x4*)(dts + (c0 + i) * 128 + k8 + 4);
                u32x4 w; w.x = pk2(st[0], st[1]); w.y = pk2(st[2], st[3]); w.z = pk2(st[4], st[5]); w.w = pk2(st[6], st[7]);
                *(u32x4*)(SLT + (ci * 128 + v) * 128 + k8) = w;
                st[0] = d0[0] * st[0] + bflo(loc[i].x); st[1] = d0[1] * st[1] + bfhi(loc[i].x); st[2] = d0[2] * st[2] + bflo(loc[i].y); st[3] = d0[3] * st[3] + bfhi(loc[i].y);
                st[4] = d1[0] * st[4] + bflo(loc[i].z); st[5] = d1[1] * st[5] + bfhi(loc[i].z); st[6] = d1[2] * st[6] + bflo(loc[i].w); st[7] = d1[3] * st[7] + bfhi(loc[i].w); }
        }
        float* o = a.out + O_SP + ((size_t)(b * 4 + h) * 128 + k8) * 128 + v;
#pragma unroll
        for (int j = 0; j < 8; ++j) o[j * 128] = st[j];
    }
}

__device__ __forceinline__ void hgrn_out_phase(const Args& a, unsigned char* lds) {
    const int tid = threadIdx.x, lane = tid & 63, wid = tid >> 6, G = gridDim.x;
    bf16* QdS = (bf16*)lds; bf16* KxS = (bf16*)(lds + 17408); bf16* VS = (bf16*)(lds + 34816); bf16* SS = (bf16*)(lds + 52224); float* red = (float*)(lds + 87040);
    unsigned char* ws = a.ws;
    constexpr int N_OUT = 512 * 4;
    u32x4 er[2], qr[2], kr[2], vr[2], sr[4];
#define HO_LOAD(IT) do { const size_t r0_ = (size_t)((IT) >> 2) * 64; const int h_ = (IT) & 3; \
        const size_t ho_ = ((size_t)h_ * MT + r0_) * 128; const bf16* CU_ = (const bf16*)(ws + WS_R3) + ho_; const bf16* Q_ = (const bf16*)(ws + WS_R1) + ho_; \
        const bf16* K_ = (const bf16*)(ws + WS_R2) + ho_; const bf16* V_ = (const bf16*)(ws + WS_R4) + ho_; const bf16* S_ = (const bf16*)(ws + WS_R0) + (size_t)(IT) * 16384; \
        _Pragma("unroll") for (int i = 0; i < 2; ++i) { const int idx = tid + 512 * i; \
            er[i] = *(const u32x4*)(CU_ + 8 * idx); \
            qr[i] = *(const u32x4*)(Q_ + 8 * idx); kr[i] = *(const u32x4*)(K_ + 8 * idx); vr[i] = *(const u32x4*)(V_ + 8 * idx); } \
        _Pragma("unroll") for (int i = 0; i < 4; ++i) { const int idx = tid + 512 * i, v = idx >> 4, c8 = (idx & 15) * 8; sr[i] = *(const u32x4*)(S_ + (size_t)v * 128 + c8); } } while (0)
    int it = blockIdx.x;
    if (it < N_OUT) HO_LOAD(it);
    for (; it < N_OUT; it += G) {
        const int cidx = it >> 2, h = it & 3;
        const size_t r0 = (size_t)cidx * 64;
        const bf16* OG = (const bf16*)(ws + WS_R5) + ((size_t)h * MT + r0) * 128;
        bf16* YA = (bf16*)(ws + WS_R6) + r0 * 512 + h * 128;
#pragma unroll
        for (int i = 0; i < 2; ++i) {
            const int idx = tid + 512 * i, j = idx >> 4, k8 = (idx & 15) * 8;
            const u32x4 ew = er[i], qw = qr[i], kw = kr[i];
            const float e[8] = {bflo(ew.x), bfhi(ew.x), bflo(ew.y), bfhi(ew.y), bflo(ew.z), bfhi(ew.z), bflo(ew.w), bfhi(ew.w)};
            float ei[8];
#pragma unroll
            for (int x = 0; x < 8; ++x) ei[x] = __builtin_amdgcn_rcpf(e[x]);
            u32x4 w;
            w.x = pk2(bflo(qw.x) * e[0], bfhi(qw.x) * e[1]); w.y = pk2(bflo(qw.y) * e[2], bfhi(qw.y) * e[3]); w.z = pk2(bflo(qw.z) * e[4], bfhi(qw.z) * e[5]); w.w = pk2(bflo(qw.w) * e[6], bfhi(qw.w) * e[7]);
            *(u32x4*)(QdS + j * 136 + k8) = w;
            w.x = pk2(bflo(kw.x) * ei[0], bfhi(kw.x) * ei[1]); w.y = pk2(bflo(kw.y) * ei[2], bfhi(kw.y) * ei[3]); w.z = pk2(bflo(kw.z) * ei[4], bfhi(kw.z) * ei[5]); w.w = pk2(bflo(kw.w) * ei[6], bfhi(kw.w) * ei[7]);
            *(u32x4*)(KxS + j * 136 + k8) = w;
            *(u32x4*)(VS + j * 136 + k8) = vr[i];
        }
#pragma unroll
        for (int i = 0; i < 4; ++i) { const int idx = tid + 512 * i, v = idx >> 4, c8 = (idx & 15) * 8; *(u32x4*)(SS + v * 136 + c8) = sr[i]; }
        __syncthreads();
        const int i16 = lane & 15, g = lane >> 4, q = i16 >> 2, p = i16 & 3, tt = wid & 3, vh = wid >> 2;
        u32x2 ogr[4];
#pragma unroll
        for (int vt = 0; vt < 4; ++vt) ogr[vt] = *(const u32x2*)(OG + (size_t)(16 * tt + i16) * 128 + vh * 64 + 16 * vt + 4 * g);
        if (it + G < N_OUT) HO_LOAD(it + G);
        bf16x8 bq[4];
#pragma unroll
        for (int kc = 0; kc < 4; ++kc) bq[kc] = *(const bf16x8*)(QdS + (16 * tt + i16) * 136 + 32 * kc + 8 * g);
        f32x4 sc[4];
#pragma unroll
        for (int jt = 0; jt < 4; ++jt) {
            f32x4 sv = {0.f, 0.f, 0.f, 0.f};
            if (jt <= tt) {
#pragma unroll
                for (int kc = 0; kc < 4; ++kc) sv = MFMA16(*(const bf16x8*)(KxS + (16 * jt + i16) * 136 + 32 * kc + 8 * g), bq[kc], sv);
                if (jt == tt) {
#pragma unroll
                    for (int r = 0; r < 4; ++r) sv[r] = (4 * g + r > i16) ? 0.f : sv[r];
                }
            }
            sc[jt] = sv;
        }
        bf16x8 pb[2];
        pb[0] = pk8(sc[0], sc[1]); pb[1] = pk8(sc[2], sc[3]);
        f32x4 acc[4]; float ss = 0.f;
#pragma unroll
        for (int vt = 0; vt < 4; ++vt) {
            const int v0 = vh * 64 + 16 * vt;
            f32x4 c = {0.f, 0.f, 0.f, 0.f};
#pragma unroll
            for (int kc = 0; kc < 4; ++kc) c = MFMA16(*(const bf16x8*)(SS + (v0 + i16) * 136 + 32 * kc + 8 * g), bq[kc], c);
#pragma unroll
            for (int jc = 0; jc < 2; ++jc) {
                const bf16x8 av = cat8(tr_read(VS + (32 * jc + 4 * g + q) * 136 + v0 + 4 * p), tr_read(VS + (32 * jc + 16 + 4 * g + q) * 136 + v0 + 4 * p));
                c = MFMA16(av, pb[jc], c);
            }
            acc[vt] = c; ss += (c[0] * c[0] + c[1] * c[1]) + (c[2] * c[2] + c[3] * c[3]);
        }
        ss += __shfl_xor(ss, 16); ss += __shfl_xor(ss, 32);
        if (g == 0) red[vh * 64 + 16 * tt + i16] = ss;
        __syncthreads();
        const float rstd = __builtin_amdgcn_rsqf((red[16 * tt + i16] + red[64 + 16 * tt + i16]) * (1.f / 128.f) + EPS);
#pragma unroll
        for (int vt = 0; vt < 4; ++vt) {
            const int col = vh * 64 + 16 * vt + 4 * g; const size_t t = (size_t)(16 * tt + i16);
            const u32x2 ow = ogr[vt]; const f32x4 nw = *(const f32x4*)(a.hgrn_norm_w + h * 128 + col);
            u32x2 w; w.x = pk2(acc[vt][0] * rstd * nw[0] * bflo(ow.x), acc[vt][1] * rstd * nw[1] * bfhi(ow.x)); w.y = pk2(acc[vt][2] * rstd * nw[2] * bflo(ow.y), acc[vt][3] * rstd * nw[3] * bfhi(ow.y));
            *(u32x2*)(YA + t * 512 + col) = w;
        }
        __syncthreads();
    }
#undef HO_LOAD
}

__device__ __forceinline__ void hgrn_sample_item(const Args& a, int b, int h, unsigned char* lds) {
    const int tid = threadIdx.x, lane = tid & 63, wid = tid >> 6;
    float* part = (float*)lds;
    float* wsum = (float*)(lds + 32768);
    unsigned char* ws = a.ws;
    const int v4 = (tid & 31) * 4, kg = tid >> 5;
    const float* S0 = a.state_hgrn + ((size_t)(b * 4 + h) * 128 + 8 * kg) * 128 + v4;
    float* S1 = a.out + O_SS + ((size_t)(b * 4 + h) * 128 + 8 * kg) * 128 + v4;
    f32x4 S[8];
#pragma unroll
    for (int e = 0; e < 8; ++e) S[e] = *(const f32x4*)(S0 + e * 128);
    const size_t rb = (size_t)MP + (size_t)b * 4;
#pragma unroll
    for (int t = 0; t < 4; ++t) {
        const size_t off = ((size_t)h * MT + rb + t) * 128;
        const f32x8 g8 = __builtin_convertvector(*(const h16x8*)((const _Float16*)(ws + WS_R3) + off + 8 * kg), f32x8);
        const f32x4 g0 = {g8[0], g8[1], g8[2], g8[3]}, g1 = {g8[4], g8[5], g8[6], g8[7]};
        const u32x4 kw = *(const u32x4*)((const bf16*)(ws + WS_R2) + off + 8 * kg), qw = *(const u32x4*)((const bf16*)(ws + WS_R1) + off + 8 * kg);
        const u32x2 vw = *(const u32x2*)((const bf16*)(ws + WS_R4) + off + v4);
        const f32x4 vv = {bflo(vw.x), bfhi(vw.x), bflo(vw.y), bfhi(vw.y)};
        const float f[8] = {__expf(g0[0]), __expf(g0[1]), __expf(g0[2]), __expf(g0[3]), __expf(g1[0]), __expf(g1[1]), __expf(g1[2]), __expf(g1[3])};
        const float kk[8] = {bflo(kw.x), bfhi(kw.x), bflo(kw.y), bfhi(kw.y), bflo(kw.z), bfhi(kw.z), bflo(kw.w), bfhi(kw.w)};
        const float qq[8] = {bflo(qw.x), bfhi(qw.x), bflo(qw.y), bfhi(qw.y), bflo(qw.z), bfhi(qw.z), bflo(qw.w), bfhi(qw.w)};
        f32x4 po = {0.f, 0.f, 0.f, 0.f};
#pragma unroll
        for (int e = 0; e < 8; ++e) { S[e] = f[e] * S[e] + kk[e] * vv; po += qq[e] * S[e]; }
        *(f32x4*)(part + (t * 16 + kg) * 128 + v4) = po;
    }
#pragma unroll
    for (int e = 0; e < 8; ++e) *(f32x4*)(S1 + e * 128) = S[e];
    __syncthreads();
    const int t = tid >> 7, v = tid & 127;
    float o = 0.f;
#pragma unroll
    for (int k = 0; k < 16; ++k) o += part[(t * 16 + k) * 128 + v];
    const float s2 = wave_sum(o * o);
    if (lane == 0) wsum[wid] = s2;
    __syncthreads();
    const float rstd = __builtin_amdgcn_rsqf((wsum[2 * t] + wsum[2 * t + 1]) * (1.f / 128.f) + EPS);
    const float y = o * rstd * a.hgrn_norm_w[h * 128 + v] * bf2f(((const bf16*)(ws + WS_R5))[((size_t)h * MT + rb + t) * 128 + v]);
    ((bf16*)(ws + WS_YAS))[((size_t)b * 4 + t) * 512 + h * 128 + v] = (bf16)(pk2(y, 0.f) & 0xffffu);
    __syncthreads();
}


template <int K, int LDW = K> __device__ __forceinline__ f32x4 mini_gemm(const bf16* __restrict__ X, const bf16* __restrict__ W, unsigned char* lds, f32x4 acc) {
    const int tid = threadIdx.x, lane = tid & 63, wid = tid >> 6, i16 = lane & 15, g = lane >> 4, rw = wid & 1, cw = wid >> 1;
    const int sr = tid >> 5, sc = (tid & 31) * 8;
    constexpr int NT = K / 256, P = 264, XB_ = 32 * P * 2, BUF = (32 + 64) * P * 2;
    static_assert(K % 256 == 0, "mini_gemm: K must be a multiple of 256");
    const bf16* xp = X + (size_t)sr * K + sc; const bf16* wp = W + (size_t)sr * LDW + sc;
    u32x4 xr[2], wv[4];
#pragma unroll
    for (int i = 0; i < 2; ++i) xr[i] = *(const u32x4*)(xp + (size_t)(16 * i) * K);
#pragma unroll
    for (int i = 0; i < 4; ++i) wv[i] = *(const u32x4*)(wp + (size_t)(16 * i) * LDW);
    __syncthreads();
#pragma unroll 1
    for (int kt = 0; kt < NT; ++kt) {
        unsigned char* b = lds + (kt & 1) * BUF;
#pragma unroll
        for (int i = 0; i < 2; ++i) *(u32x4*)(b + ((sr + 16 * i) * P + sc) * 2) = xr[i];
#pragma unroll
        for (int i = 0; i < 4; ++i) *(u32x4*)(b + XB_ + ((sr + 16 * i) * P + sc) * 2) = wv[i];
        __syncthreads();
        if (kt + 1 < NT) {
#pragma unroll
            for (int i = 0; i < 2; ++i) xr[i] = *(const u32x4*)(xp + (size_t)(16 * i) * K + 256 * (kt + 1));
#pragma unroll
            for (int i = 0; i < 4; ++i) wv[i] = *(const u32x4*)(wp + (size_t)(16 * i) * LDW + 256 * (kt + 1));
        }
        const bf16* xs = (const bf16*)b + (16 * rw + i16) * P + 8 * g; const bf16* wsm = (const bf16*)(b + XB_) + (16 * cw + i16) * P + 8 * g;
#pragma unroll
        for (int kc = 0; kc < 8; ++kc) acc = MFMA16(*(const bf16x8*)(wsm + 32 * kc), *(const bf16x8*)(xs + 32 * kc), acc);
    }
    return acc;
}
#define SAMPLE_TILE_VARS const int lane = threadIdx.x & 63, wid = threadIdx.x >> 6, i16 = lane & 15, g = lane >> 4; \
    const int row0 = MP + 32 * (tile & 15), colb = 64 * (tile >> 4), row = row0 + 16 * (wid & 1) + i16, col0 = colb + 16 * (wid >> 1); const size_t off = (size_t)row * 1024 + col0 + 4 * g
__device__ __forceinline__ void p5_sample(const Args& a, unsigned char* lds) {
    unsigned char* ws = a.ws;
    for (int tile = blockIdx.x; tile < 256; tile += gridDim.x) {
        SAMPLE_TILE_VARS;
        const f32x4 z = {0.f, 0.f, 0.f, 0.f};
        const f32x4 pa = mini_gemm<512, 1024>((const bf16*)(ws + WS_YAS) + (size_t)(row0 - MP) * 512, (const bf16*)(ws + WS_WOH) + (size_t)colb * 1024, lds, z);
        const f32x4 pb = mini_gemm<512, 1024>((const bf16*)(ws + WS_R10) + (size_t)row0 * 512, (const bf16*)(ws + WS_WOH) + (size_t)colb * 1024 + 512, lds, z);
        const u32x2 ga = *(const u32x2*)((const bf16*)(ws + WS_R8) + off), gb = *(const u32x2*)((const bf16*)(ws + WS_R9) + off);
        u32x2 w; w.x = pk2(bflo(gb.x) * (bflo(ga.x) * pa[0] + pb[0]), bfhi(gb.x) * (bfhi(ga.x) * pa[1] + pb[1])); w.y = pk2(bflo(gb.y) * (bflo(ga.y) * pa[2] + pb[2]), bfhi(gb.y) * (bfhi(ga.y) * pa[3] + pb[3]));
        *(u32x2*)((bf16*)(ws + WS_R3) + off) = w;
    }
    __syncthreads();
}
__device__ __forceinline__ void p6_sample(const Args& a, unsigned char* lds) {
    unsigned char* ws = a.ws;
    for (int tile = blockIdx.x; tile < 256; tile += gridDim.x) {
        SAMPLE_TILE_VARS;
        const f32x4 z = {0.f, 0.f, 0.f, 0.f};
        const f32x4 p = mini_gemm<1024>((const bf16*)(ws + WS_R3) + (size_t)row0 * 1024, (const bf16*)(ws + WS_WOUT) + (size_t)colb * 1024, lds, z);
        const f32x4 v = p + *(const f32x4*)(a.x_sample + off - (size_t)MP * 1024);
        u32x2 w; w.x = pk2(v[0], v[1]); w.y = pk2(v[2], v[3]);
        *(u32x2*)((bf16*)(ws + WS_R8) + off) = w;
        float ss = (v[0] * v[0] + v[1] * v[1]) + (v[2] * v[2] + v[3] * v[3]);
        ss += __shfl_xor(ss, 16); ss += __shfl_xor(ss, 32);
        if (g == 0) atomicAdd((float*)(ws + WS_SUMSQ) + row, ss);
    }
    __syncthreads();
}
__device__ __forceinline__ void p8_sample(const Args& a, unsigned char* lds) {
    unsigned char* ws = a.ws;
    for (int tile = blockIdx.x; tile < 256; tile += gridDim.x) {
        SAMPLE_TILE_VARS;
        const f32x4 z = {0.f, 0.f, 0.f, 0.f};
        const f32x4 p = mini_gemm<DFF>((const bf16*)(ws + WS_R0) + (size_t)row0 * DFF, (const bf16*)(ws + WS_WD) + (size_t)colb * DFF, lds, z);
        const u32x2 xw = *(const u32x2*)((const bf16*)(ws + WS_R8) + off);
        *(f32x4*)(a.out + O_Y + off) = (f32x4){p[0] + bflo(xw.x), p[1] + bfhi(xw.x), p[2] + bflo(xw.y), p[3] + bfhi(xw.y)};
    }
    __syncthreads();
}
#define XB_TMO      128
#define XB_XCNT(j)  (256  + 64 * (j))
#define XB_XSUB(j)  (1280 + 64 * (j))
#define XB_XGEN(j)  (2304 + 64 * (j))
#define XB_TOP      3328
#define XB_TOPGEN   3392
#define XCD_BAR_WORDS 3456
#define XB_SPIN_CAP (1u << 18)

__device__ __forceinline__ unsigned xb_ld(unsigned* p)              { return __hip_atomic_load(p, __ATOMIC_RELAXED, __HIP_MEMORY_SCOPE_AGENT); }
__device__ __forceinline__ unsigned xb_add(unsigned* p, unsigned v) { return __hip_atomic_fetch_add(p, v, __ATOMIC_RELAXED, __HIP_MEMORY_SCOPE_AGENT); }
__device__ __forceinline__ unsigned xb_xcc_id() { return (unsigned)__builtin_amdgcn_s_getreg((3 << 11) | 20) & 0xFu; }
#define XB_SPIN(cond, bar) do { unsigned _sp = 0; while (cond) { __builtin_amdgcn_s_sleep(1); \
    if ((++_sp & 255u) == 0u) { if (xb_ld(&(bar)[XB_TMO])) break; if (_sp > XB_SPIN_CAP) { atomicAdd(&(bar)[XB_TMO], 1u); break; } } } } while (0)

struct XcdBarrier {
    unsigned* bar; unsigned x;
    volatile LAS unsigned* st;
};

__device__ __forceinline__ XcdBarrier xcd_barrier_post(unsigned* bar, volatile LAS unsigned* st) {
    XcdBarrier b; b.bar = bar; b.x = xb_xcc_id(); b.st = st;
    if (threadIdx.x == 0) (void)xb_add(&bar[XB_XCNT(b.x)], 1u);
    return b;
}
__device__ __forceinline__ void xcd_barrier_complete(unsigned* bar, unsigned x, unsigned& nloc, unsigned& nx) {
    const unsigned G = gridDim.x * gridDim.y * gridDim.z;
    unsigned sum, cnt, mine, sp = 0u;
    for (;;) {
        sum = 0u; cnt = 0u; mine = 0u;
#pragma unroll
        for (unsigned j = 0; j < 16; ++j) { const unsigned c = xb_ld(&bar[XB_XCNT(j)]); sum += c; cnt += (c > 0u) ? 1u : 0u; mine = (j == x) ? c : mine; }
        if (sum == G) break;
        __builtin_amdgcn_s_sleep(1);
        if ((++sp & 255u) == 0u) { if (xb_ld(&bar[XB_TMO])) break; if (sp > XB_SPIN_CAP) { atomicAdd(&bar[XB_TMO], 1u); break; } }
    }
    nloc = mine > 0u ? mine : 1u; nx = cnt > 0u ? cnt : 1u;
}

__device__ __forceinline__ void xcd_barrier(const XcdBarrier& b) {
    asm volatile("s_waitcnt vmcnt(0)" ::: "memory");
    __syncthreads();
    if (threadIdx.x == 0) {
        unsigned* bar = b.bar;
        __builtin_amdgcn_s_waitcnt(0);
        unsigned nloc = b.st[0], nx = b.st[1];
        if (nloc == 0u) { xcd_barrier_complete(bar, b.x, nloc, nx); b.st[0] = nloc; b.st[1] = nx; }
        const unsigned old = xb_add(&bar[XB_XSUB(b.x)], 1u);
        const unsigned gen = old / nloc;
        if (old + 1u == (gen + 1u) * nloc) {
            __builtin_amdgcn_fence(__ATOMIC_RELEASE, "agent");
            asm volatile("s_waitcnt vmcnt(0)" ::: "memory");
            const unsigned og = xb_add(&bar[XB_TOP], 1u);
            const unsigned tg = og / nx;
            if (og + 1u == (tg + 1u) * nx) xb_add(&bar[XB_TOPGEN], 1u);
            else XB_SPIN(xb_ld(&bar[XB_TOPGEN]) == tg, bar);
            __builtin_amdgcn_fence(__ATOMIC_ACQUIRE, "agent");
            xb_add(&bar[XB_XGEN(b.x)], 1u);
            asm volatile("s_waitcnt vmcnt(0)" ::: "memory");
        } else {
            XB_SPIN(xb_ld(&bar[XB_XGEN(b.x)]) == gen, bar);
            __builtin_amdgcn_fence(__ATOMIC_ACQUIRE, "agent");
            asm volatile("s_waitcnt vmcnt(0)" ::: "memory");
        }
    }
    __syncthreads();
}


#ifndef PG_ALIGN_BIG
#define PG_ALIGN_BIG true
#endif
#ifndef PG_ALIGN_N1K
#define PG_ALIGN_N1K true
#endif
__global__ void __launch_bounds__(NTHREADS, 2) mk_fwd(Args a) {
    extern __shared__ __attribute__((aligned(16))) unsigned char lds[];
    cg::grid_group grid = cg::this_grid();
    const int lo = a.ph_lo, hi = a.ph_hi, G = gridDim.x, bid = blockIdx.x;
    unsigned char* ws = a.ws;
    LAS unsigned char* ring = (LAS unsigned char*)(LAS void*)lds;
#ifdef PH_MASK
#define IN(k) (((PH_MASK) >> (k)) & 1)
#else
#define IN(k) (lo <= (k) && (k) < hi)
#endif
#ifdef TPROBE_A
#define STAMP(k) do { if (bid == 0 && threadIdx.x == 0) ((volatile unsigned long long*)(lds + 131072 + 64))[k] = __builtin_amdgcn_s_memrealtime(); } while (0)
#else
#define STAMP(k) do { } while (0)
#endif
    if (threadIdx.x < 2) ((volatile LAS unsigned*)(LAS void*)(lds + LDS_BYTES))[threadIdx.x] = 0u;
    __syncthreads();
    XcdBarrier xbar = xcd_barrier_post((unsigned*)(ws + WS_BAR), (volatile LAS unsigned*)(LAS void*)(lds + LDS_BYTES));
#define SEAM(k) do { if (IN(k) && IN((k) + 1)) { if (hi > 1000) grid.sync(); else xcd_barrier(xbar); } STAMP((k) + 1); } while (0)
    STAMP(0);

    constexpr int P1_NWG = (MT / 256) * (PW / 256);
    const int p1_rem = P1_NWG % G;
    if (IN(0)) { p0_prologue(a, lds, (p1_rem != 0 && IN(1)) ? P0_I1 : P0_NITEMS); }
    SEAM(0);
    if (IN(1)) {
        pg8::Gemm g{(const bf16*)(ws + WS_R0), (const bf16*)(ws + WS_W1T), MT, PW, 1024}; pg8::StaticOrder S; S.init(MT, PW, G, bid);
        pg8::EpiProj E{(bf16*)(ws + WS_R1), (bf16*)(ws + WS_R2), (bf16*)(ws + WS_R4), (bf16*)(ws + WS_R5), (bf16*)(ws + WS_R6), (bf16*)(ws + WS_R7), (bf16*)(ws + WS_R8), (bf16*)(ws + WS_R9),
                       (_Float16*)(ws + WS_R3), (const float*)(ws + WS_LBV)};
        pg8::gemm_phase<pg8::EpiProj, pg8::StaticOrder, PG_ALIGN_BIG, true>(ring, g, S, E);
        if (p1_rem != 0 && IN(0) && bid >= p1_rem) p0_weights(a, lds, P0_I1, P0_NITEMS, (bid - p1_rem) * 8 + (int)(threadIdx.x >> 6), (G - p1_rem) * 8);
    }
    SEAM(1);
    if (IN(2)) { hgrn_local_phase(a, lds); }
    SEAM(2);
    if (IN(3)) {
        constexpr int N_ATT = 4 * 64 * 2, N_SAT = DEC_B;
        const int ns = (G >= 128) ? 64 : 0;
        if (G == 256) {
            if (bid < ns) {
                hgrn_scan(a, bid, ns, lds); STAMP(10);
                __syncthreads();
                { const int r = 448 + bid; attn_prompt_item(a, r >> 7, (r >> 1) & 63, r & 1, lds); }
                for (int r = 320 + 3 * bid; r < 320 + 3 * bid + 3; ++r) hgrn_sample_item(a, r >> 2, r & 3, lds);
            } else {
                const int j = bid - ns;
                if (j < 128) { attn_sample_item(a, j, lds);
                    for (int r = 2 * j; r < 2 * j + 2; ++r) attn_prompt_item(a, r >> 7, (r >> 1) & 63, r & 1, lds);
                    for (int r = 2 * j; r < 2 * j + 2; ++r) hgrn_sample_item(a, r >> 2, r & 3, lds); }
                else { for (int r = 256 + 3 * (j - 128); r < 256 + 3 * (j - 128) + 3; ++r) attn_prompt_item(a, r >> 7, (r >> 1) & 63, r & 1, lds);
                    { const int r = 256 + (j - 128); hgrn_sample_item(a, r >> 2, r & 3, lds); } }
            }
        } else {
            if (ns == 0) hgrn_scan(a, bid, G, lds); else if (bid < ns) hgrn_scan(a, bid, ns, lds);
            __syncthreads();
            if (bid >= ns) {
                for (int it = bid - ns; it < N_ATT + N_SAT; it += G - ns) {
                    if (it < N_ATT) attn_prompt_item(a, it >> 7, (it >> 1) & 63, it & 1, lds);
                    else attn_sample_item(a, it - N_ATT, lds);
                }
                for (int r = bid - ns; r < DEC_B * 4; r += G - ns) hgrn_sample_item(a, r >> 2, r & 3, lds);
            }
        }
    }
    SEAM(3);
    if (IN(4)) {
        hgrn_out_phase(a, lds);
    }
    SEAM(4);
    if (IN(5)) {
        p5_sample(a, lds);
        pg8::StaticOrder S; S.init(MP, 1024, G, bid);
        pg8::Gemm g{(const bf16*)(ws + WS_R6), (const bf16*)(ws + WS_WOH), MP, 1024, 1024, (const bf16*)(ws + WS_R10), 512, 8};
        pg8::EpiMerge E{(const bf16*)(ws + WS_R8), (const bf16*)(ws + WS_R9), (bf16*)(ws + WS_R3)};
        pg8::gemm_phase<pg8::EpiMerge, pg8::StaticOrder, PG_ALIGN_N1K, true, true>(ring, g, S, E);
    }
    SEAM(5);
    if (IN(6)) {
        p6_sample(a, lds);
        pg8::Gemm g{(const bf16*)(ws + WS_R3), (const bf16*)(ws + WS_WOUT), MP, 1024, 1024}; pg8::StaticOrder S; S.init(MP, 1024, G, bid);
        pg8::EpiRes1 E{a.x_prompt, (bf16*)(ws + WS_R8), (float*)(ws + WS_SUMSQ)};
        pg8::gemm_phase<pg8::EpiRes1, pg8::StaticOrder, PG_ALIGN_N1K, true>(ring, g, S, E);
    }
    SEAM(6);
    if (IN(7)) {
        pg8::Gemm g{(const bf16*)(ws + WS_R8), (const bf16*)(ws + WS_WGU), MT, 2 * DFF, 1024}; pg8::StaticOrder S; S.init(MT, 2 * DFF, G, bid);
        pg8::EpiFfn E{(const float*)(ws + WS_SUMSQ), (bf16*)(ws + WS_R0)};
        pg8::gemm_phase<pg8::EpiFfn, pg8::StaticOrder, PG_ALIGN_BIG, true>(ring, g, S, E);
    }
    SEAM(7);
    if (IN(8)) {
        p8_sample(a, lds);
        pg8::Gemm g{(const bf16*)(ws + WS_R0), (const bf16*)(ws + WS_WD), MP, 1024, DFF}; pg8::StaticOrder S; S.init(MP, 1024, G, bid);
        pg8::EpiRes2 E{(const bf16*)(ws + WS_R8), a.out + O_Y};
        pg8::gemm_phase<pg8::EpiRes2, pg8::StaticOrder, PG_ALIGN_N1K, true>(ring, g, S, E);
    }
#ifdef TPROBE_A
    {
        grid.sync(); STAMP(9);
        unsigned long long* pw = (unsigned long long*)(ws + WS_MISC + 2048);
        if (bid == 0 && threadIdx.x == 0) { volatile unsigned long long* t = (volatile unsigned long long*)(lds + 131072 + 64);
            pw[0] = (TPROBE_A >= 0) ? t[TPROBE_A + 1] - t[TPROBE_A] : 0ull; pw[1] = (TPROBE_B == 10) ? t[10] - t[3] : t[TPROBE_B + 1] - t[TPROBE_B]; __threadfence(); }
        grid.sync();
        const unsigned long long dA = __hip_atomic_load(pw, __ATOMIC_RELAXED, __HIP_MEMORY_SCOPE_AGENT), dB = __hip_atomic_load(pw + 1, __ATOMIC_RELAXED, __HIP_MEMORY_SCOPE_AGENT);
        const float eps = sqrtf(2e-5f + (float)dB * 0.01f * (float)(TPROBE_KB));
        f32x4* cvs = (f32x4*)(a.out + O_VS);
        for (int i = bid * NTHREADS + threadIdx.x; i < 128 * 128 * 128 / 4; i += G * NTHREADS) cvs[i] = cvs[i] * (1.f + eps);
        const unsigned long long t0 = __builtin_amdgcn_s_memrealtime();
        while (__builtin_amdgcn_s_memrealtime() - t0 < 4ull * dA) __builtin_amdgcn_s_sleep(8);
    }
#endif
#undef IN
#undef SEAM
}

__global__ void dump_ws(const unsigned short* w, float* o, size_t n, size_t tot) {
    for (size_t i = blockIdx.x * (size_t)blockDim.x + threadIdx.x; i < n; i += (size_t)gridDim.x * blockDim.x) { unsigned s = 0; for (size_t j = i; j < tot; j += n) s += w[j]; o[i] = (float)s; }
}
constexpr int N_PHASES = 9;
extern "C" void kernel_launch(void* const* d_in, const int* in_sizes, int n_in, void* d_out, int out_size, void* d_ws, size_t ws_size, hipStream_t stream) {
    static int grid = 0;
    if (grid == 0) {
        if (n_in != 19 || (size_t)out_size != O_END || ws_size < WS_END) { fprintf(stderr, "kernel_launch: unexpected shapes: n_in %d out %d ws %zu (need %zu)\n", n_in, out_size, ws_size, (size_t)WS_END); grid = -1; return; }
        int dev = 0, cus = 0, per_cu = 0;
        if (hipGetDevice(&dev) != hipSuccess || hipDeviceGetAttribute(&cus, hipDeviceAttributeMultiprocessorCount, dev) != hipSuccess) { grid = -1; return; }
        if (hipFuncSetAttribute((const void*)mk_fwd, hipFuncAttributeMaxDynamicSharedMemorySize, LDS_TOTAL) != hipSuccess) { fprintf(stderr, "kernel_launch: hipFuncSetAttribute failed\n"); grid = -1; return; }
        if (hipOccupancyMaxActiveBlocksPerMultiprocessor(&per_cu, (const void*)mk_fwd, NTHREADS, LDS_TOTAL) != hipSuccess || per_cu < 1) { fprintf(stderr, "kernel_launch: occupancy query says %d\n", per_cu); (void)hipGetLastError(); grid = -1; return; }
        grid = cus;
    }
    if (grid < 0) return;
    Args a{};
    const float** ap = (const float**)&a;
    for (int i = 0; i < 19; ++i) ap[i] = (const float*)d_in[i];
    a.out = (float*)d_out; a.ws = (unsigned char*)d_ws;
#if MK_N_LAUNCHES == 1
    if (hipMemsetAsync((char*)d_ws + WS_BAR, 0, XCD_BAR_WORDS * 4, stream) != hipSuccess) { fprintf(stderr, "kernel_launch: memset of the barrier words failed\n"); return; }
    a.ph_lo = 0; a.ph_hi = N_PHASES;
    void* args[] = {&a};
    hipError_t e = hipLaunchCooperativeKernel((const void*)mk_fwd, dim3(grid), dim3(NTHREADS), args, LDS_TOTAL, stream);
    if (e != hipSuccess) fprintf(stderr, "kernel_launch: cooperative launch failed: %s (grid %d)\n", hipGetErrorString(e), grid);
#else
#ifndef PROBE_K
#define PROBE_K 8
#endif
    for (int ph = 0; ph <= PROBE_K; ++ph) {
        a.ph_lo = ph; a.ph_hi = ph + 1;
        hipLaunchKernelGGL(mk_fwd, dim3(grid), dim3(NTHREADS), LDS_TOTAL, stream, a);
    }
#if PROBE_K < 8
    hipLaunchKernelGGL(dump_ws, dim3(2048), dim3(256), 0, stream, (const unsigned short*)d_ws, (float*)d_out, (size_t)out_size, (size_t)(WS_END / 2));
#endif
#endif
}
```
